# Optimizing an MI355X kernel written in HIP

```python
import math
import jax, jax.numpy as jnp
from jax import lax
import numpy as np

D_MODEL = 4096
BATCH = 4
SEQ = 2048
DEPTH = 1

HEAD_DIM = 128
MIX_WIDTH = D_MODEL
SWA_HEADS = (MIX_WIDTH // 2) // HEAD_DIM
SWA_KV_HEADS = SWA_HEADS // 4
SWA_GROUP = SWA_HEADS // SWA_KV_HEADS
WINDOW = 128
BLOCK = 128
DIFF_HEADS = (MIX_WIDTH // 2) // HEAD_DIM
DIFF_QK_DIM = HEAD_DIM // 2
DIFF_V_DIM = HEAD_DIM
D_FF = 4 * D_MODEL
PLE_DIM = 256
ROPE_THETA = 10000.0
NORM_EPS = 1e-6
NEG_INF = -1e30

SWA_Q_COLS = SWA_HEADS * HEAD_DIM
SWA_KV_COLS = SWA_KV_HEADS * HEAD_DIM
DIFF_QK_COLS = 2 * DIFF_HEADS * DIFF_QK_DIM
DIFF_V_COLS = DIFF_HEADS * DIFF_V_DIM
IN_COLS = SWA_Q_COLS + 2 * SWA_KV_COLS + 2 * DIFF_QK_COLS + DIFF_V_COLS

kernel_name = "hymba_swa_sink_diffattn_sqrelu_ple"


def rmsnorm(x, g):
    xf = x.astype(jnp.float32)
    y = xf * lax.rsqrt(jnp.mean(xf * xf, axis=-1, keepdims=True) + NORM_EPS)
    return (y * g.astype(jnp.float32)).astype(x.dtype)


def rope_tables(seq_len, dim):
    pos = jnp.arange(seq_len, dtype=jnp.float32)
    inv = 1.0 / (ROPE_THETA ** (jnp.arange(0, dim, 2, dtype=jnp.float32) / dim))
    ang = pos[:, None] * inv[None, :]
    ang = jnp.concatenate([ang, ang], axis=-1)
    return jnp.cos(ang), jnp.sin(ang)


def apply_rope(x, cos, sin):
    shape = (1, cos.shape[0]) + (1,) * (x.ndim - 3) + (cos.shape[1],)
    c, s = cos.reshape(shape), sin.reshape(shape)
    xf = x.astype(jnp.float32)
    x1, x2 = jnp.split(xf, 2, axis=-1)
    rot = jnp.concatenate([-x2, x1], axis=-1)
    return (xf * c + rot * s).astype(x.dtype)


def sliding_window_sink_attention(q, k, v, sinks):
    B, S = q.shape[0], q.shape[1]
    nb = S // BLOCK
    qb = q.reshape(B, nb, BLOCK, SWA_KV_HEADS, SWA_GROUP, HEAD_DIM)
    kb = k.reshape(B, nb, BLOCK, SWA_KV_HEADS, HEAD_DIM)
    vb = v.reshape(B, nb, BLOCK, SWA_KV_HEADS, HEAD_DIM)
    pad = lambda t: jnp.concatenate([jnp.zeros_like(t[:, :1]), t[:, :-1]], axis=1)
    kk = jnp.concatenate([pad(kb), kb], axis=2)
    vv = jnp.concatenate([pad(vb), vb], axis=2)
    scale = 1.0 / math.sqrt(HEAD_DIM)
    s = jnp.einsum('bnqkgd,bnjkd->bnkgqj', qb, kk).astype(jnp.float32) * scale
    blk = jnp.arange(nb)[:, None, None] * BLOCK
    qpos = blk + jnp.arange(BLOCK)[None, :, None]
    kpos = blk - BLOCK + jnp.arange(2 * BLOCK)[None, None, :]
    valid = (kpos <= qpos) & (qpos - kpos < WINDOW) & (kpos >= 0)
    s = jnp.where(valid[None, :, None, None], s, NEG_INF)
    sink = jnp.broadcast_to(
        sinks.astype(jnp.float32).reshape(1, 1, SWA_KV_HEADS, SWA_GROUP, 1, 1),
        s.shape[:-1] + (1,))
    probs = jax.nn.softmax(jnp.concatenate([s, sink], axis=-1), axis=-1)[..., :-1]
    o = jnp.einsum('bnkgqj,bnjkd->bnqkgd', probs.astype(v.dtype), vv)
    return o.reshape(B, S, SWA_HEADS * HEAD_DIM)


def differential_attention(q, k, v, lam):
    B, S = q.shape[0], q.shape[1]
    nb = S // BLOCK
    qb = q.reshape(B, nb, BLOCK, 2, DIFF_HEADS, DIFF_QK_DIM).transpose(1, 0, 2, 3, 4, 5)
    kpos = jnp.arange(S)
    scale = 1.0 / math.sqrt(DIFF_QK_DIM)

    def one_block(args):
        qi, i = args
        s = jnp.einsum('bqchd,bkchd->bchqk', qi, k).astype(jnp.float32) * scale
        qpos = i * BLOCK + jnp.arange(BLOCK)
        causal = kpos[None, :] <= qpos[:, None]
        s = jnp.where(causal, s, NEG_INF)
        pr = jax.nn.softmax(s, axis=-1)
        w = (pr[:, 0] - lam * pr[:, 1]).astype(v.dtype)
        return jnp.einsum('bhqk,bkhd->bqhd', w, v)

    o = lax.map(one_block, (qb, jnp.arange(nb)))
    return o.transpose(1, 0, 2, 3, 4).reshape(B, S, DIFF_HEADS, DIFF_V_DIM)


def setup_inputs(seed: int = 0) -> dict:
    key = jax.random.key(seed)
    ks = jax.random.split(key, 24)
    nrm = lambda k, shape, sc: jax.random.normal(k, shape, jnp.float32) * sc
    gain = lambda k, n: 1.0 + 0.02 * jax.random.normal(k, (DEPTH, n), jnp.float32)
    return {
        "x": nrm(ks[0], (BATCH, SEQ, D_MODEL), 1.0),
        "p": nrm(ks[1], (DEPTH, BATCH, SEQ, PLE_DIM), 1.0),
        "attn_norm_g": gain(ks[2], D_MODEL),
        "w_in": nrm(ks[3], (DEPTH, D_MODEL, IN_COLS), D_MODEL ** -0.5),
        "swa_q_norm_g": gain(ks[4], HEAD_DIM),
        "swa_k_norm_g": gain(ks[5], HEAD_DIM),
        "swa_sinks": nrm(ks[6], (DEPTH, SWA_HEADS), 0.5),
        "diff_q_norm_g": gain(ks[7], DIFF_QK_DIM),
        "diff_k_norm_g": gain(ks[8], DIFF_QK_DIM),
        "diff_lambda_q1": nrm(ks[9], (DEPTH, DIFF_QK_DIM), 0.1),
        "diff_lambda_k1": nrm(ks[10], (DEPTH, DIFF_QK_DIM), 0.1),
        "diff_lambda_q2": nrm(ks[11], (DEPTH, DIFF_QK_DIM), 0.1),
        "diff_lambda_k2": nrm(ks[12], (DEPTH, DIFF_QK_DIM), 0.1),
        "diff_subln_g": gain(ks[13], DIFF_V_DIM),
        "w_o": nrm(ks[14], (DEPTH, MIX_WIDTH, D_MODEL), MIX_WIDTH ** -0.5),
        "mlp_norm_g": gain(ks[15], D_MODEL),
        "w_up": nrm(ks[16], (DEPTH, D_MODEL, D_FF), D_MODEL ** -0.5),
        "w_down": nrm(ks[17], (DEPTH, D_FF, D_MODEL), D_FF ** -0.5),
        "w_ple_proj": nrm(ks[18], (DEPTH, PLE_DIM, D_MODEL), PLE_DIM ** -0.5),
        "ple_norm_g": gain(ks[19], D_MODEL),
        "w_ple_gate": nrm(ks[20], (DEPTH, D_MODEL, D_MODEL), D_MODEL ** -0.5),
    }


def reference(x, p, attn_norm_g, w_in, swa_q_norm_g, swa_k_norm_g, swa_sinks,
              diff_q_norm_g, diff_k_norm_g, diff_lambda_q1, diff_lambda_k1,
              diff_lambda_q2, diff_lambda_k2, diff_subln_g, w_o, mlp_norm_g,
              w_up, w_down, w_ple_proj, ple_norm_g, w_ple_gate):
    B, S, _ = x.shape
    cos_a, sin_a = rope_tables(S, HEAD_DIM)
    cos_b, sin_b = rope_tables(S, DIFF_QK_DIM)
    splits = np.cumsum([SWA_Q_COLS, SWA_KV_COLS, SWA_KV_COLS,
                        DIFF_QK_COLS, DIFF_QK_COLS])
    h = x
    for i in range(DEPTH):
        a = rmsnorm(h, attn_norm_g[i])
        proj = a @ w_in[i]
        qa, ka, va, qb, kb, vb = jnp.split(proj, splits, axis=-1)

        qa = qa.reshape(B, S, SWA_HEADS, HEAD_DIM)
        ka = ka.reshape(B, S, SWA_KV_HEADS, HEAD_DIM)
        va = va.reshape(B, S, SWA_KV_HEADS, HEAD_DIM)
        qa = apply_rope(rmsnorm(qa, swa_q_norm_g[i]), cos_a, sin_a)
        ka = apply_rope(rmsnorm(ka, swa_k_norm_g[i]), cos_a, sin_a)
        out_a = sliding_window_sink_attention(qa, ka, va, swa_sinks[i])

        qb = qb.reshape(B, S, 2, DIFF_HEADS, DIFF_QK_DIM)
        kb = kb.reshape(B, S, 2, DIFF_HEADS, DIFF_QK_DIM)
        vb = vb.reshape(B, S, DIFF_HEADS, DIFF_V_DIM)
        qb = apply_rope(rmsnorm(qb, diff_q_norm_g[i]), cos_b, sin_b)
        kb = apply_rope(rmsnorm(kb, diff_k_norm_g[i]), cos_b, sin_b)
        lambda_init = 0.8 - 0.6 * math.exp(-0.3 * i)
        lam = (jnp.exp(jnp.sum(diff_lambda_q1[i].astype(jnp.float32) * diff_lambda_k1[i].astype(jnp.float32)))
               - jnp.exp(jnp.sum(diff_lambda_q2[i].astype(jnp.float32) * diff_lambda_k2[i].astype(jnp.float32)))
               + lambda_init)
        ob = differential_attention(qb, kb, vb, lam)
        out_b = (rmsnorm(ob, diff_subln_g[i]) * (1.0 - lambda_init)).reshape(B, S, DIFF_V_COLS)

        h = h + jnp.concatenate([out_a, out_b], axis=-1) @ w_o[i]

        m = rmsnorm(h, mlp_norm_g[i])
        h = h + jnp.square(jax.nn.relu(m @ w_up[i])) @ w_down[i]

        pe = rmsnorm(p[i] @ w_ple_proj[i], ple_norm_g[i])
        h = h + jax.nn.sigmoid(h @ w_ple_gate[i]) * pe
    return h
```

```cpp
#include <hip/hip_runtime.h>
#include <hip/hip_cooperative_groups.h>
#include <cstdio>
#include <cstdint>
namespace cg = cooperative_groups;
namespace pg8 {
#define PG8_LAS __attribute__((address_space(3)))
typedef unsigned short bf16_t;
typedef short bf16x8 __attribute__((ext_vector_type(8)));
typedef float f32x4 __attribute__((ext_vector_type(4)));
typedef unsigned u32x4 __attribute__((ext_vector_type(4)));
constexpr int BM = 256, BK = 64, HALF = 128, HTB = HALF * BK * 2  , STAGE_BYTES = 8 * HTB, NXCD = 8, WGM = 8;

__host__ __device__ __forceinline__ int lds_byte(int r, int c) { const int st = (r >> 4) * 2 + (c >> 5), rr = r & 15, cc = c & 31, ob = rr * 64 + cc * 2; return st * 1024 + (ob ^ (((ob >> 9) & 1) << 5)); }
__host__ __device__ __forceinline__ void stage_rc(int b, int& R, int& C) { const int st = b / 1024, sb = b % 1024, swz = sb ^ (((sb >> 9) & 1) << 5); R = (st >> 1) * 16 + swz / 64; C = (st & 1) * 32 + (swz % 64) / 2; }
__host__ __device__ __forceinline__ int perm32(int rho) { const int n = rho >> 4, i = rho & 15; return 8 * (i >> 2) + 4 * n + (i & 3); }

struct Unit { int pm, pn; };
struct Gemm { const bf16_t* A; const bf16_t* Bt; int M, N, K; };

struct StaticOrder {
    int nM, nN, nwg, G, c;
    __host__ __device__ void init(int M, int N, int G_, int c_) { nM = M / BM; nN = N / BM; nwg = nM * nN; G = G_; c = c_; }
    __host__ __device__ bool next(int i, Unit& u) const {
        const long L = (long)i * G + c; if (L >= nwg) return false;
        int wgid = (int)L; { const int q = nwg / NXCD, r = nwg % NXCD, xcd = wgid % NXCD, off = wgid / NXCD; wgid = (xcd < r ? xcd * (q + 1) : r * (q + 1) + (xcd - r) * q) + off; }
        const int nig = WGM * nN, gid = wgid / nig, fm = gid * WGM, gsz = (nM - fm) < WGM ? (nM - fm) : WGM;
        u.pm = fm + ((wgid % nig) % gsz); u.pn = (wgid % nig) / gsz; return true;
    }
    __device__ __forceinline__ void a_ready(const Unit&) const {}
    __device__ __forceinline__ void done(const Unit&) const {}
};

__device__ __forceinline__ unsigned cvt_pk_bf16(float lo, float hi) { unsigned r; asm volatile("v_cvt_pk_bf16_f32 %0, %1, %2" : "=v"(r) : "v"(lo), "v"(hi)); return r; }
typedef float f32x2 __attribute__((ext_vector_type(2)));
constexpr float RMS_EPS = 1e-6f;
__device__ __forceinline__ u32x4 pack8(const f32x4 v0, const f32x4 v1) { u32x4 w; w.x = cvt_pk_bf16(v0[0], v0[1]); w.y = cvt_pk_bf16(v0[2], v0[3]); w.z = cvt_pk_bf16(v1[0], v1[1]); w.w = cvt_pk_bf16(v1[2], v1[3]); return w; }
__device__ __forceinline__ float bf_lo(unsigned w) { return __uint_as_float(w << 16); }
__device__ __forceinline__ float bf_hi(unsigned w) { return __uint_as_float(w & 0xffff0000u); }

struct EpiPlain {
    static constexpr bool PERM = true, AFTER_DRAIN = false;
    bf16_t* O; int ldc;
    __device__ __forceinline__ void operator()(const f32x4 (&acc)[2][2][4][2], const Unit& u, int wr, int wc, int fr, int fq) const {
        const int row0 = u.pm * BM + wr * 64 + fr, col0 = u.pn * BM + wc * 32 + 8 * fq;
#pragma unroll
        for (int ai = 0; ai < 2; ++ai)
#pragma unroll
            for (int m = 0; m < 4; ++m) { bf16_t* rowp = O + (size_t)(row0 + ai * HALF + m * 16) * ldc + col0;
#pragma unroll
                for (int bj = 0; bj < 2; ++bj) *(u32x4*)(rowp + bj * HALF) = pack8(acc[ai][bj][m][0], acc[ai][bj][m][1]); }
    }
};
struct EpiPle {
    static constexpr bool PERM = true, AFTER_DRAIN = false;
    bf16_t* O; int ldc; float* rowss;
    __device__ __forceinline__ void operator()(const f32x4 (&acc)[2][2][4][2], const Unit& u, int wr, int wc, int fr, int fq) const {
        const int row0 = u.pm * BM + wr * 64 + fr, col0 = u.pn * BM + wc * 32 + 8 * fq;
#pragma unroll
        for (int ai = 0; ai < 2; ++ai)
#pragma unroll
            for (int m = 0; m < 4; ++m) { const int row = row0 + ai * HALF + m * 16; bf16_t* rowp = O + (size_t)row * ldc + col0; float ss = 0.f;
#pragma unroll
                for (int bj = 0; bj < 2; ++bj) { const f32x4 v0 = acc[ai][bj][m][0], v1 = acc[ai][bj][m][1];
                    ss += (v0[0] * v0[0] + v0[1] * v0[1]) + (v0[2] * v0[2] + v0[3] * v0[3]) + (v1[0] * v1[0] + v1[1] * v1[1]) + (v1[2] * v1[2] + v1[3] * v1[3]);
                    *(u32x4*)(rowp + bj * HALF) = pack8(v0, v1); }
                ss += __shfl_xor(ss, 16); ss += __shfl_xor(ss, 32);
                if (fq == 0) atomicAdd(rowss + row, ss); }
    }
};
struct EpiUp {
    static constexpr bool PERM = true, AFTER_DRAIN = false;
    bf16_t* O; int ldc; const float* rowss; float inv_nfeat;
    __device__ __forceinline__ void operator()(const f32x4 (&acc)[2][2][4][2], const Unit& u, int wr, int wc, int fr, int fq) const {
        const int row0 = u.pm * BM + wr * 64 + fr, col0 = u.pn * BM + wc * 32 + 8 * fq;
#pragma unroll
        for (int ai = 0; ai < 2; ++ai)
#pragma unroll
            for (int m = 0; m < 4; ++m) { const int row = row0 + ai * HALF + m * 16; bf16_t* rowp = O + (size_t)row * ldc + col0;
                const float r2 = 1.0f / (rowss[row] * inv_nfeat + RMS_EPS);
#pragma unroll
                for (int bj = 0; bj < 2; ++bj) { f32x4 v0 = acc[ai][bj][m][0], v1 = acc[ai][bj][m][1];
#pragma unroll
                    for (int e = 0; e < 4; ++e) { const float a = fmaxf(v0[e], 0.f), b = fmaxf(v1[e], 0.f); v0[e] = a * a * r2; v1[e] = b * b * r2; }
                    *(u32x4*)(rowp + bj * HALF) = pack8(v0, v1); } }
    }
};
struct EpiRes {
    static constexpr bool PERM = true, AFTER_DRAIN = false;
    const float* base; float* out; bf16_t* hb; int ldc; const float* gain; float* rowss;
    __device__ __forceinline__ void operator()(const f32x4 (&acc)[2][2][4][2], const Unit& u, int wr, int wc, int fr, int fq) const {
        const int row0 = u.pm * BM + wr * 64 + fr, col0 = u.pn * BM + wc * 32 + 8 * fq;
        f32x4 g[2][2];
#pragma unroll
        for (int bj = 0; bj < 2; ++bj)
#pragma unroll
            for (int n = 0; n < 2; ++n) g[bj][n] = gain ? *(const f32x4*)(gain + col0 + bj * HALF + 4 * n) : (f32x4){1.f, 1.f, 1.f, 1.f};
#pragma unroll
        for (int ai = 0; ai < 2; ++ai)
#pragma unroll
            for (int m = 0; m < 4; ++m) { const int row = row0 + ai * HALF + m * 16; const size_t off = (size_t)row * ldc + col0; float ss = 0.f;
#pragma unroll
                for (int bj = 0; bj < 2; ++bj) { const f32x4 b0 = *(const f32x4*)(base + off + bj * HALF), b1 = *(const f32x4*)(base + off + bj * HALF + 4);
                    const f32x4 v0 = acc[ai][bj][m][0] + b0, v1 = acc[ai][bj][m][1] + b1;
                    *(f32x4*)(out + off + bj * HALF) = v0; *(f32x4*)(out + off + bj * HALF + 4) = v1;
                    ss += (v0[0] * v0[0] + v0[1] * v0[1]) + (v0[2] * v0[2] + v0[3] * v0[3]) + (v1[0] * v1[0] + v1[1] * v1[1]) + (v1[2] * v1[2] + v1[3] * v1[3]);
                    *(u32x4*)(hb + off + bj * HALF) = pack8(v0 * g[bj][0], v1 * g[bj][1]); }
                if (rowss) { ss += __shfl_xor(ss, 16); ss += __shfl_xor(ss, 32); if (fq == 0) atomicAdd(rowss + row, ss); } }
    }
};
struct EpiFinal {
    static constexpr bool PERM = true, AFTER_DRAIN = false;
    float* out; const bf16_t* pe; int ldc; const float* rowss; const float* gple; float inv_nfeat;
    __device__ __forceinline__ void operator()(const f32x4 (&acc)[2][2][4][2], const Unit& u, int wr, int wc, int fr, int fq) const {
        const int row0 = u.pm * BM + wr * 64 + fr, col0 = u.pn * BM + wc * 32 + 8 * fq;
        f32x4 g[2][2];
#pragma unroll
        for (int bj = 0; bj < 2; ++bj)
#pragma unroll
            for (int n = 0; n < 2; ++n) g[bj][n] = *(const f32x4*)(gple + col0 + bj * HALF + 4 * n);
#pragma unroll
        for (int ai = 0; ai < 2; ++ai)
#pragma unroll
            for (int m = 0; m < 4; ++m) { const int row = row0 + ai * HALF + m * 16; const size_t off = (size_t)row * ldc + col0;
                const float rs = 1.0f / sqrtf(rowss[row] * inv_nfeat + RMS_EPS);
#pragma unroll
                for (int bj = 0; bj < 2; ++bj) { const f32x4 b0 = *(const f32x4*)(out + off + bj * HALF), b1 = *(const f32x4*)(out + off + bj * HALF + 4);
                    const u32x4 pw = *(const u32x4*)(pe + off + bj * HALF);
                    const f32x4 p0 = (f32x4){bf_lo(pw.x), bf_hi(pw.x), bf_lo(pw.y), bf_hi(pw.y)}, p1 = (f32x4){bf_lo(pw.z), bf_hi(pw.z), bf_lo(pw.w), bf_hi(pw.w)};
                    f32x4 v0 = acc[ai][bj][m][0], v1 = acc[ai][bj][m][1];
#pragma unroll
                    for (int e = 0; e < 4; ++e) { v0[e] = 1.0f / (1.0f + __expf(-v0[e])); v1[e] = 1.0f / (1.0f + __expf(-v1[e])); }
                    v0 = b0 + v0 * (p0 * g[bj][0]) * rs; v1 = b1 + v1 * (p1 * g[bj][1]) * rs;
                    *(f32x4*)(out + off + bj * HALF) = v0; *(f32x4*)(out + off + bj * HALF + 4) = v1; } }
    }
};
template <class Epi, class Sched, bool ALIGN_EPI = false, bool SP2 = false>
__device__ __forceinline__ void gemm_phase(PG8_LAS unsigned char* lds, const Gemm g, const Sched& S, const Epi& E) {
    const int tid = threadIdx.x, wid = __builtin_amdgcn_readfirstlane(tid >> 6), lane = tid & 63, wr = wid >> 2, wc = wid & 3, fr = lane & 15, fq = lane >> 4;
    const int K = g.K, nt = K / BK;
    unsigned voffA[2], voffB[2];
#pragma unroll
    for (int i = 0; i < 2; ++i) { int R, C; stage_rc(tid * 16 + i * 8192, R, C); const int Rb = Epi::PERM ? ((R & ~31) + perm32(R & 31)) : R;
        voffA[i] = (unsigned)(R * K + C) * 2u; voffB[i] = (unsigned)(Rb * K + C) * 2u; }
    const size_t kstep = (size_t)(BK * 2);
    const size_t hstep = (size_t)HALF * K * 2;
    const size_t tstep = 2 * hstep;
    const unsigned ldsw = (unsigned)wid * 1024u;
    const int aoff = lds_byte(wr * 64 + fr, fq * 8), boff = lds_byte(wc * 32 + fr, fq * 8);
#define PG8_SA(b, h) (((b) * 2 + (h)) * HTB)
#define PG8_SB(b, h) ((4 + (b) * 2 + (h)) * HTB)
#define PG8_STAGE(bufoff, gbase, voff) do { _Pragma("unroll") for (int _i = 0; _i < 2; ++_i) \
        __builtin_amdgcn_global_load_lds((const unsigned*)((const char*)(gbase) + (voff)[_i]), (PG8_LAS unsigned*)(lds + (bufoff) + ldsw + _i * 8192), 16, 0, 0); } while (0)
#define PG8_LDA(dst, b, h) do { _Pragma("unroll") for (int m = 0; m < 4; ++m) _Pragma("unroll") for (int k = 0; k < 2; ++k) dst[m][k] = *(const PG8_LAS bf16x8*)(lds + PG8_SA(b, h) + aoff + m * 2048 + k * 1024); } while (0)
#define PG8_LDB(dst, b, h) do { _Pragma("unroll") for (int n = 0; n < 2; ++n) _Pragma("unroll") for (int k = 0; k < 2; ++k) dst[n][k] = *(const PG8_LAS bf16x8*)(lds + PG8_SB(b, h) + boff + n * 2048 + k * 1024); } while (0)
#define PG8_MMA(ai, bj, At, Bt) do { __builtin_amdgcn_s_setprio(1); _Pragma("unroll") for (int m = 0; m < 4; ++m) _Pragma("unroll") for (int n = 0; n < 2; ++n) _Pragma("unroll") for (int k = 0; k < 2; ++k) \
        acc[ai][bj][m][n] = __builtin_amdgcn_mfma_f32_16x16x32_bf16(Bt[n][k], At[m][k], acc[ai][bj][m][n], 0, 0, 0); __builtin_amdgcn_s_setprio(0); } while (0)
#define PG8_WAIT_V(n) asm volatile("s_waitcnt vmcnt(" #n ")" ::: "memory")
#define PG8_WAIT_L(n) asm volatile("s_waitcnt lgkmcnt(" #n ")" ::: "memory")
#define PG8_BAR __builtin_amdgcn_s_barrier()
#define PG8_SCHED __builtin_amdgcn_sched_barrier(0)
    Unit cur, nxt; int ui = 0;
    if (!S.next(0, cur)) return;
    f32x4 acc[2][2][4][2];
#pragma unroll
    for (int a = 0; a < 2; ++a)
#pragma unroll
        for (int b = 0; b < 2; ++b)
#pragma unroll
            for (int m = 0; m < 4; ++m)
#pragma unroll
                for (int n = 0; n < 2; ++n) acc[a][b][m][n] = (f32x4){0.f, 0.f, 0.f, 0.f};
    bf16x8 At[4][2], B0[2][2], B1[2][2];
    const char* cA = (const char*)g.A + (size_t)cur.pm * tstep; const char* cB = (const char*)g.Bt + (size_t)cur.pn * tstep;
    S.a_ready(cur);
    if constexpr (SP2) {
        PG8_STAGE(PG8_SB(0, 0), cB, voffB); PG8_STAGE(PG8_SB(0, 1), cB + hstep, voffB); PG8_STAGE(PG8_SA(0, 0), cA, voffA); PG8_STAGE(PG8_SA(0, 1), cA + hstep, voffA);
        if (wr == 1) PG8_BAR;
        PG8_WAIT_V(2); PG8_BAR;
        PG8_STAGE(PG8_SB(1, 0), cB + kstep, voffB); PG8_STAGE(PG8_SA(1, 0), cA + kstep, voffA); PG8_STAGE(PG8_SB(1, 1), cB + hstep + kstep, voffB);
        PG8_WAIT_V(6); PG8_BAR;
    } else {
        PG8_STAGE(PG8_SB(0, 0), cB, voffB); PG8_STAGE(PG8_SA(0, 0), cA, voffA); PG8_STAGE(PG8_SB(0, 1), cB + hstep, voffB); PG8_STAGE(PG8_SA(0, 1), cA + hstep, voffA);
        if (wr == 1) PG8_BAR;
        PG8_WAIT_V(4); PG8_BAR;
        PG8_STAGE(PG8_SB(1, 0), cB + kstep, voffB); PG8_STAGE(PG8_SA(1, 0), cA + kstep, voffA); PG8_STAGE(PG8_SB(1, 1), cB + hstep + kstep, voffB);
        PG8_WAIT_V(6); PG8_BAR;
    }
    for (;;) {
        const bool has_next = S.next(ui + 1, nxt);
        const char* nA = has_next ? (const char*)g.A + (size_t)nxt.pm * tstep : cA; const char* nB = has_next ? (const char*)g.Bt + (size_t)nxt.pn * tstep : cB;
        for (int t = 0; t < nt; t += 2) {
            const bool last = (t == nt - 2);
            const char* a1 = cA + (size_t)(t + 1) * kstep;
            const char* a2 = last ? nA : cA + (size_t)(t + 2) * kstep; const char* b2 = last ? nB : cB + (size_t)(t + 2) * kstep;
            const char* a3 = a2 + kstep; const char* b3 = b2 + kstep;
            if (last && has_next) S.a_ready(nxt);
            if constexpr (SP2) {
            PG8_LDB(B0, 0, 0); PG8_LDB(B1, 0, 1); PG8_SCHED; PG8_LDA(At, 0, 0); PG8_STAGE(PG8_SA(1, 1), a1 + hstep, voffA);
            PG8_WAIT_V(8); PG8_WAIT_L(0); PG8_BAR; PG8_MMA(0, 0, At, B0); PG8_MMA(0, 1, At, B1); PG8_BAR; PG8_SCHED;
            PG8_LDA(At, 0, 1); PG8_STAGE(PG8_SB(0, 0), b2, voffB); PG8_STAGE(PG8_SB(0, 1), b2 + hstep, voffB); PG8_STAGE(PG8_SA(0, 0), a2, voffA);
            PG8_WAIT_V(8); PG8_WAIT_L(0); PG8_BAR; PG8_MMA(1, 0, At, B0); PG8_MMA(1, 1, At, B1); PG8_BAR; PG8_SCHED;
            PG8_LDB(B0, 1, 0); PG8_LDB(B1, 1, 1); PG8_SCHED; PG8_LDA(At, 1, 0); PG8_STAGE(PG8_SA(0, 1), a2 + hstep, voffA);
            PG8_WAIT_V(8); PG8_WAIT_L(0); PG8_BAR; PG8_MMA(0, 0, At, B0); PG8_MMA(0, 1, At, B1); PG8_BAR; PG8_SCHED;
            PG8_LDA(At, 1, 1); PG8_STAGE(PG8_SB(1, 0), b3, voffB); PG8_STAGE(PG8_SB(1, 1), b3 + hstep, voffB); PG8_STAGE(PG8_SA(1, 0), a3, voffA);
            PG8_WAIT_V(8); PG8_WAIT_L(0); PG8_BAR; PG8_MMA(1, 0, At, B0); PG8_MMA(1, 1, At, B1); PG8_BAR; PG8_SCHED;
            } else {
            PG8_LDB(B0, 0, 0); PG8_SCHED; PG8_LDA(At, 0, 0); PG8_STAGE(PG8_SA(1, 1), a1 + hstep, voffA);
            PG8_WAIT_L(8); PG8_BAR; PG8_WAIT_L(0); PG8_MMA(0, 0, At, B0); PG8_BAR; PG8_SCHED;
            PG8_LDB(B1, 0, 1); PG8_STAGE(PG8_SB(0, 0), b2, voffB);
            PG8_BAR; PG8_WAIT_L(0); PG8_MMA(0, 1, At, B1); PG8_BAR;
            PG8_LDA(At, 0, 1); PG8_STAGE(PG8_SA(0, 0), a2, voffA);
            PG8_BAR; PG8_WAIT_L(0); PG8_MMA(1, 0, At, B0); PG8_BAR; PG8_SCHED;
            PG8_STAGE(PG8_SB(0, 1), b2 + hstep, voffB);
            PG8_WAIT_V(6); PG8_BAR; PG8_MMA(1, 1, At, B1); PG8_BAR;
            PG8_LDB(B0, 1, 0); PG8_SCHED; PG8_LDA(At, 1, 0); PG8_STAGE(PG8_SA(0, 1), a2 + hstep, voffA);
            PG8_WAIT_L(8); PG8_BAR; PG8_WAIT_L(0); PG8_MMA(0, 0, At, B0); PG8_BAR; PG8_SCHED;
            PG8_LDB(B1, 1, 1); PG8_STAGE(PG8_SB(1, 0), b3, voffB);
            PG8_BAR; PG8_WAIT_L(0); PG8_MMA(0, 1, At, B1); PG8_BAR;
            PG8_LDA(At, 1, 1); PG8_STAGE(PG8_SA(1, 0), a3, voffA);
            PG8_BAR; PG8_WAIT_L(0); PG8_MMA(1, 0, At, B0); PG8_BAR; PG8_SCHED;
            PG8_STAGE(PG8_SB(1, 1), b3 + hstep, voffB);
            PG8_WAIT_V(6); PG8_BAR; PG8_MMA(1, 1, At, B1); PG8_BAR;
            }
        }
        if constexpr (ALIGN_EPI) { if (wr == 0) PG8_BAR; }
        if constexpr (!Epi::AFTER_DRAIN) { E(acc, cur, wr, wc, fr, fq); S.done(cur); }
        if (!has_next) break;
#pragma unroll
        for (int a = 0; a < 2; ++a)
#pragma unroll
            for (int b = 0; b < 2; ++b)
#pragma unroll
                for (int m = 0; m < 4; ++m)
#pragma unroll
                    for (int n = 0; n < 2; ++n) acc[a][b][m][n] = (f32x4){0.f, 0.f, 0.f, 0.f};
        cur = nxt; cA = nA; cB = nB; ++ui;
        if constexpr (ALIGN_EPI) { if (wr == 1) PG8_BAR; }
    }
    PG8_WAIT_V(0);
    if constexpr (!ALIGN_EPI) { if (wr == 0) PG8_BAR; }
    PG8_BAR;
    if constexpr (Epi::AFTER_DRAIN) { E.fused(acc, cur, wr, wc, fr, fq, lds, wid, lane); S.done(cur); }
#undef PG8_SA
#undef PG8_SB
#undef PG8_STAGE
#undef PG8_LDA
#undef PG8_LDB
#undef PG8_MMA
#undef PG8_WAIT_V
#undef PG8_WAIT_L
#undef PG8_BAR
#undef PG8_SCHED
}
}

constexpr int NWAVES = 8, NTHREADS = 512;
constexpr int D_MODEL = 4096, BATCH = 4, SEQ = 2048, M_TOK = BATCH * SEQ, IN_COLS = 9216, D_FF = 16384, PLE_DIM = 256;
constexpr int COL_QA = 0, COL_KA = 2048, COL_VA = 2560, COL_QB = 3072, COL_KB = 5120, COL_VB = 7168;
constexpr float NORM_EPS = 1e-6f;
constexpr float LOG2E = 1.4426950408889634f;
constexpr size_t MiB = 1u << 20;
constexpr size_t WS_CTL = 0;
constexpr size_t WS_ROWSS_MLP = 64 * 1024, WS_ROWSS_PLE = 128 * 1024;
constexpr size_t WS_TAB128 = 1 * MiB;
constexpr size_t WS_TAB64 = 2 * MiB;
constexpr size_t WS_WIN = 4 * MiB, WS_WO = 76 * MiB, WS_WUP = 108 * MiB, WS_WDN = 236 * MiB, WS_WG = 364 * MiB, WS_WPLE = 396 * MiB;
constexpr size_t WS_PB = 398 * MiB;
constexpr size_t WS_XN = 402 * MiB;
constexpr size_t WS_PE = 466 * MiB;
constexpr size_t WS_PROJ = 530 * MiB;
constexpr size_t WS_VTA = 674 * MiB, WS_VTB = 682 * MiB;
constexpr size_t WS_CAT = 714 * MiB;
constexpr size_t WS_U = 530 * MiB;
constexpr size_t WS_OSCR = 786 * MiB;
constexpr size_t WS_END = 818 * MiB;
constexpr int LDS_BYTES = 147456;

#define GAS __attribute__((address_space(1)))
#define LAS __attribute__((address_space(3)))
typedef unsigned short bf16;
typedef unsigned v4u __attribute__((ext_vector_type(4)));
typedef unsigned v2u __attribute__((ext_vector_type(2)));
typedef float f32x4 __attribute__((ext_vector_type(4)));
typedef float f32x2 __attribute__((ext_vector_type(2)));
typedef short bf16x8 __attribute__((ext_vector_type(8)));
#define LDS_WAIT() asm volatile("s_waitcnt lgkmcnt(0)" ::: "memory")

__device__ __forceinline__ unsigned pk2(float lo, float hi) { return pg8::cvt_pk_bf16(lo, hi); }
__device__ __forceinline__ float bflo(unsigned w) { return __uint_as_float(w << 16); }
__device__ __forceinline__ float bfhi(unsigned w) { return __uint_as_float(w & 0xffff0000u); }
__device__ __forceinline__ float wave_sum(float v) {
#pragma unroll
    for (int o = 1; o < 64; o <<= 1) v += __shfl_xor(v, o);
    return v;
}

struct Args {
    const float *x, *p, *attn_g, *w_in, *qa_g, *ka_g, *sinks, *qb_g, *kb_g, *lq1, *lk1, *lq2, *lk2, *subln_g, *w_o, *mlp_g, *w_up, *w_down, *w_ple, *ple_g, *w_gate;
    float* out; unsigned char* ws; int ph_lo, ph_hi, coop, pad;
};

__device__ __forceinline__ void p0_transpose_item(const float* W, int K, int N, bf16* WT, LAS float* scr, int item, int lane) {
    const int nblk = N / 64, kb = item / nblk, nb = item % nblk, k0 = 64 * kb, n0 = 64 * nb;
    const float* src = W + (size_t)k0 * N + n0 + lane;
#pragma unroll 16
    for (int kk = 0; kk < 64; ++kk) scr[kk * 65 + lane] = src[(size_t)kk * N];
    LDS_WAIT(); asm volatile("" ::: "memory");
    const int c = lane & 7;
#pragma unroll
    for (int j = 0; j < 8; ++j) { const int n = (lane >> 3) + 8 * j; const LAS float* s = scr + (8 * c) * 65 + n;
        v4u o; o.x = pk2(s[0 * 65], s[1 * 65]); o.y = pk2(s[2 * 65], s[3 * 65]); o.z = pk2(s[4 * 65], s[5 * 65]); o.w = pk2(s[6 * 65], s[7 * 65]);
        *(v4u*)(WT + (size_t)(n0 + n) * K + k0 + 8 * c) = o; }
    LDS_WAIT(); asm volatile("" ::: "memory");
}
__device__ __forceinline__ void p0_prologue(const Args& A, LAS unsigned char* lds, int gw, int NGW, int wave, int lane) {
    unsigned char* ws = A.ws;
    LAS float* scr = (LAS float*)(lds + wave * 16640);
    constexpr int I_IN = (D_MODEL / 64) * (IN_COLS / 64), I_O = (D_MODEL / 64) * (D_MODEL / 64), I_UP = (D_MODEL / 64) * (D_FF / 64), I_DN = I_UP, I_G = I_O, I_PLE = (PLE_DIM / 64) * (D_MODEL / 64);
    constexpr int NITEMS = I_IN + I_O + I_UP + I_DN + I_G + I_PLE;
    for (int it = gw; it < NITEMS; it += NGW) {
        int r = it;
        if (r < I_IN) { p0_transpose_item(A.w_in, D_MODEL, IN_COLS, (bf16*)(ws + WS_WIN), scr, r, lane); continue; } r -= I_IN;
        if (r < I_O) { p0_transpose_item(A.w_o, D_MODEL, D_MODEL, (bf16*)(ws + WS_WO), scr, r, lane); continue; } r -= I_O;
        if (r < I_UP) { p0_transpose_item(A.w_up, D_MODEL, D_FF, (bf16*)(ws + WS_WUP), scr, r, lane); continue; } r -= I_UP;
        if (r < I_DN) { p0_transpose_item(A.w_down, D_FF, D_MODEL, (bf16*)(ws + WS_WDN), scr, r, lane); continue; } r -= I_DN;
        if (r < I_G) { p0_transpose_item(A.w_gate, D_MODEL, D_MODEL, (bf16*)(ws + WS_WG), scr, r, lane); continue; } r -= I_G;
        p0_transpose_item(A.w_ple, PLE_DIM, D_MODEL, (bf16*)(ws + WS_WPLE), scr, r, lane);
    }
    for (int m = gw; m < M_TOK; m += NGW) {
        const f32x4* xr = (const f32x4*)(A.x + (size_t)m * D_MODEL) + lane;
        f32x4 v[16]; float s = 0.f;
#pragma unroll
        for (int j = 0; j < 16; ++j) { v[j] = xr[64 * j]; s += (v[j].x * v[j].x + v[j].y * v[j].y) + (v[j].z * v[j].z + v[j].w * v[j].w); }
        const float rstd = 1.0f / sqrtf(wave_sum(s) * (1.0f / D_MODEL) + NORM_EPS);
        v2u* o8 = (v2u*)((bf16*)(ws + WS_XN) + (size_t)m * D_MODEL) + lane;
        const f32x4* gr = (const f32x4*)A.attn_g + lane;
#pragma unroll
        for (int j = 0; j < 16; ++j) { const f32x4 g = gr[64 * j]; v2u o; o.x = pk2(v[j].x * rstd * g.x, v[j].y * rstd * g.y); o.y = pk2(v[j].z * rstd * g.z, v[j].w * rstd * g.w); o8[64 * j] = o; }
    }
    { const int gt = gw * 64 + lane, NGT = NGW * 64;
      for (int i = gt; i < M_TOK * PLE_DIM / 8; i += NGT) { const f32x4 a = ((const f32x4*)A.p)[2 * i], b = ((const f32x4*)A.p)[2 * i + 1];
          v4u o; o.x = pk2(a.x, a.y); o.y = pk2(a.z, a.w); o.z = pk2(b.x, b.y); o.w = pk2(b.z, b.w); ((v4u*)(ws + WS_PB))[i] = o; }
      for (int i = gt; i < SEQ * 64; i += NGT) { const int pos = i >> 6, j = i & 63;
          const float inv = __builtin_amdgcn_exp2f(-(float)(2 * j) * (1.0f / 128.0f) * 13.287712379549449f); const float ang = (float)pos * inv;
          double xr = (double)ang * 0.15915494309189535; xr -= __builtin_rint(xr); const float fx = (float)xr;
          ((f32x2*)(ws + WS_TAB128))[i] = (f32x2){__builtin_amdgcn_cosf(fx), __builtin_amdgcn_sinf(fx)}; }
      for (int i = gt; i < SEQ * 32; i += NGT) { const int pos = i >> 5, j = i & 31;
          const float inv = __builtin_amdgcn_exp2f(-(float)(2 * j) * (1.0f / 64.0f) * 13.287712379549449f); const float ang = (float)pos * inv;
          double xr = (double)ang * 0.15915494309189535; xr -= __builtin_rint(xr); const float fx = (float)xr;
          ((f32x2*)(ws + WS_TAB64))[i] = (f32x2){__builtin_amdgcn_cosf(fx), __builtin_amdgcn_sinf(fx)}; }
      for (int i = gt; i < M_TOK; i += NGT) { ((float*)(ws + WS_ROWSS_MLP))[i] = 0.f; ((float*)(ws + WS_ROWSS_PLE))[i] = 0.f; }
    }
}

__device__ __forceinline__ void p2_qknorm_rope(const Args& A, LAS unsigned char* lds, int gw, int NGW, int tid, int lane) {
    unsigned char* ws = A.ws; bf16* proj = (bf16*)(ws + WS_PROJ);
    const f32x2* tab128 = (const f32x2*)(ws + WS_TAB128); const f32x2* tab64 = (const f32x2*)(ws + WS_TAB64);
    const float qs128 = 0.08838834764831845f * LOG2E, qs64 = 0.125f * LOG2E;
    for (int row = gw; row < M_TOK; row += NGW) {
        const int pos = row & (SEQ - 1); bf16* prow = proj + (size_t)row * IN_COLS;
#pragma unroll 1
        for (int it = 0; it < 5; ++it) { const int ch = it * 64 + lane, col = ch * 8, i = ch & 15; const bool isq = col < COL_KA;
            const v4u w = *(const v4u*)(prow + col);
            float x[8] = {bflo(w.x), bfhi(w.x), bflo(w.y), bfhi(w.y), bflo(w.z), bfhi(w.z), bflo(w.w), bfhi(w.w)};
            float ss = 0.f;
#pragma unroll
            for (int e = 0; e < 8; ++e) ss += x[e] * x[e];
            ss += __shfl_xor(ss, 1); ss += __shfl_xor(ss, 2); ss += __shfl_xor(ss, 4); ss += __shfl_xor(ss, 8);
            const float rstd = 1.0f / sqrtf(ss * (1.0f / 128.0f) + NORM_EPS);
            const float* gp = (isq ? A.qa_g : A.ka_g) + i * 8; const f32x4 g0 = *(const f32x4*)gp, g1 = *(const f32x4*)(gp + 4);
            const float g[8] = {g0.x, g0.y, g0.z, g0.w, g1.x, g1.y, g1.z, g1.w};
            const f32x2* tb = tab128 + pos * 64 + (i & 7) * 8; const float sgn = (i < 8) ? -1.f : 1.f, sc = isq ? qs128 : 1.f;
            float o[8];
#pragma unroll
            for (int e = 0; e < 8; ++e) { const float y = x[e] * rstd * g[e]; const float py = __shfl_xor(y, 8); const f32x2 cs = tb[e]; o[e] = (y * cs.x + sgn * py * cs.y) * sc; }
            v4u ow; ow.x = pk2(o[0], o[1]); ow.y = pk2(o[2], o[3]); ow.z = pk2(o[4], o[5]); ow.w = pk2(o[6], o[7]);
            *(v4u*)(prow + col) = ow; }
#pragma unroll 1
        for (int it = 0; it < 8; ++it) { const int ch = it * 64 + lane, col = COL_QB + ch * 8, i = ch & 7; const bool isq = ch < 256;
            const v4u w = *(const v4u*)(prow + col);
            float x[8] = {bflo(w.x), bfhi(w.x), bflo(w.y), bfhi(w.y), bflo(w.z), bfhi(w.z), bflo(w.w), bfhi(w.w)};
            float ss = 0.f;
#pragma unroll
            for (int e = 0; e < 8; ++e) ss += x[e] * x[e];
            ss += __shfl_xor(ss, 1); ss += __shfl_xor(ss, 2); ss += __shfl_xor(ss, 4);
            const float rstd = 1.0f / sqrtf(ss * (1.0f / 64.0f) + NORM_EPS);
            const float* gp = (isq ? A.qb_g : A.kb_g) + i * 8; const f32x4 g0 = *(const f32x4*)gp, g1 = *(const f32x4*)(gp + 4);
            const float g[8] = {g0.x, g0.y, g0.z, g0.w, g1.x, g1.y, g1.z, g1.w};
            const f32x2* tb = tab64 + pos * 32 + (i & 3) * 8; const float sgn = (i < 4) ? -1.f : 1.f, sc = isq ? qs64 : 1.f;
            float o[8];
#pragma unroll
            for (int e = 0; e < 8; ++e) { const float y = x[e] * rstd * g[e]; const float py = __shfl_xor(y, 4); const f32x2 cs = tb[e]; o[e] = (y * cs.x + sgn * py * cs.y) * sc; }
            v4u ow; ow.x = pk2(o[0], o[1]); ow.y = pk2(o[2], o[3]); ow.z = pk2(o[4], o[5]); ow.w = pk2(o[6], o[7]);
            *(v4u*)(prow + col) = ow; }
    }
    LAS bf16* T = (LAS bf16*)lds;
    for (int tile = blockIdx.x; tile < (M_TOK / 64) * 20; tile += gridDim.x) {
        const int tb = tile / 20, hd = tile % 20, b = tb / (SEQ / 64), s0 = (tb % (SEQ / 64)) * 64;
        const int vcol = hd < 4 ? COL_VA + hd * 128 : COL_VB + (hd - 4) * 128;
        bf16* dst = hd < 4 ? (bf16*)(ws + WS_VTA) + (size_t)(b * 4 + hd) * 128 * SEQ : (bf16*)(ws + WS_VTB) + (size_t)(b * 16 + (hd - 4)) * 128 * SEQ;
#pragma unroll
        for (int k = 0; k < 2; ++k) { const int ci = tid + 512 * k, tok = ci >> 4, dc = ci & 15;
            const v4u w = *(const v4u*)(proj + (size_t)(tb * 64 + tok) * IN_COLS + vcol + dc * 8);
            LAS bf16* t = T + (dc * 8) * 72 + tok;
            t[0 * 72] = (bf16)(w.x & 0xffff); t[1 * 72] = (bf16)(w.x >> 16); t[2 * 72] = (bf16)(w.y & 0xffff); t[3 * 72] = (bf16)(w.y >> 16);
            t[4 * 72] = (bf16)(w.z & 0xffff); t[5 * 72] = (bf16)(w.z >> 16); t[6 * 72] = (bf16)(w.w & 0xffff); t[7 * 72] = (bf16)(w.w >> 16); }
        __syncthreads();
#pragma unroll
        for (int k = 0; k < 2; ++k) { const int ci = tid + 512 * k, d = ci >> 3, tc = ci & 7;
            const v4u w = *(const LAS v4u*)(T + d * 72 + tc * 8);
            *(v4u*)(dst + (size_t)d * SEQ + s0 + tc * 8) = w; }
        __syncthreads();
    }
}

namespace att {
constexpr int BUF_BYTES = 32768, K_OFF = 0, V_OFF = 16384;
constexpr float NEG = -1e30f;
__device__ __forceinline__ int swz(int rr, int fq) { const int ob = rr * 64 + fq * 16; return ob ^ (((ob >> 9) & 1) << 5); }

template <int DK> struct Stage { v4u k[DK / 64]; v4u v[2]; };

template <int DK>
__device__ __forceinline__ void stage_load(Stage<DK>& st, const bf16* Kb, int ldk, const bf16* Vt, int kt0, int tid) {
#pragma unroll
    for (int k = 0; k < DK / 64; ++k) { const int ci = tid + 512 * k, kl = ci / (DK / 8), c8 = ci % (DK / 8); st.k[k] = *(const v4u*)(Kb + (size_t)(kt0 + kl) * ldk + c8 * 8); }
#pragma unroll
    for (int k = 0; k < 2; ++k) { const int ci = tid + 512 * k, d = ci >> 3, kc = ci & 7; st.v[k] = *(const v4u*)(Vt + (size_t)d * SEQ + kt0 + kc * 8); }
}
template <int DK>
__device__ __forceinline__ void stage_write(const Stage<DK>& st, LAS unsigned char* buf, int tid) {
#pragma unroll
    for (int k = 0; k < DK / 64; ++k) { const int ci = tid + 512 * k, kl = ci / (DK / 8), c8 = ci % (DK / 8);
        const int u = kl >> 5, g = (kl >> 3) & 3, e = (kl >> 2) & 1, i = kl & 3, t = 2 * u + e, rr = 4 * g + i, c = c8 >> 2, fq = c8 & 3;
        *(LAS v4u*)(buf + K_OFF + (t * (DK / 32) + c) * 1024 + swz(rr, fq)) = st.k[k]; }
#pragma unroll
    for (int k = 0; k < 2; ++k) { const int ci = tid + 512 * k, d = ci >> 3, kc = ci & 7; const int dt = d >> 4, rr = d & 15, u = kc >> 2, fq = kc & 3;
        *(LAS v4u*)(buf + V_OFF + (dt * 2 + u) * 1024 + swz(rr, fq)) = st.v[k]; }
}

template <int DK, bool SWA>
__device__ __forceinline__ void pass(LAS unsigned char* lds, const bf16* Q, int ldq, const bf16* Kb, int ldk, const bf16* Vt, int q0, int jt_lo, int jt_hi,
                                     float (&mrow)[2], float (&lrow)[2], f32x4 (&O)[2][8], int tid, int wave, int lane) {
    const int fr = lane & 15, fq = lane >> 4, qw = q0 + 32 * wave;
    bf16x8 qf[2][DK / 32];
#pragma unroll
    for (int rg = 0; rg < 2; ++rg)
#pragma unroll
        for (int c = 0; c < DK / 32; ++c) qf[rg][c] = *(const bf16x8*)(Q + (size_t)(qw + 16 * rg + fr) * ldq + 32 * c + 8 * fq);
    const int fro = swz(fr, fq);
    Stage<DK> st;
    stage_load<DK>(st, Kb, ldk, Vt, jt_lo * 64, tid);
    stage_write<DK>(st, lds, tid);
    __syncthreads();
    for (int jt = jt_lo; jt <= jt_hi; ++jt) {
        LAS unsigned char* buf = lds + ((jt - jt_lo) & 1) * BUF_BYTES;
        if (jt < jt_hi) stage_load<DK>(st, Kb, ldk, Vt, (jt + 1) * 64, tid);
        const int kt0 = jt * 64;
        bool need = kt0 <= qw + 31; if (SWA) need = need && (kt0 + 63 >= qw - 127);
        if (need) {
            f32x4 s[2][4];
#pragma unroll
            for (int t = 0; t < 4; ++t) {
#pragma unroll
                for (int rg = 0; rg < 2; ++rg) s[rg][t] = (f32x4){0.f, 0.f, 0.f, 0.f};
#pragma unroll
                for (int c = 0; c < DK / 32; ++c) { const bf16x8 kf = *(const LAS bf16x8*)(buf + K_OFF + (t * (DK / 32) + c) * 1024 + fro);
#pragma unroll
                    for (int rg = 0; rg < 2; ++rg) s[rg][t] = __builtin_amdgcn_mfma_f32_16x16x32_bf16(kf, qf[rg][c], s[rg][t], 0, 0, 0); }
                if (t & 1) __builtin_amdgcn_sched_barrier(0);
            }
            const bool domask = SWA || (kt0 + 63 > qw);
            if (domask) {
#pragma unroll
                for (int rg = 0; rg < 2; ++rg) { const int q = qw + 16 * rg + fr;
#pragma unroll
                    for (int t = 0; t < 4; ++t)
#pragma unroll
                        for (int i = 0; i < 4; ++i) { const int key = kt0 + 32 * (t >> 1) + 8 * fq + 4 * (t & 1) + i;
                            bool ok = key <= q; if (SWA) ok = ok && (q - key < 128);
                            s[rg][t][i] = ok ? s[rg][t][i] : NEG; } }
            }
            bf16x8 pf[2][2];
#pragma unroll
            for (int rg = 0; rg < 2; ++rg) {
                float mx = NEG;
#pragma unroll
                for (int t = 0; t < 4; ++t) mx = fmaxf(mx, fmaxf(fmaxf(s[rg][t][0], s[rg][t][1]), fmaxf(s[rg][t][2], s[rg][t][3])));
                mx = fmaxf(mx, __shfl_xor(mx, 16)); mx = fmaxf(mx, __shfl_xor(mx, 32));
                const float mnew = fmaxf(mrow[rg], mx), alpha = __builtin_amdgcn_exp2f(mrow[rg] - mnew); mrow[rg] = mnew;
                float ps = 0.f;
#pragma unroll
                for (int t = 0; t < 4; ++t)
#pragma unroll
                    for (int i = 0; i < 4; ++i) { const float p = __builtin_amdgcn_exp2f(s[rg][t][i] - mnew); s[rg][t][i] = p; ps += p; }
                lrow[rg] = lrow[rg] * alpha + ps;
#pragma unroll
                for (int dt = 0; dt < 8; ++dt) O[rg][dt] = O[rg][dt] * alpha;
#pragma unroll
                for (int u = 0; u < 2; ++u) { v4u w; w.x = pk2(s[rg][2 * u][0], s[rg][2 * u][1]); w.y = pk2(s[rg][2 * u][2], s[rg][2 * u][3]);
                    w.z = pk2(s[rg][2 * u + 1][0], s[rg][2 * u + 1][1]); w.w = pk2(s[rg][2 * u + 1][2], s[rg][2 * u + 1][3]); pf[rg][u] = __builtin_bit_cast(bf16x8, w); }
            }
#pragma unroll
            for (int dt = 0; dt < 8; ++dt)
#pragma unroll
                for (int u = 0; u < 2; ++u) { const bf16x8 vf = *(const LAS bf16x8*)(buf + V_OFF + (dt * 2 + u) * 1024 + fro);
#pragma unroll
                    for (int rg = 0; rg < 2; ++rg) O[rg][dt] = __builtin_amdgcn_mfma_f32_16x16x32_bf16(vf, pf[rg][u], O[rg][dt], 0, 0, 0);
                    if (u == 1 && (dt & 1)) __builtin_amdgcn_sched_barrier(0); }
        }
        if (jt < jt_hi) stage_write<DK>(st, lds + (((jt - jt_lo) & 1) ^ 1) * BUF_BYTES, tid);
        __syncthreads();
    }
}

__device__ __forceinline__ void init_state(float (&m)[2], float (&l)[2], f32x4 (&O)[2][8]) {
#pragma unroll
    for (int rg = 0; rg < 2; ++rg) { m[rg] = NEG; l[rg] = 0.f;
#pragma unroll
        for (int dt = 0; dt < 8; ++dt) O[rg][dt] = (f32x4){0.f, 0.f, 0.f, 0.f}; }
}

__device__ __forceinline__ void swa_unit(const Args& A, LAS unsigned char* lds, int unit) {
    const int tid = threadIdx.x, lane = tid & 63, wave = __builtin_amdgcn_readfirstlane(tid >> 6);
    unsigned char* ws = A.ws; const bf16* proj = (const bf16*)(ws + WS_PROJ);
    const int qb = unit & 7, hq = (unit >> 3) & 15, b = unit >> 7, kvh = hq >> 2, q0 = qb * 256;
    const bf16* Q = proj + (size_t)b * SEQ * IN_COLS + COL_QA + hq * 128;
    const bf16* Kb = proj + (size_t)b * SEQ * IN_COLS + COL_KA + kvh * 128;
    const bf16* Vt = (const bf16*)(ws + WS_VTA) + (size_t)(b * 4 + kvh) * 128 * SEQ;
    float m[2], l[2]; f32x4 O[2][8]; init_state(m, l, O);
    const int jt_lo = (4 * qb - 2) > 0 ? 4 * qb - 2 : 0, jt_hi = 4 * qb + 3;
    pass<128, true>(lds, Q, IN_COLS, Kb, IN_COLS, Vt, q0, jt_lo, jt_hi, m, l, O, tid, wave, lane);
    const int fr = lane & 15, fq = lane >> 4; const float sink2 = A.sinks[hq] * LOG2E;
    bf16* cat = (bf16*)(ws + WS_CAT);
#pragma unroll
    for (int rg = 0; rg < 2; ++rg) { float lt = l[rg]; lt += __shfl_xor(lt, 16); lt += __shfl_xor(lt, 32);
        lt += __builtin_amdgcn_exp2f(sink2 - m[rg]); const float inv = 1.0f / lt;
        bf16* orow = cat + (size_t)(b * SEQ + q0 + 32 * wave + 16 * rg + fr) * D_MODEL + hq * 128 + 4 * fq;
#pragma unroll
        for (int dt = 0; dt < 8; ++dt) { const f32x4 o = O[rg][dt] * inv; v2u w; w.x = pk2(o[0], o[1]); w.y = pk2(o[2], o[3]); *(v2u*)(orow + 16 * dt) = w; } }
}
__device__ __forceinline__ void diff_unit(const Args& A, LAS unsigned char* lds, int b, int h, int qb, float lam) {
    const int tid = threadIdx.x, lane = tid & 63, wave = __builtin_amdgcn_readfirstlane(tid >> 6);
    unsigned char* ws = A.ws; const bf16* proj = (const bf16*)(ws + WS_PROJ);
    const int q0 = qb * 256; const size_t boff = (size_t)b * SEQ * IN_COLS;
    const bf16* Vt = (const bf16*)(ws + WS_VTB) + (size_t)(b * 16 + h) * 128 * SEQ;
    const int jt_hi = 4 * qb + 3;
    float m[2], l[2]; f32x4 O1[2][8], O0[2][8];
    f32x4* oscr = (f32x4*)(ws + WS_OSCR) + (size_t)blockIdx.x * 16 * 512 + tid;
#pragma unroll 1
    for (int mp = 0; mp < 2; ++mp) {
        init_state(m, l, O1);
        pass<64, false>(lds, proj + boff + COL_QB + mp * 1024 + h * 64, IN_COLS, proj + boff + COL_KB + mp * 1024 + h * 64, IN_COLS, Vt, q0, 0, jt_hi, m, l, O1, tid, wave, lane);
        if (mp == 0) {
#pragma unroll
            for (int rg = 0; rg < 2; ++rg) { float lt = l[rg]; lt += __shfl_xor(lt, 16); lt += __shfl_xor(lt, 32); const float inv = 1.0f / lt;
#pragma unroll
                for (int dt = 0; dt < 8; ++dt) oscr[(rg * 8 + dt) * 512] = O1[rg][dt] * inv; }
        }
    }
#pragma unroll
    for (int rg = 0; rg < 2; ++rg)
#pragma unroll
        for (int dt = 0; dt < 8; ++dt) O0[rg][dt] = oscr[(rg * 8 + dt) * 512];
    const int fr = lane & 15, fq = lane >> 4;
    bf16* cat = (bf16*)(ws + WS_CAT);
#pragma unroll
    for (int rg = 0; rg < 2; ++rg) { float lt = l[rg]; lt += __shfl_xor(lt, 16); lt += __shfl_xor(lt, 32); const float sc = -lam / lt;
        float ss = 0.f;
#pragma unroll
        for (int dt = 0; dt < 8; ++dt) { const f32x4 o = O0[rg][dt] + O1[rg][dt] * sc; O0[rg][dt] = o; ss += (o[0] * o[0] + o[1] * o[1]) + (o[2] * o[2] + o[3] * o[3]); }
        ss += __shfl_xor(ss, 16); ss += __shfl_xor(ss, 32);
        const float rs = 0.8f / sqrtf(ss * (1.0f / 128.0f) + NORM_EPS);
        bf16* orow = cat + (size_t)(b * SEQ + q0 + 32 * wave + 16 * rg + fr) * D_MODEL + 2048 + h * 128 + 4 * fq;
#pragma unroll
        for (int dt = 0; dt < 8; ++dt) { const f32x4 g = *(const f32x4*)(A.subln_g + 16 * dt + 4 * fq); const f32x4 o = O0[rg][dt] * g * rs;
            v2u w; w.x = pk2(o[0], o[1]); w.y = pk2(o[2], o[3]); *(v2u*)(orow + 16 * dt) = w; } }
}
}

#define PG8_SP2 true
#define PG8_ALIGN true
__global__ void __launch_bounds__(NTHREADS, 2) hymba_fwd(Args A) {
    extern __shared__ __attribute__((aligned(16))) unsigned char lds_raw[];
    LAS unsigned char* lds = (LAS unsigned char*)lds_raw;
    const int tid = threadIdx.x, lane = tid & 63, wave = __builtin_amdgcn_readfirstlane(tid >> 6);
    const int G = gridDim.x, gw = blockIdx.x * NWAVES + wave, NGW = G * NWAVES;
    unsigned char* ws = A.ws;
    const int lo = A.ph_lo, hi = A.ph_hi;
#ifndef PHMASK
#define PHMASK 0xff
#endif
#define IN(k) (((PHMASK >> (k)) & 1) && lo <= (k) && (k) < hi)
#define SEAM(k) do { if (IN(k) && IN((k) + 1)) { cg::this_grid().sync(); } } while (0)

    if (IN(0)) { p0_prologue(A, lds, gw, NGW, wave, lane); }
    SEAM(0);
    if (IN(1)) {
        { pg8::Gemm g{(const bf16*)(ws + WS_XN), (const bf16*)(ws + WS_WIN), M_TOK, IN_COLS, D_MODEL}; pg8::StaticOrder S; S.init(M_TOK, IN_COLS, G, (int)blockIdx.x);
          pg8::EpiPlain E{(bf16*)(ws + WS_PROJ), IN_COLS};
          pg8::gemm_phase<pg8::EpiPlain, pg8::StaticOrder, PG8_ALIGN, PG8_SP2>(lds, g, S, E); }
        { pg8::Gemm g{(const bf16*)(ws + WS_PB), (const bf16*)(ws + WS_WPLE), M_TOK, D_MODEL, PLE_DIM}; pg8::StaticOrder S; S.init(M_TOK, D_MODEL, G, (int)blockIdx.x);
          pg8::EpiPle E{(bf16*)(ws + WS_PE), D_MODEL, (float*)(ws + WS_ROWSS_PLE)};
          pg8::gemm_phase<pg8::EpiPle, pg8::StaticOrder, PG8_ALIGN, PG8_SP2>(lds, g, S, E); }
    }
    SEAM(1);
    if (IN(2)) { p2_qknorm_rope(A, lds, gw, NGW, tid, lane); }
    SEAM(2);
    if (IN(3)) {
        const float s1 = wave_sum(A.lq1[lane] * A.lk1[lane]), s2 = wave_sum(A.lq2[lane] * A.lk2[lane]);
        const float lam = __expf(s1) - __expf(s2) + 0.2f;
#ifndef NO_DIFF
#pragma unroll 1
        for (int pr2 = 2 * blockIdx.x; pr2 < 512; pr2 += 2 * G)
#pragma unroll 1
            for (int k = 0; k < 2; ++k) { const int pr = pr2 >> 1, b = pr >> 6, h = (pr >> 2) & 15, pi = pr & 3;
                att::diff_unit(A, lds, b, h, k ? pi : 7 - pi, lam); }
#endif
#ifndef NO_SWA
#pragma unroll 1
        for (int un = blockIdx.x; un < 512; un += G) att::swa_unit(A, lds, un);
#endif
    }
    SEAM(3);
    if (IN(4)) {
        pg8::Gemm g{(const bf16*)(ws + WS_CAT), (const bf16*)(ws + WS_WO), M_TOK, D_MODEL, D_MODEL}; pg8::StaticOrder S; S.init(M_TOK, D_MODEL, G, (int)blockIdx.x);
        pg8::EpiRes E{A.x, A.out, (bf16*)(ws + WS_XN), D_MODEL, A.mlp_g, (float*)(ws + WS_ROWSS_MLP)};
        pg8::gemm_phase<pg8::EpiRes, pg8::StaticOrder, PG8_ALIGN, PG8_SP2>(lds, g, S, E);
    }
    SEAM(4);
    if (IN(5)) {
        pg8::Gemm g{(const bf16*)(ws + WS_XN), (const bf16*)(ws + WS_WUP), M_TOK, D_FF, D_MODEL}; pg8::StaticOrder S; S.init(M_TOK, D_FF, G, (int)blockIdx.x);
        pg8::EpiUp E{(bf16*)(ws + WS_U), D_FF, (const float*)(ws + WS_ROWSS_MLP), 1.0f / D_MODEL};
        pg8::gemm_phase<pg8::EpiUp, pg8::StaticOrder, PG8_ALIGN, PG8_SP2>(lds, g, S, E);
    }
    SEAM(5);
    if (IN(6)) {
        pg8::Gemm g{(const bf16*)(ws + WS_U), (const bf16*)(ws + WS_WDN), M_TOK, D_MODEL, D_FF}; pg8::StaticOrder S; S.init(M_TOK, D_MODEL, G, (int)blockIdx.x);
        pg8::EpiRes E{A.out, A.out, (bf16*)(ws + WS_XN), D_MODEL, nullptr, nullptr};
        pg8::gemm_phase<pg8::EpiRes, pg8::StaticOrder, PG8_ALIGN, PG8_SP2>(lds, g, S, E);
    }
    SEAM(6);
    if (IN(7)) {
        pg8::Gemm g{(const bf16*)(ws + WS_XN), (const bf16*)(ws + WS_WG), M_TOK, D_MODEL, D_MODEL}; pg8::StaticOrder S; S.init(M_TOK, D_MODEL, G, (int)blockIdx.x);
        pg8::EpiFinal E{A.out, (const bf16*)(ws + WS_PE), D_MODEL, (const float*)(ws + WS_ROWSS_PLE), A.ple_g, 1.0f / D_MODEL};
        pg8::gemm_phase<pg8::EpiFinal, pg8::StaticOrder, PG8_ALIGN, PG8_SP2>(lds, g, S, E);
    }
#undef IN
#undef SEAM
}

#ifndef MK_PER_PHASE
#define MK_PER_PHASE 0
#endif
extern "C" void kernel_launch(void* const* d_in, const int* in_sizes, int n_in, void* d_out, int out_size, void* d_ws, size_t ws_size, hipStream_t stream) {
    static int grid = 0;
    if (grid == 0) {
        if (n_in != 21 || in_sizes[0] != M_TOK * D_MODEL || out_size != M_TOK * D_MODEL || ws_size < WS_END) { fprintf(stderr, "kernel_launch: unexpected shapes (n_in %d, ws %zu); nothing launched\n", n_in, ws_size); grid = -1; return; }
        int dev = 0, cus = 0, per_cu = 0;
        if (hipGetDevice(&dev) != hipSuccess || hipDeviceGetAttribute(&cus, hipDeviceAttributeMultiprocessorCount, dev) != hipSuccess) { grid = -1; return; }
        if (hipFuncSetAttribute((const void*)hymba_fwd, hipFuncAttributeMaxDynamicSharedMemorySize, LDS_BYTES) != hipSuccess) { fprintf(stderr, "kernel_launch: hipFuncSetAttribute failed\n"); grid = -1; return; }
        if (hipOccupancyMaxActiveBlocksPerMultiprocessor(&per_cu, (const void*)hymba_fwd, NTHREADS, LDS_BYTES) != hipSuccess || per_cu < 1) { fprintf(stderr, "kernel_launch: occupancy query says %d\n", per_cu); per_cu = 1; }
        (void)hipGetLastError();
        grid = cus;
    }
    if (grid < 0) return;
    Args a{};
    const float** f = (const float**)&a;
    for (int i = 0; i < 21; ++i) f[i] = (const float*)d_in[i];
    a.out = (float*)d_out; a.ws = (unsigned char*)d_ws;
#if MK_PER_PHASE
    for (int ph = 0; ph < 8; ++ph) { a.ph_lo = ph; a.ph_hi = ph + 1; a.coop = 0; hipLaunchKernelGGL(hymba_fwd, dim3(grid), dim3(NTHREADS), LDS_BYTES, stream, a); }
#else
    a.ph_lo = 0; a.ph_hi = 8; a.coop = 1;
    void* args[] = {&a};
    hipError_t e = hipLaunchCooperativeKernel((const void*)hymba_fwd, dim3(grid), dim3(NTHREADS), args, LDS_BYTES, stream);
    if (e != hipSuccess) fprintf(stderr, "kernel_launch: cooperative launch failed: %s (grid %d)\n", hipGetErrorString(e), grid);
#endif
}
```

```cpp
#include <hip/hip_runtime.h>
#include <hip/hip_cooperative_groups.h>
#include <cstdio>
#include <cstdint>
namespace cg = cooperative_groups;
namespace pg8 {
#define PG8_LAS __attribute__((address_space(3)))
typedef unsigned short bf16_t;
typedef short bf16x8 __attribute__((ext_vector_type(8)));
typedef float f32x4 __attribute__((ext_vector_type(4)));
typedef unsigned u32x4 __attribute__((ext_vector_type(4)));
constexpr int BM = 256, BK = 64, HALF = 128, HTB = HALF * BK * 2  , STAGE_BYTES = 8 * HTB, NXCD = 8, WGM = 8;

__host__ __device__ __forceinline__ int lds_byte(int r, int c) { const int st = (r >> 4) * 2 + (c >> 5), rr = r & 15, cc = c & 31, ob = rr * 64 + cc * 2; return st * 1024 + (ob ^ (((ob >> 9) & 1) << 5)); }
__host__ __device__ __forceinline__ void stage_rc(int b, int& R, int& C) { const int st = b / 1024, sb = b % 1024, swz = sb ^ (((sb >> 9) & 1) << 5); R = (st >> 1) * 16 + swz / 64; C = (st & 1) * 32 + (swz % 64) / 2; }
__host__ __device__ __forceinline__ int perm32(int rho) { const int n = rho >> 4, i = rho & 15; return 8 * (i >> 2) + 4 * n + (i & 3); }

struct Unit { int pm, pn; };
struct Gemm { const bf16_t* A; const bf16_t* Bt; int M, N, K; };

struct StaticOrder {
    int nM, nN, nwg, G, c;
    __host__ __device__ void init(int M, int N, int G_, int c_) { nM = M / BM; nN = N / BM; nwg = nM * nN; G = G_; c = c_; }
    __host__ __device__ bool next(int i, Unit& u) const {
        const long L = (long)i * G + c; if (L >= nwg) return false;
        int wgid = (int)L; { const int q = nwg / NXCD, r = nwg % NXCD, xcd = wgid % NXCD, off = wgid / NXCD; wgid = (xcd < r ? xcd * (q + 1) : r * (q + 1) + (xcd - r) * q) + off; }
        const int nig = WGM * nN, gid = wgid / nig, fm = gid * WGM, gsz = (nM - fm) < WGM ? (nM - fm) : WGM;
        u.pm = fm + ((wgid % nig) % gsz); u.pn = (wgid % nig) / gsz; return true;
    }
    __device__ __forceinline__ void a_ready(const Unit&) const {}
    __device__ __forceinline__ void done(const Unit&) const {}
};

__device__ __forceinline__ unsigned cvt_pk_bf16(float lo, float hi) { unsigned r; asm volatile("v_cvt_pk_bf16_f32 %0, %1, %2" : "=v"(r) : "v"(lo), "v"(hi)); return r; }
typedef float f32x2 __attribute__((ext_vector_type(2)));
constexpr float RMS_EPS = 1e-6f;
__device__ __forceinline__ u32x4 pack8(const f32x4 v0, const f32x4 v1) { u32x4 w; w.x = cvt_pk_bf16(v0[0], v0[1]); w.y = cvt_pk_bf16(v0[2], v0[3]); w.z = cvt_pk_bf16(v1[0], v1[1]); w.w = cvt_pk_bf16(v1[2], v1[3]); return w; }
__device__ __forceinline__ float bf_lo(unsigned w) { return __uint_as_float(w << 16); }
__device__ __forceinline__ float bf_hi(unsigned w) { return __uint_as_float(w & 0xffff0000u); }

struct EpiPlain {
    static constexpr bool PERM = true, AFTER_DRAIN = false;
    bf16_t* O; int ldc;
    __device__ __forceinline__ void operator()(const f32x4 (&acc)[2][2][4][2], const Unit& u, int wr, int wc, int fr, int fq) const {
        const int row0 = u.pm * BM + wr * 64 + fr, col0 = u.pn * BM + wc * 32 + 8 * fq;
#pragma unroll
        for (int ai = 0; ai < 2; ++ai)
#pragma unroll
            for (int m = 0; m < 4; ++m) { bf16_t* rowp = O + (size_t)(row0 + ai * HALF + m * 16) * ldc + col0;
#pragma unroll
                for (int bj = 0; bj < 2; ++bj) *(u32x4*)(rowp + bj * HALF) = pack8(acc[ai][bj][m][0], acc[ai][bj][m][1]); }
    }
};
struct EpiPle {
    static constexpr bool PERM = true, AFTER_DRAIN = false;
    bf16_t* O; int ldc; float* rowss;
    __device__ __forceinline__ void operator()(const f32x4 (&acc)[2][2][4][2], const Unit& u, int wr, int wc, int fr, int fq) const {
        const int row0 = u.pm * BM + wr * 64 + fr, col0 = u.pn * BM + wc * 32 + 8 * fq;
#pragma unroll
        for (int ai = 0; ai < 2; ++ai)
#pragma unroll
            for (int m = 0; m < 4; ++m) { const int row = row0 + ai * HALF + m * 16; bf16_t* rowp = O + (size_t)row * ldc + col0; float ss = 0.f;
#pragma unroll
                for (int bj = 0; bj < 2; ++bj) { const f32x4 v0 = acc[ai][bj][m][0], v1 = acc[ai][bj][m][1];
                    ss += (v0[0] * v0[0] + v0[1] * v0[1]) + (v0[2] * v0[2] + v0[3] * v0[3]) + (v1[0] * v1[0] + v1[1] * v1[1]) + (v1[2] * v1[2] + v1[3] * v1[3]);
                    *(u32x4*)(rowp + bj * HALF) = pack8(v0, v1); }
                ss += __shfl_xor(ss, 16); ss += __shfl_xor(ss, 32);
                if (fq == 0) atomicAdd(rowss + row, ss); }
    }
};
struct EpiUp {
    static constexpr bool PERM = true, AFTER_DRAIN = false;
    bf16_t* O; int ldc; const float* rowss; float inv_nfeat;
    __device__ __forceinline__ void operator()(const f32x4 (&acc)[2][2][4][2], const Unit& u, int wr, int wc, int fr, int fq) const {
        const int row0 = u.pm * BM + wr * 64 + fr, col0 = u.pn * BM + wc * 32 + 8 * fq;
#pragma unroll
        for (int ai = 0; ai < 2; ++ai)
#pragma unroll
            for (int m = 0; m < 4; ++m) { const int row = row0 + ai * HALF + m * 16; bf16_t* rowp = O + (size_t)row * ldc + col0;
                const float r2 = 1.0f / (rowss[row] * inv_nfeat + RMS_EPS);
#pragma unroll
                for (int bj = 0; bj < 2; ++bj) { f32x4 v0 = acc[ai][bj][m][0], v1 = acc[ai][bj][m][1];
#pragma unroll
                    for (int e = 0; e < 4; ++e) { const float a = fmaxf(v0[e], 0.f), b = fmaxf(v1[e], 0.f); v0[e] = a * a * r2; v1[e] = b * b * r2; }
                    *(u32x4*)(rowp + bj * HALF) = pack8(v0, v1); } }
    }
};
struct EpiRes {
    static constexpr bool PERM = true, AFTER_DRAIN = false;
    const float* base; float* out; bf16_t* hb; int ldc; const float* gain; float* rowss;
    __device__ __forceinline__ void operator()(const f32x4 (&acc)[2][2][4][2], const Unit& u, int wr, int wc, int fr, int fq) const {
        const int row0 = u.pm * BM + wr * 64 + fr, col0 = u.pn * BM + wc * 32 + 8 * fq;
        f32x4 g[2][2];
#pragma unroll
        for (int bj = 0; bj < 2; ++bj)
#pragma unroll
            for (int n = 0; n < 2; ++n) g[bj][n] = gain ? *(const f32x4*)(gain + col0 + bj * HALF + 4 * n) : (f32x4){1.f, 1.f, 1.f, 1.f};
#pragma unroll
        for (int ai = 0; ai < 2; ++ai)
#pragma unroll
            for (int m = 0; m < 4; ++m) { const int row = row0 + ai * HALF + m * 16; const size_t off = (size_t)row * ldc + col0; float ss = 0.f;
#pragma unroll
                for (int bj = 0; bj < 2; ++bj) { const f32x4 b0 = *(const f32x4*)(base + off + bj * HALF), b1 = *(const f32x4*)(base + off + bj * HALF + 4);
                    const f32x4 v0 = acc[ai][bj][m][0] + b0, v1 = acc[ai][bj][m][1] + b1;
                    *(f32x4*)(out + off + bj * HALF) = v0; *(f32x4*)(out + off + bj * HALF + 4) = v1;
                    ss += (v0[0] * v0[0] + v0[1] * v0[1]) + (v0[2] * v0[2] + v0[3] * v0[3]) + (v1[0] * v1[0] + v1[1] * v1[1]) + (v1[2] * v1[2] + v1[3] * v1[3]);
                    *(u32x4*)(hb + off + bj * HALF) = pack8(v0 * g[bj][0], v1 * g[bj][1]); }
                if (rowss) { ss += __shfl_xor(ss, 16); ss += __shfl_xor(ss, 32); if (fq == 0) atomicAdd(rowss + row, ss); } }
    }
};
struct EpiFinal {
    static constexpr bool PERM = true, AFTER_DRAIN = false;
    float* out; const bf16_t* pe; int ldc; const float* rowss; const float* gple; float inv_nfeat;
    __device__ __forceinline__ void operator()(const f32x4 (&acc)[2][2][4][2], const Unit& u, int wr, int wc, int fr, int fq) const {
        const int row0 = u.pm * BM + wr * 64 + fr, col0 = u.pn * BM + wc * 32 + 8 * fq;
        f32x4 g[2][2];
#pragma unroll
        for (int bj = 0; bj < 2; ++bj)
#pragma unroll
            for (int n = 0; n < 2; ++n) g[bj][n] = *(const f32x4*)(gple + col0 + bj * HALF + 4 * n);
#pragma unroll
        for (int ai = 0; ai < 2; ++ai)
#pragma unroll
            for (int m = 0; m < 4; ++m) { const int row = row0 + ai * HALF + m * 16; const size_t off = (size_t)row * ldc + col0;
                const float rs = 1.0f / sqrtf(rowss[row] * inv_nfeat + RMS_EPS);
#pragma unroll
                for (int bj = 0; bj < 2; ++bj) { const f32x4 b0 = *(const f32x4*)(out + off + bj * HALF), b1 = *(const f32x4*)(out + off + bj * HALF + 4);
                    const u32x4 pw = *(const u32x4*)(pe + off + bj * HALF);
                    const f32x4 p0 = (f32x4){bf_lo(pw.x), bf_hi(pw.x), bf_lo(pw.y), bf_hi(pw.y)}, p1 = (f32x4){bf_lo(pw.z), bf_hi(pw.z), bf_lo(pw.w), bf_hi(pw.w)};
                    f32x4 v0 = acc[ai][bj][m][0], v1 = acc[ai][bj][m][1];
#pragma unroll
                    for (int e = 0; e < 4; ++e) { v0[e] = 1.0f / (1.0f + __expf(-v0[e])); v1[e] = 1.0f / (1.0f + __expf(-v1[e])); }
                    v0 = b0 + v0 * (p0 * g[bj][0]) * rs; v1 = b1 + v1 * (p1 * g[bj][1]) * rs;
                    *(f32x4*)(out + off + bj * HALF) = v0; *(f32x4*)(out + off + bj * HALF + 4) = v1; } }
    }
};
template <class Epi, class Sched, bool ALIGN_EPI = false, bool SP2 = false>
__device__ __forceinline__ void gemm_phase(PG8_LAS unsigned char* lds, const Gemm g, const Sched& S, const Epi& E) {
    const int tid = threadIdx.x, wid = __builtin_amdgcn_readfirstlane(tid >> 6), lane = tid & 63, wr = wid >> 2, wc = wid & 3, fr = lane & 15, fq = lane >> 4;
    const int K = g.K, nt = K / BK;
    unsigned voffA[2], voffB[2];
#pragma unroll
    for (int i = 0; i < 2; ++i) { int R, C; stage_rc(tid * 16 + i * 8192, R, C); const int Rb = Epi::PERM ? ((R & ~31) + perm32(R & 31)) : R;
        voffA[i] = (unsigned)(R * K + C) * 2u; voffB[i] = (unsigned)(Rb * K + C) * 2u; }
    const size_t kstep = (size_t)(BK * 2);
    const size_t hstep = (size_t)HALF * K * 2;
    const size_t tstep = 2 * hstep;
    const unsigned ldsw = (unsigned)wid * 1024u;
    const int aoff = lds_byte(wr * 64 + fr, fq * 8), boff = lds_byte(wc * 32 + fr, fq * 8);
#define PG8_SA(b, h) (((b) * 2 + (h)) * HTB)
#define PG8_SB(b, h) ((4 + (b) * 2 + (h)) * HTB)
#define PG8_STAGE(bufoff, gbase, voff) do { _Pragma("unroll") for (int _i = 0; _i < 2; ++_i) \
        __builtin_amdgcn_global_load_lds((const unsigned*)((const char*)(gbase) + (voff)[_i]), (PG8_LAS unsigned*)(lds + (bufoff) + ldsw + _i * 8192), 16, 0, 0); } while (0)
#define PG8_LDA(dst, b, h) do { _Pragma("unroll") for (int m = 0; m < 4; ++m) _Pragma("unroll") for (int k = 0; k < 2; ++k) dst[m][k] = *(const PG8_LAS bf16x8*)(lds + PG8_SA(b, h) + aoff + m * 2048 + k * 1024); } while (0)
#define PG8_LDB(dst, b, h) do { _Pragma("unroll") for (int n = 0; n < 2; ++n) _Pragma("unroll") for (int k = 0; k < 2; ++k) dst[n][k] = *(const PG8_LAS bf16x8*)(lds + PG8_SB(b, h) + boff + n * 2048 + k * 1024); } while (0)
#define PG8_MMA(ai, bj, At, Bt) do { __builtin_amdgcn_s_setprio(1); _Pragma("unroll") for (int m = 0; m < 4; ++m) _Pragma("unroll") for (int n = 0; n < 2; ++n) _Pragma("unroll") for (int k = 0; k < 2; ++k) \
        acc[ai][bj][m][n] = __builtin_amdgcn_mfma_f32_16x16x32_bf16(Bt[n][k], At[m][k], acc[ai][bj][m][n], 0, 0, 0); __builtin_amdgcn_s_setprio(0); } while (0)
#define PG8_WAIT_V(n) asm volatile("s_waitcnt vmcnt(" #n ")" ::: "memory")
#define PG8_WAIT_L(n) asm volatile("s_waitcnt lgkmcnt(" #n ")" ::: "memory")
#define PG8_BAR __builtin_amdgcn_s_barrier()
#define PG8_SCHED __builtin_amdgcn_sched_barrier(0)
    Unit cur, nxt; int ui = 0;
    if (!S.next(0, cur)) return;
    f32x4 acc[2][2][4][2];
#pragma unroll
    for (int a = 0; a < 2; ++a)
#pragma unroll
        for (int b = 0; b < 2; ++b)
#pragma unroll
            for (int m = 0; m < 4; ++m)
#pragma unroll
                for (int n = 0; n < 2; ++n) acc[a][b][m][n] = (f32x4){0.f, 0.f, 0.f, 0.f};
    bf16x8 At[4][2], B0[2][2], B1[2][2];
    const char* cA = (const char*)g.A + (size_t)cur.pm * tstep; const char* cB = (const char*)g.Bt + (size_t)cur.pn * tstep;
    S.a_ready(cur);
    if constexpr (SP2) {
        PG8_STAGE(PG8_SB(0, 0), cB, voffB); PG8_STAGE(PG8_SB(0, 1), cB + hstep, voffB); PG8_STAGE(PG8_SA(0, 0), cA, voffA); PG8_STAGE(PG8_SA(0, 1), cA + hstep, voffA);
        if (wr == 1) PG8_BAR;
        PG8_WAIT_V(2); PG8_BAR;
        PG8_STAGE(PG8_SB(1, 0), cB + kstep, voffB); PG8_STAGE(PG8_SA(1, 0), cA + kstep, voffA); PG8_STAGE(PG8_SB(1, 1), cB + hstep + kstep, voffB);
        PG8_WAIT_V(6); PG8_BAR;
    } else {
        PG8_STAGE(PG8_SB(0, 0), cB, voffB); PG8_STAGE(PG8_SA(0, 0), cA, voffA); PG8_STAGE(PG8_SB(0, 1), cB + hstep, voffB); PG8_STAGE(PG8_SA(0, 1), cA + hstep, voffA);
        if (wr == 1) PG8_BAR;
        PG8_WAIT_V(4); PG8_BAR;
        PG8_STAGE(PG8_SB(1, 0), cB + kstep, voffB); PG8_STAGE(PG8_SA(1, 0), cA + kstep, voffA); PG8_STAGE(PG8_SB(1, 1), cB + hstep + kstep, voffB);
        PG8_WAIT_V(6); PG8_BAR;
    }
    for (;;) {
        const bool has_next = S.next(ui + 1, nxt);
        const char* nA = has_next ? (const char*)g.A + (size_t)nxt.pm * tstep : cA; const char* nB = has_next ? (const char*)g.Bt + (size_t)nxt.pn * tstep : cB;
        for (int t = 0; t < nt; t += 2) {
            const bool last = (t == nt - 2);
            const char* a1 = cA + (size_t)(t + 1) * kstep;
            const char* a2 = last ? nA : cA + (size_t)(t + 2) * kstep; const char* b2 = last ? nB : cB + (size_t)(t + 2) * kstep;
            const char* a3 = a2 + kstep; const char* b3 = b2 + kstep;
            if (last && has_next) S.a_ready(nxt);
            if constexpr (SP2) {
            PG8_LDB(B0, 0, 0); PG8_LDB(B1, 0, 1); PG8_SCHED; PG8_LDA(At, 0, 0); PG8_STAGE(PG8_SA(1, 1), a1 + hstep, voffA);
            PG8_WAIT_V(8); PG8_WAIT_L(0); PG8_BAR; PG8_MMA(0, 0, At, B0); PG8_MMA(0, 1, At, B1); PG8_BAR; PG8_SCHED;
            PG8_LDA(At, 0, 1); PG8_STAGE(PG8_SB(0, 0), b2, voffB); PG8_STAGE(PG8_SB(0, 1), b2 + hstep, voffB); PG8_STAGE(PG8_SA(0, 0), a2, voffA);
            PG8_WAIT_V(8); PG8_WAIT_L(0); PG8_BAR; PG8_MMA(1, 0, At, B0); PG8_MMA(1, 1, At, B1); PG8_BAR; PG8_SCHED;
            PG8_LDB(B0, 1, 0); PG8_LDB(B1, 1, 1); PG8_SCHED; PG8_LDA(At, 1, 0); PG8_STAGE(PG8_SA(0, 1), a2 + hstep, voffA);
            PG8_WAIT_V(8); PG8_WAIT_L(0); PG8_BAR; PG8_MMA(0, 0, At, B0); PG8_MMA(0, 1, At, B1); PG8_BAR; PG8_SCHED;
            PG8_LDA(At, 1, 1); PG8_STAGE(PG8_SB(1, 0), b3, voffB); PG8_STAGE(PG8_SB(1, 1), b3 + hstep, voffB); PG8_STAGE(PG8_SA(1, 0), a3, voffA);
            PG8_WAIT_V(8); PG8_WAIT_L(0); PG8_BAR; PG8_MMA(1, 0, At, B0); PG8_MMA(1, 1, At, B1); PG8_BAR; PG8_SCHED;
            } else {
            PG8_LDB(B0, 0, 0); PG8_SCHED; PG8_LDA(At, 0, 0); PG8_STAGE(PG8_SA(1, 1), a1 + hstep, voffA);
            PG8_WAIT_L(8); PG8_BAR; PG8_WAIT_L(0); PG8_MMA(0, 0, At, B0); PG8_BAR; PG8_SCHED;
            PG8_LDB(B1, 0, 1); PG8_STAGE(PG8_SB(0, 0), b2, voffB);
            PG8_BAR; PG8_WAIT_L(0); PG8_MMA(0, 1, At, B1); PG8_BAR;
            PG8_LDA(At, 0, 1); PG8_STAGE(PG8_SA(0, 0), a2, voffA);
            PG8_BAR; PG8_WAIT_L(0); PG8_MMA(1, 0, At, B0); PG8_BAR; PG8_SCHED;
            PG8_STAGE(PG8_SB(0, 1), b2 + hstep, voffB);
            PG8_WAIT_V(6); PG8_BAR; PG8_MMA(1, 1, At, B1); PG8_BAR;
            PG8_LDB(B0, 1, 0); PG8_SCHED; PG8_LDA(At, 1, 0); PG8_STAGE(PG8_SA(0, 1), a2 + hstep, voffA);
            PG8_WAIT_L(8); PG8_BAR; PG8_WAIT_L(0); PG8_MMA(0, 0, At, B0); PG8_BAR; PG8_SCHED;
            PG8_LDB(B1, 1, 1); PG8_STAGE(PG8_SB(1, 0), b3, voffB);
            PG8_BAR; PG8_WAIT_L(0); PG8_MMA(0, 1, At, B1); PG8_BAR;
            PG8_LDA(At, 1, 1); PG8_STAGE(PG8_SA(1, 0), a3, voffA);
            PG8_BAR; PG8_WAIT_L(0); PG8_MMA(1, 0, At, B0); PG8_BAR; PG8_SCHED;
            PG8_STAGE(PG8_SB(1, 1), b3 + hstep, voffB);
            PG8_WAIT_V(6); PG8_BAR; PG8_MMA(1, 1, At, B1); PG8_BAR;
            }
        }
        if constexpr (ALIGN_EPI) { if (wr == 0) PG8_BAR; }
        if constexpr (!Epi::AFTER_DRAIN) { E(acc, cur, wr, wc, fr, fq); S.done(cur); }
        if (!has_next) break;
#pragma unroll
        for (int a = 0; a < 2; ++a)
#pragma unroll
            for (int b = 0; b < 2; ++b)
#pragma unroll
                for (int m = 0; m < 4; ++m)
#pragma unroll
                    for (int n = 0; n < 2; ++n) acc[a][b][m][n] = (f32x4){0.f, 0.f, 0.f, 0.f};
        cur = nxt; cA = nA; cB = nB; ++ui;
        if constexpr (ALIGN_EPI) { if (wr == 1) PG8_BAR; }
    }
    PG8_WAIT_V(0);
    if constexpr (!ALIGN_EPI) { if (wr == 0) PG8_BAR; }
    PG8_BAR;
    if constexpr (Epi::AFTER_DRAIN) { E.fused(acc, cur, wr, wc, fr, fq, lds, wid, lane); S.done(cur); }
#undef PG8_SA
#undef PG8_SB
#undef PG8_STAGE
#undef PG8_LDA
#undef PG8_LDB
#undef PG8_MMA
#undef PG8_WAIT_V
#undef PG8_WAIT_L
#undef PG8_BAR
#undef PG8_SCHED
}
}

constexpr int NWAVES = 8, NTHREADS = 512;
constexpr int D_MODEL = 4096, BATCH = 4, SEQ = 2048, M_TOK = BATCH * SEQ, IN_COLS = 9216, D_FF = 16384, PLE_DIM = 256;
constexpr int COL_QA = 0, COL_KA = 2048, COL_VA = 2560, COL_QB = 3072, COL_KB = 5120, COL_VB = 7168;
constexpr float NORM_EPS = 1e-6f;
constexpr float LOG2E = 1.4426950408889634f;
constexpr size_t MiB = 1u << 20;
constexpr size_t WS_CTL = 0;
constexpr size_t WS_ROWSS_MLP = 64 * 1024, WS_ROWSS_PLE = 128 * 1024;
constexpr size_t WS_TAB128 = 1 * MiB;
constexpr size_t WS_TAB64 = 2 * MiB;
constexpr size_t WS_WIN = 4 * MiB, WS_WO = 76 * MiB, WS_WUP = 108 * MiB, WS_WDN = 236 * MiB, WS_WG = 364 * MiB, WS_WPLE = 396 * MiB;
constexpr size_t WS_PB = 398 * MiB;
constexpr size_t WS_XN = 402 * MiB;
constexpr size_t WS_PE = 466 * MiB;
constexpr size_t WS_PROJ = 530 * MiB;
constexpr size_t WS_VTA = 674 * MiB, WS_VTB = 682 * MiB;
constexpr size_t WS_CAT = 714 * MiB;
constexpr size_t WS_U = 530 * MiB;
constexpr size_t WS_OSCR = 786 * MiB;
constexpr size_t WS_END = 818 * MiB;
constexpr int LDS_BYTES = 147456;

#define GAS __attribute__((address_space(1)))
#define LAS __attribute__((address_space(3)))
typedef unsigned short bf16;
typedef unsigned v4u __attribute__((ext_vector_type(4)));
typedef unsigned v2u __attribute__((ext_vector_type(2)));
typedef float f32x4 __attribute__((ext_vector_type(4)));
typedef float f32x2 __attribute__((ext_vector_type(2)));
typedef short bf16x8 __attribute__((ext_vector_type(8)));
#define LDS_WAIT() asm volatile("s_waitcnt lgkmcnt(0)" ::: "memory")

__device__ __forceinline__ unsigned pk2(float lo, float hi) { return pg8::cvt_pk_bf16(lo, hi); }
__device__ __forceinline__ float bflo(unsigned w) { return __uint_as_float(w << 16); }
__device__ __forceinline__ float bfhi(unsigned w) { return __uint_as_float(w & 0xffff0000u); }
__device__ __forceinline__ float wave_sum(float v) {
#pragma unroll
    for (int o = 1; o < 64; o <<= 1) v += __shfl_xor(v, o);
    return v;
}

struct Args {
    const float *x, *p, *attn_g, *w_in, *qa_g, *ka_g, *sinks, *qb_g, *kb_g, *lq1, *lk1, *lq2, *lk2, *subln_g, *w_o, *mlp_g, *w_up, *w_down, *w_ple, *ple_g, *w_gate;
    float* out; unsigned char* ws; int ph_lo, ph_hi, coop, pad;
};

__device__ __forceinline__ void p0_transpose_item(const float* W, int K, int N, bf16* WT, LAS float* scr, int item, int lane) {
    const int nblk = N / 64, kb = item / nblk, nb = item % nblk, k0 = 64 * kb, n0 = 64 * nb;
    const float* src = W + (size_t)k0 * N + n0 + lane;
#pragma unroll 16
    for (int kk = 0; kk < 64; ++kk) scr[kk * 65 + lane] = src[(size_t)kk * N];
    LDS_WAIT(); asm volatile("" ::: "memory");
    const int c = lane & 7;
#pragma unroll
    for (int j = 0; j < 8; ++j) { const int n = (lane >> 3) + 8 * j; const LAS float* s = scr + (8 * c) * 65 + n;
        v4u o; o.x = pk2(s[0 * 65], s[1 * 65]); o.y = pk2(s[2 * 65], s[3 * 65]); o.z = pk2(s[4 * 65], s[5 * 65]); o.w = pk2(s[6 * 65], s[7 * 65]);
        *(v4u*)(WT + (size_t)(n0 + n) * K + k0 + 8 * c) = o; }
    LDS_WAIT(); asm volatile("" ::: "memory");
}
__device__ __forceinline__ void p0_prologue(const Args& A, LAS unsigned char* lds, int gw, int NGW, int wave, int lane) {
    unsigned char* ws = A.ws;
    LAS float* scr = (LAS float*)(lds + wave * 16640);
    constexpr int I_IN = (D_MODEL / 64) * (IN_COLS / 64), I_O = (D_MODEL / 64) * (D_MODEL / 64), I_UP = (D_MODEL / 64) * (D_FF / 64), I_DN = I_UP, I_G = I_O, I_PLE = (PLE_DIM / 64) * (D_MODEL / 64);
    constexpr int NITEMS = I_IN + I_O + I_UP + I_DN + I_G + I_PLE;
    for (int it = gw; it < NITEMS; it += NGW) {
        int r = it;
        if (r < I_IN) { p0_transpose_item(A.w_in, D_MODEL, IN_COLS, (bf16*)(ws + WS_WIN), scr, r, lane); continue; } r -= I_IN;
        if (r < I_O) { p0_transpose_item(A.w_o, D_MODEL, D_MODEL, (bf16*)(ws + WS_WO), scr, r, lane); continue; } r -= I_O;
        if (r < I_UP) { p0_transpose_item(A.w_up, D_MODEL, D_FF, (bf16*)(ws + WS_WUP), scr, r, lane); continue; } r -= I_UP;
        if (r < I_DN) { p0_transpose_item(A.w_down, D_FF, D_MODEL, (bf16*)(ws + WS_WDN), scr, r, lane); continue; } r -= I_DN;
        if (r < I_G) { p0_transpose_item(A.w_gate, D_MODEL, D_MODEL, (bf16*)(ws + WS_WG), scr, r, lane); continue; } r -= I_G;
        p0_transpose_item(A.w_ple, PLE_DIM, D_MODEL, (bf16*)(ws + WS_WPLE), scr, r, lane);
    }
    for (int m = gw; m < M_TOK; m += NGW) {
        const f32x4* xr = (const f32x4*)(A.x + (size_t)m * D_MODEL) + lane;
        f32x4 v[16]; float s = 0.f;
#pragma unroll
        for (int j = 0; j < 16; ++j) { v[j] = xr[64 * j]; s += (v[j].x * v[j].x + v[j].y * v[j].y) + (v[j].z * v[j].z + v[j].w * v[j].w); }
        const float rstd = 1.0f / sqrtf(wave_sum(s) * (1.0f / D_MODEL) + NORM_EPS);
        v2u* o8 = (v2u*)((bf16*)(ws + WS_XN) + (size_t)m * D_MODEL) + lane;
        const f32x4* gr = (const f32x4*)A.attn_g + lane;
#pragma unroll
        for (int j = 0; j < 16; ++j) { const f32x4 g = gr[64 * j]; v2u o; o.x = pk2(v[j].x * rstd * g.x, v[j].y * rstd * g.y); o.y = pk2(v[j].z * rstd * g.z, v[j].w * rstd * g.w); o8[64 * j] = o; }
    }
    { const int gt = gw * 64 + lane, NGT = NGW * 64;
      for (int i = gt; i < M_TOK * PLE_DIM / 8; i += NGT) { const f32x4 a = ((const f32x4*)A.p)[2 * i], b = ((const f32x4*)A.p)[2 * i + 1];
          v4u o; o.x = pk2(a.x, a.y); o.y = pk2(a.z, a.w); o.z = pk2(b.x, b.y); o.w = pk2(b.z, b.w); ((v4u*)(ws + WS_PB))[i] = o; }
      for (int i = gt; i < SEQ * 64; i += NGT) { const int pos = i >> 6, j = i & 63;
          const float inv = __builtin_amdgcn_exp2f(-(float)(2 * j) * (1.0f / 128.0f) * 13.287712379549449f); const float ang = (float)pos * inv;
          double xr = (double)ang * 0.15915494309189535; xr -= __builtin_rint(xr); const float fx = (float)xr;
          ((f32x2*)(ws + WS_TAB128))[i] = (f32x2){__builtin_amdgcn_cosf(fx), __builtin_amdgcn_sinf(fx)}; }
      for (int i = gt; i < SEQ * 32; i += NGT) { const int pos = i >> 5, j = i & 31;
          const float inv = __builtin_amdgcn_exp2f(-(float)(2 * j) * (1.0f / 64.0f) * 13.287712379549449f); const float ang = (float)pos * inv;
          double xr = (double)ang * 0.15915494309189535; xr -= __builtin_rint(xr); const float fx = (float)xr;
          ((f32x2*)(ws + WS_TAB64))[i] = (f32x2){__builtin_amdgcn_cosf(fx), __builtin_amdgcn_sinf(fx)}; }
      for (int i = gt; i < M_TOK; i += NGT) { ((float*)(ws + WS_ROWSS_MLP))[i] = 0.f; ((float*)(ws + WS_ROWSS_PLE))[i] = 0.f; }
    }
}

__device__ __forceinline__ void p2_qknorm_rope(const Args& A, LAS unsigned char* lds, int gw, int NGW, int tid, int lane) {
    unsigned char* ws = A.ws; bf16* proj = (bf16*)(ws + WS_PROJ);
    const f32x2* tab128 = (const f32x2*)(ws + WS_TAB128); const f32x2* tab64 = (const f32x2*)(ws + WS_TAB64);
    const float qs128 = 0.08838834764831845f * LOG2E, qs64 = 0.125f * LOG2E;
    for (int row = gw; row < M_TOK; row += NGW) {
        const int pos = row & (SEQ - 1); bf16* prow = proj + (size_t)row * IN_COLS;
#pragma unroll 1
        for (int it = 0; it < 5; ++it) { const int ch = it * 64 + lane, col = ch * 8, i = ch & 15; const bool isq = col < COL_KA;
            const v4u w = *(const v4u*)(prow + col);
            float x[8] = {bflo(w.x), bfhi(w.x), bflo(w.y), bfhi(w.y), bflo(w.z), bfhi(w.z), bflo(w.w), bfhi(w.w)};
            float ss = 0.f;
#pragma unroll
            for (int e = 0; e < 8; ++e) ss += x[e] * x[e];
            ss += __shfl_xor(ss, 1); ss += __shfl_xor(ss, 2); ss += __shfl_xor(ss, 4); ss += __shfl_xor(ss, 8);
            const float rstd = 1.0f / sqrtf(ss * (1.0f / 128.0f) + NORM_EPS);
            const float* gp = (isq ? A.qa_g : A.ka_g) + i * 8; const f32x4 g0 = *(const f32x4*)gp, g1 = *(const f32x4*)(gp + 4);
            const float g[8] = {g0.x, g0.y, g0.z, g0.w, g1.x, g1.y, g1.z, g1.w};
            const f32x2* tb = tab128 + pos * 64 + (i & 7) * 8; const float sgn = (i < 8) ? -1.f : 1.f, sc = isq ? qs128 : 1.f;
            float o[8];
#pragma unroll
            for (int e = 0; e < 8; ++e) { const float y = x[e] * rstd * g[e]; const float py = __shfl_xor(y, 8); const f32x2 cs = tb[e]; o[e] = (y * cs.x + sgn * py * cs.y) * sc; }
            v4u ow; ow.x = pk2(o[0], o[1]); ow.y = pk2(o[2], o[3]); ow.z = pk2(o[4], o[5]); ow.w = pk2(o[6], o[7]);
            *(v4u*)(prow + col) = ow; }
#pragma unroll 1
        for (int it = 0; it < 8; ++it) { const int ch = it * 64 + lane, col = COL_QB + ch * 8, i = ch & 7; const bool isq = ch < 256;
            const v4u w = *(const v4u*)(prow + col);
            float x[8] = {bflo(w.x), bfhi(w.x), bflo(w.y), bfhi(w.y), bflo(w.z), bfhi(w.z), bflo(w.w), bfhi(w.w)};
            float ss = 0.f;
#pragma unroll
            for (int e = 0; e < 8; ++e) ss += x[e] * x[e];
            ss += __shfl_xor(ss, 1); ss += __shfl_xor(ss, 2); ss += __shfl_xor(ss, 4);
            const float rstd = 1.0f / sqrtf(ss * (1.0f / 64.0f) + NORM_EPS);
            const float* gp = (isq ? A.qb_g : A.kb_g) + i * 8; const f32x4 g0 = *(const f32x4*)gp, g1 = *(const f32x4*)(gp + 4);
            const float g[8] = {g0.x, g0.y, g0.z, g0.w, g1.x, g1.y, g1.z, g1.w};
            const f32x2* tb = tab64 + pos * 32 + (i & 3) * 8; const float sgn = (i < 4) ? -1.f : 1.f, sc = isq ? qs64 : 1.f;
            float o[8];
#pragma unroll
            for (int e = 0; e < 8; ++e) { const float y = x[e] * rstd * g[e]; const float py = __shfl_xor(y, 4); const f32x2 cs = tb[e]; o[e] = (y * cs.x + sgn * py * cs.y) * sc; }
            v4u ow; ow.x = pk2(o[0], o[1]); ow.y = pk2(o[2], o[3]); ow.z = pk2(o[4], o[5]); ow.w = pk2(o[6], o[7]);
            *(v4u*)(prow + col) = ow; }
    }
    LAS bf16* T = (LAS bf16*)lds;
    for (int tile = blockIdx.x; tile < (M_TOK / 64) * 20; tile += gridDim.x) {
        const int tb = tile / 20, hd = tile % 20, b = tb / (SEQ / 64), s0 = (tb % (SEQ / 64)) * 64;
        const int vcol = hd < 4 ? COL_VA + hd * 128 : COL_VB + (hd - 4) * 128;
        bf16* dst = hd < 4 ? (bf16*)(ws + WS_VTA) + (size_t)(b * 4 + hd) * 128 * SEQ : (bf16*)(ws + WS_VTB) + (size_t)(b * 16 + (hd - 4)) * 128 * SEQ;
#pragma unroll
        for (int k = 0; k < 2; ++k) { const int ci = tid + 512 * k, tok = ci >> 4, dc = ci & 15;
            const v4u w = *(const v4u*)(proj + (size_t)(tb * 64 + tok) * IN_COLS + vcol + dc * 8);
            LAS bf16* t = T + (dc * 8) * 72 + tok;
            t[0 * 72] = (bf16)(w.x & 0xffff); t[1 * 72] = (bf16)(w.x >> 16); t[2 * 72] = (bf16)(w.y & 0xffff); t[3 * 72] = (bf16)(w.y >> 16);
            t[4 * 72] = (bf16)(w.z & 0xffff); t[5 * 72] = (bf16)(w.z >> 16); t[6 * 72] = (bf16)(w.w & 0xffff); t[7 * 72] = (bf16)(w.w >> 16); }
        __syncthreads();
#pragma unroll
        for (int k = 0; k < 2; ++k) { const int ci = tid + 512 * k, d = ci >> 3, tc = ci & 7;
            const v4u w = *(const LAS v4u*)(T + d * 72 + tc * 8);
            *(v4u*)(dst + (size_t)d * SEQ + s0 + tc * 8) = w; }
        __syncthreads();
    }
}

namespace att {
constexpr int BUF_BYTES = 32768, K_OFF = 0, V_OFF = 16384;
constexpr float NEG = -1e30f;
__device__ __forceinline__ int swz(int rr, int fq) { const int ob = rr * 64 + fq * 16; return ob ^ (((ob >> 9) & 1) << 5); }

template <int DK> struct Stage { v4u k[DK / 64]; v4u v[2]; };

template <int DK>
__device__ __forceinline__ void stage_load(Stage<DK>& st, const bf16* Kb, int ldk, const bf16* Vt, int kt0, int tid) {
#pragma unroll
    for (int k = 0; k < DK / 64; ++k) { const int ci = tid + 512 * k, kl = ci / (DK / 8), c8 = ci % (DK / 8); st.k[k] = *(const v4u*)(Kb + (size_t)(kt0 + kl) * ldk + c8 * 8); }
#pragma unroll
    for (int k = 0; k < 2; ++k) { const int ci = tid + 512 * k, d = ci >> 3, kc = ci & 7; st.v[k] = *(const v4u*)(Vt + (size_t)d * SEQ + kt0 + kc * 8); }
}
template <int DK>
__device__ __forceinline__ void stage_write(const Stage<DK>& st, LAS unsigned char* buf, int tid) {
#pragma unroll
    for (int k = 0; k < DK / 64; ++k) { const int ci = tid + 512 * k, kl = ci / (DK / 8), c8 = ci % (DK / 8);
        const int u = kl >> 5, g = (kl >> 3) & 3, e = (kl >> 2) & 1, i = kl & 3, t = 2 * u + e, rr = 4 * g + i, c = c8 >> 2, fq = c8 & 3;
        *(LAS v4u*)(buf + K_OFF + (t * (DK / 32) + c) * 1024 + swz(rr, fq)) = st.k[k]; }
#pragma unroll
    for (int k = 0; k < 2; ++k) { const int ci = tid + 512 * k, d = ci >> 3, kc = ci & 7; const int dt = d >> 4, rr = d & 15, u = kc >> 2, fq = kc & 3;
        *(LAS v4u*)(buf + V_OFF + (dt * 2 + u) * 1024 + swz(rr, fq)) = st.v[k]; }
}

template <int DK, bool SWA>
__device__ __forceinline__ void pass(LAS unsigned char* lds, const bf16* Q, int ldq, const bf16* Kb, int ldk, const bf16* Vt, int q0, int jt_lo, int jt_hi,
                                     float (&mrow)[2], float (&lrow)[2], f32x4 (&O)[2][8], int tid, int wave, int lane) {
    const int fr = lane & 15, fq = lane >> 4, qw = q0 + 32 * wave;
    bf16x8 qf[2][DK / 32];
#pragma unroll
    for (int rg = 0; rg < 2; ++rg)
#pragma unroll
        for (int c = 0; c < DK / 32; ++c) qf[rg][c] = *(const bf16x8*)(Q + (size_t)(qw + 16 * rg + fr) * ldq + 32 * c + 8 * fq);
    const int fro = swz(fr, fq);
    Stage<DK> st;
    stage_load<DK>(st, Kb, ldk, Vt, jt_lo * 64, tid);
    stage_write<DK>(st, lds, tid);
    __syncthreads();
    for (int jt = jt_lo; jt <= jt_hi; ++jt) {
        LAS unsigned char* buf = lds + ((jt - jt_lo) & 1) * BUF_BYTES;
        if (jt < jt_hi) stage_load<DK>(st, Kb, ldk, Vt, (jt + 1) * 64, tid);
        const int kt0 = jt * 64;
        bool need = kt0 <= qw + 31; if (SWA) need = need && (kt0 + 63 >= qw - 127);
        if (need) {
            f32x4 s[2][4];
#pragma unroll
            for (int t = 0; t < 4; ++t) {
#pragma unroll
                for (int rg = 0; rg < 2; ++rg) s[rg][t] = (f32x4){0.f, 0.f, 0.f, 0.f};
#pragma unroll
                for (int c = 0; c < DK / 32; ++c) { const bf16x8 kf = *(const LAS bf16x8*)(buf + K_OFF + (t * (DK / 32) + c) * 1024 + fro);
#pragma unroll
                    for (int rg = 0; rg < 2; ++rg) s[rg][t] = __builtin_amdgcn_mfma_f32_16x16x32_bf16(kf, qf[rg][c], s[rg][t], 0, 0, 0); }
                if (t & 1) __builtin_amdgcn_sched_barrier(0);
            }
            const bool domask = SWA || (kt0 + 63 > qw);
            if (domask) {
#pragma unroll
                for (int rg = 0; rg < 2; ++rg) { const int q = qw + 16 * rg + fr;
#pragma unroll
                    for (int t = 0; t < 4; ++t)
#pragma unroll
                        for (int i = 0; i < 4; ++i) { const int key = kt0 + 32 * (t >> 1) + 8 * fq + 4 * (t & 1) + i;
                            bool ok = key <= q; if (SWA) ok = ok && (q - key < 128);
                            s[rg][t][i] = ok ? s[rg][t][i] : NEG; } }
            }
            bf16x8 pf[2][2];
#pragma unroll
            for (int rg = 0; rg < 2; ++rg) {
                float mx = NEG;
#pragma unroll
                for (int t = 0; t < 4; ++t) mx = fmaxf(mx, fmaxf(fmaxf(s[rg][t][0], s[rg][t][1]), fmaxf(s[rg][t][2], s[rg][t][3])));
                mx = fmaxf(mx, __shfl_xor(mx, 16)); mx = fmaxf(mx, __shfl_xor(mx, 32));
                const float mnew = fmaxf(mrow[rg], mx), alpha = __builtin_amdgcn_exp2f(mrow[rg] - mnew); mrow[rg] = mnew;
                float ps = 0.f;
#pragma unroll
                for (int t = 0; t < 4; ++t)
#pragma unroll
                    for (int i = 0; i < 4; ++i) { const float p = __builtin_amdgcn_exp2f(s[rg][t][i] - mnew); s[rg][t][i] = p; ps += p; }
                lrow[rg] = lrow[rg] * alpha + ps;
#pragma unroll
                for (int dt = 0; dt < 8; ++dt) O[rg][dt] = O[rg][dt] * alpha;
#pragma unroll
                for (int u = 0; u < 2; ++u) { v4u w; w.x = pk2(s[rg][2 * u][0], s[rg][2 * u][1]); w.y = pk2(s[rg][2 * u][2], s[rg][2 * u][3]);
                    w.z = pk2(s[rg][2 * u + 1][0], s[rg][2 * u + 1][1]); w.w = pk2(s[rg][2 * u + 1][2], s[rg][2 * u + 1][3]); pf[rg][u] = __builtin_bit_cast(bf16x8, w); }
            }
#pragma unroll
            for (int dt = 0; dt < 8; ++dt)
#pragma unroll
                for (int u = 0; u < 2; ++u) { const bf16x8 vf = *(const LAS bf16x8*)(buf + V_OFF + (dt * 2 + u) * 1024 + fro);
#pragma unroll
                    for (int rg = 0; rg < 2; ++rg) O[rg][dt] = __builtin_amdgcn_mfma_f32_16x16x32_bf16(vf, pf[rg][u], O[rg][dt], 0, 0, 0);
                    if (u == 1 && (dt & 1)) __builtin_amdgcn_sched_barrier(0); }
        }
        if (jt < jt_hi) stage_write<DK>(st, lds + (((jt - jt_lo) & 1) ^ 1) * BUF_BYTES, tid);
        __syncthreads();
    }
}

__device__ __forceinline__ void init_state(float (&m)[2], float (&l)[2], f32x4 (&O)[2][8]) {
#pragma unroll
    for (int rg = 0; rg < 2; ++rg) { m[rg] = NEG; l[rg] = 0.f;
#pragma unroll
        for (int dt = 0; dt < 8; ++dt) O[rg][dt] = (f32x4){0.f, 0.f, 0.f, 0.f}; }
}

__device__ __forceinline__ void swa_unit(const Args& A, LAS unsigned char* lds, int unit) {
    const int tid = threadIdx.x, lane = tid & 63, wave = __builtin_amdgcn_readfirstlane(tid >> 6);
    unsigned char* ws = A.ws; const bf16* proj = (const bf16*)(ws + WS_PROJ);
    const int qb = unit & 7, hq = (unit >> 3) & 15, b = unit >> 7, kvh = hq >> 2, q0 = qb * 256;
    const bf16* Q = proj + (size_t)b * SEQ * IN_COLS + COL_QA + hq * 128;
    const bf16* Kb = proj + (size_t)b * SEQ * IN_COLS + COL_KA + kvh * 128;
    const bf16* Vt = (const bf16*)(ws + WS_VTA) + (size_t)(b * 4 + kvh) * 128 * SEQ;
    float m[2], l[2]; f32x4 O[2][8]; init_state(m, l, O);
    const int jt_lo = (4 * qb - 2) > 0 ? 4 * qb - 2 : 0, jt_hi = 4 * qb + 3;
    pass<128, true>(lds, Q, IN_COLS, Kb, IN_COLS, Vt, q0, jt_lo, jt_hi, m, l, O, tid, wave, lane);
    const int fr = lane & 15, fq = lane >> 4; const float sink2 = A.sinks[hq] * LOG2E;
    bf16* cat = (bf16*)(ws + WS_CAT);
#pragma unroll
    for (int rg = 0; rg < 2; ++rg) { float lt = l[rg]; lt += __shfl_xor(lt, 16); lt += __shfl_xor(lt, 32);
        lt += __builtin_amdgcn_exp2f(sink2 - m[rg]); const float inv = 1.0f / lt;
        bf16* orow = cat + (size_t)(b * SEQ + q0 + 32 * wave + 16 * rg + fr) * D_MODEL + hq * 128 + 4 * fq;
#pragma unroll
        for (int dt = 0; dt < 8; ++dt) { const f32x4 o = O[rg][dt] * inv; v2u w; w.x = pk2(o[0], o[1]); w.y = pk2(o[2], o[3]); *(v2u*)(orow + 16 * dt) = w; } }
}
__device__ __forceinline__ void diff_unit(const Args& A, LAS unsigned char* lds, int b, int h, int qb, float lam) {
    const int tid = threadIdx.x, lane = tid & 63, wave = __builtin_amdgcn_readfirstlane(tid >> 6);
    unsigned char* ws = A.ws; const bf16* proj = (const bf16*)(ws + WS_PROJ);
    const int q0 = qb * 256; const size_t boff = (size_t)b * SEQ * IN_COLS;
    const bf16* Vt = (const bf16*)(ws + WS_VTB) + (size_t)(b * 16 + h) * 128 * SEQ;
    const int jt_hi = 4 * qb + 3;
    float m[2], l[2]; f32x4 O1[2][8], O0[2][8];
    f32x4* oscr = (f32x4*)(ws + WS_OSCR) + (size_t)blockIdx.x * 16 * 512 + tid;
#pragma unroll 1
    for (int mp = 0; mp < 2; ++mp) {
        init_state(m, l, O1);
        pass<64, false>(lds, proj + boff + COL_QB + mp * 1024 + h * 64, IN_COLS, proj + boff + COL_KB + mp * 1024 + h * 64, IN_COLS, Vt, q0, 0, jt_hi, m, l, O1, tid, wave, lane);
        if (mp == 0) {
#pragma unroll
            for (int rg = 0; rg < 2; ++rg) { float lt = l[rg]; lt += __shfl_xor(lt, 16); lt += __shfl_xor(lt, 32); const float inv = 1.0f / lt;
#pragma unroll
                for (int dt = 0; dt < 8; ++dt) oscr[(rg * 8 + dt) * 512] = O1[rg][dt] * inv; }
        }
    }
#pragma unroll
    for (int rg = 0; rg < 2; ++rg)
#pragma unroll
        for (int dt = 0; dt < 8; ++dt) O0[rg][dt] = oscr[(rg * 8 + dt) * 512];
    const int fr = lane & 15, fq = lane >> 4;
    bf16* cat = (bf16*)(ws + WS_CAT);
#pragma unroll
    for (int rg = 0; rg < 2; ++rg) { float lt = l[rg]; lt += __shfl_xor(lt, 16); lt += __shfl_xor(lt, 32); const float sc = -lam / lt;
        float ss = 0.f;
#pragma unroll
        for (int dt = 0; dt < 8; ++dt) { const f32x4 o = O0[rg][dt] + O1[rg][dt] * sc; O0[rg][dt] = o; ss += (o[0] * o[0] + o[1] * o[1]) + (o[2] * o[2] + o[3] * o[3]); }
        ss += __shfl_xor(ss, 16); ss += __shfl_xor(ss, 32);
        const float rs = 0.8f / sqrtf(ss * (1.0f / 128.0f) + NORM_EPS);
        bf16* orow = cat + (size_t)(b * SEQ + q0 + 32 * wave + 16 * rg + fr) * D_MODEL + 2048 + h * 128 + 4 * fq;
#pragma unroll
        for (int dt = 0; dt < 8; ++dt) { const f32x4 g = *(const f32x4*)(A.subln_g + 16 * dt + 4 * fq); const f32x4 o = O0[rg][dt] * g * rs;
            v2u w; w.x = pk2(o[0], o[1]); w.y = pk2(o[2], o[3]); *(v2u*)(orow + 16 * dt) = w; } }
}
}

#define RLX_AGENT __ATOMIC_RELAXED, __HIP_MEMORY_SCOPE_AGENT
#define XB_TMO      128
#define XB_XCNT(j)  (256  + 64 * (j))
#define XB_XSUB(j)  (1280 + 64 * (j))
#define XB_XGEN(j)  (2304 + 64 * (j))
#define XB_TOP      3328
#define XB_TOPGEN   3392
#define XCD_BAR_WORDS 3456
#define XB_SPIN_CAP (1u << 18)

__device__ __forceinline__ unsigned xb_ld(unsigned* p)              { return __hip_atomic_load(p, __ATOMIC_RELAXED, __HIP_MEMORY_SCOPE_AGENT); }
__device__ __forceinline__ unsigned xb_add(unsigned* p, unsigned v) { return __hip_atomic_fetch_add(p, v, __ATOMIC_RELAXED, __HIP_MEMORY_SCOPE_AGENT); }
__device__ __forceinline__ unsigned xb_xcc_id() { return (unsigned)__builtin_amdgcn_s_getreg((3 << 11) | 20) & 0xFu; }
#define XB_SPIN(cond, bar) do { unsigned _sp = 0; while (cond) { __builtin_amdgcn_s_sleep(1); \
    if ((++_sp & 255u) == 0u) { if (xb_ld(&(bar)[XB_TMO])) break; if (_sp > XB_SPIN_CAP) { atomicAdd(&(bar)[XB_TMO], 1u); break; } } } } while (0)

struct XcdBarrier {
    unsigned* bar; unsigned x;
    volatile LAS unsigned* st;
};

__device__ __forceinline__ XcdBarrier xcd_barrier_post(unsigned* bar, volatile LAS unsigned* st) {
    XcdBarrier b; b.bar = bar; b.x = xb_xcc_id(); b.st = st;
    if (threadIdx.x == 0) (void)xb_add(&bar[XB_XCNT(b.x)], 1u);
    return b;
}
__device__ __forceinline__ void xcd_barrier_complete(unsigned* bar, unsigned x, unsigned& nloc, unsigned& nx) {
    const unsigned G = gridDim.x * gridDim.y * gridDim.z;
    unsigned sum, cnt, mine, sp = 0u;
    for (;;) {
        sum = 0u; cnt = 0u; mine = 0u;
#pragma unroll
        for (unsigned j = 0; j < 16; ++j) { const unsigned c = xb_ld(&bar[XB_XCNT(j)]); sum += c; cnt += (c > 0u) ? 1u : 0u; mine = (j == x) ? c : mine; }
        if (sum == G) break;
        __builtin_amdgcn_s_sleep(1);
        if ((++sp & 255u) == 0u) { if (xb_ld(&bar[XB_TMO])) break; if (sp > XB_SPIN_CAP) { atomicAdd(&bar[XB_TMO], 1u); break; } }
    }
    nloc = mine > 0u ? mine : 1u; nx = cnt > 0u ? cnt : 1u;
}

__device__ __forceinline__ void xcd_barrier(const XcdBarrier& b) {
    asm volatile("s_waitcnt vmcnt(0)" ::: "memory");
    __syncthreads();
    if (threadIdx.x == 0) {
        unsigned* bar = b.bar;
        __builtin_amdgcn_s_waitcnt(0);
        unsigned nloc = b.st[0], nx = b.st[1];
        if (nloc == 0u) { xcd_barrier_complete(bar, b.x, nloc, nx); b.st[0] = nloc; b.st[1] = nx; }
        const unsigned old = xb_add(&bar[XB_XSUB(b.x)], 1u);
        const unsigned gen = old / nloc;
        if (old + 1u == (gen + 1u) * nloc) {
            __builtin_amdgcn_fence(__ATOMIC_RELEASE, "agent");
            asm volatile("s_waitcnt vmcnt(0)" ::: "memory");
            const unsigned og = xb_add(&bar[XB_TOP], 1u);
            const unsigned tg = og / nx;
            if (og + 1u == (tg + 1u) * nx) xb_add(&bar[XB_TOPGEN], 1u);
            else XB_SPIN(xb_ld(&bar[XB_TOPGEN]) == tg, bar);
            __builtin_amdgcn_fence(__ATOMIC_ACQUIRE, "agent");
            xb_add(&bar[XB_XGEN(b.x)], 1u);
            asm volatile("s_waitcnt vmcnt(0)" ::: "memory");
        } else {
            XB_SPIN(xb_ld(&bar[XB_XGEN(b.x)]) == gen, bar);
            __builtin_amdgcn_fence(__ATOMIC_ACQUIRE, "agent");
            asm volatile("s_waitcnt vmcnt(0)" ::: "memory");
        }
    }
    __syncthreads();
}

#define PG8_SP2 true
#define PG8_ALIGN true
__global__ void __launch_bounds__(NTHREADS, 2) hymba_fwd(Args A) {
    extern __shared__ __attribute__((aligned(16))) unsigned char lds_raw[];
    LAS unsigned char* lds = (LAS unsigned char*)lds_raw;
    const int tid = threadIdx.x, lane = tid & 63, wave = __builtin_amdgcn_readfirstlane(tid >> 6);
    const int G = gridDim.x, gw = blockIdx.x * NWAVES + wave, NGW = G * NWAVES;
    unsigned char* ws = A.ws;
    const int lo = A.ph_lo, hi = A.ph_hi;
#ifndef PHMASK
#define PHMASK 0xff
#endif
#define IN(k) (((PHMASK >> (k)) & 1) && lo <= (k) && (k) < hi)
#define SEAM(k) do { if (IN(k) && IN((k) + 1)) { if ((k) == 0) cg::this_grid().sync(); else xcd_barrier(bar); } } while (0)
    volatile LAS unsigned* MISC = (volatile LAS unsigned*)(lds + LDS_BYTES - 64);
    if (tid < 16) MISC[tid] = 0u;
    __syncthreads();
    XcdBarrier bar; bar.bar = (unsigned*)(ws + WS_CTL); bar.x = 0; bar.st = nullptr;
    if (A.coop) bar = xcd_barrier_post((unsigned*)(ws + WS_CTL), MISC);

#ifndef REP0
#define REP0 1
#endif
#ifndef REP3
#define REP3 1
#endif
#ifndef REP5
#define REP5 1
#endif
    if (IN(0)) { for (int rep = 0; rep < REP0; ++rep) p0_prologue(A, lds, gw, NGW, wave, lane); }
    SEAM(0);
    if (IN(1)) {
        { pg8::Gemm g{(const bf16*)(ws + WS_XN), (const bf16*)(ws + WS_WIN), M_TOK, IN_COLS, D_MODEL}; pg8::StaticOrder S; S.init(M_TOK, IN_COLS, G, (int)blockIdx.x);
          pg8::EpiPlain E{(bf16*)(ws + WS_PROJ), IN_COLS};
          pg8::gemm_phase<pg8::EpiPlain, pg8::StaticOrder, PG8_ALIGN, PG8_SP2>(lds, g, S, E); }
        { pg8::Gemm g{(const bf16*)(ws + WS_PB), (const bf16*)(ws + WS_WPLE), M_TOK, D_MODEL, PLE_DIM}; pg8::StaticOrder S; S.init(M_TOK, D_MODEL, G, (int)blockIdx.x);
          pg8::EpiPle E{(bf16*)(ws + WS_PE), D_MODEL, (float*)(ws + WS_ROWSS_PLE)};
          pg8::gemm_phase<pg8::EpiPle, pg8::StaticOrder, PG8_ALIGN, PG8_SP2>(lds, g, S, E); }
    }
    SEAM(1);
    if (IN(2)) { p2_qknorm_rope(A, lds, gw, NGW, tid, lane); }
    SEAM(2);
    if (IN(3)) {
        const float s1 = wave_sum(A.lq1[lane] * A.lk1[lane]), s2 = wave_sum(A.lq2[lane] * A.lk2[lane]);
        const float lam = __expf(s1) - __expf(s2) + 0.2f;
        for (int rep = 0; rep < REP3; ++rep) {
#ifndef NO_DIFF
#pragma unroll 1
        for (int pr2 = 2 * blockIdx.x; pr2 < 512; pr2 += 2 * G)
#pragma unroll 1
            for (int k = 0; k < 2; ++k) { const int pr = pr2 >> 1, b = pr >> 6, h = (pr >> 2) & 15, pi = pr & 3;
                att::diff_unit(A, lds, b, h, k ? pi : 7 - pi, lam); }
#endif
#ifndef NO_SWA
#pragma unroll 1
        for (int un = blockIdx.x; un < 512; un += G) att::swa_unit(A, lds, un);
#endif
        }
    }
    SEAM(3);
    if (IN(4)) {
        pg8::Gemm g{(const bf16*)(ws + WS_CAT), (const bf16*)(ws + WS_WO), M_TOK, D_MODEL, D_MODEL}; pg8::StaticOrder S; S.init(M_TOK, D_MODEL, G, (int)blockIdx.x);
        pg8::EpiRes E{A.x, A.out, (bf16*)(ws + WS_XN), D_MODEL, A.mlp_g, (float*)(ws + WS_ROWSS_MLP)};
        pg8::gemm_phase<pg8::EpiRes, pg8::StaticOrder, PG8_ALIGN, PG8_SP2>(lds, g, S, E);
    }
    SEAM(4);
    if (IN(5)) {
        pg8::Gemm g{(const bf16*)(ws + WS_XN), (const bf16*)(ws + WS_WUP), M_TOK, D_FF, D_MODEL}; pg8::StaticOrder S; S.init(M_TOK, D_FF, G, (int)blockIdx.x);
        pg8::EpiUp E{(bf16*)(ws + WS_U), D_FF, (const float*)(ws + WS_ROWSS_MLP), 1.0f / D_MODEL};
        for (int rep = 0; rep < REP5; ++rep) pg8::gemm_phase<pg8::EpiUp, pg8::StaticOrder, PG8_ALIGN, PG8_SP2>(lds, g, S, E);
    }
    SEAM(5);
    if (IN(6)) {
        pg8::Gemm g{(const bf16*)(ws + WS_U), (const bf16*)(ws + WS_WDN), M_TOK, D_MODEL, D_FF}; pg8::StaticOrder S; S.init(M_TOK, D_MODEL, G, (int)blockIdx.x);
        pg8::EpiRes E{A.out, A.out, (bf16*)(ws + WS_XN), D_MODEL, nullptr, nullptr};
        pg8::gemm_phase<pg8::EpiRes, pg8::StaticOrder, PG8_ALIGN, PG8_SP2>(lds, g, S, E);
    }
    SEAM(6);
    if (IN(7)) {
        pg8::Gemm g{(const bf16*)(ws + WS_XN), (const bf16*)(ws + WS_WG), M_TOK, D_MODEL, D_MODEL}; pg8::StaticOrder S; S.init(M_TOK, D_MODEL, G, (int)blockIdx.x);
        pg8::EpiFinal E{A.out, (const bf16*)(ws + WS_PE), D_MODEL, (const float*)(ws + WS_ROWSS_PLE), A.ple_g, 1.0f / D_MODEL};
        pg8::gemm_phase<pg8::EpiFinal, pg8::StaticOrder, PG8_ALIGN, PG8_SP2>(lds, g, S, E);
    }
#undef IN
#undef SEAM
}

#ifndef MK_PER_PHASE
#define MK_PER_PHASE 0
#endif
extern "C" void kernel_launch(void* const* d_in, const int* in_sizes, int n_in, void* d_out, int out_size, void* d_ws, size_t ws_size, hipStream_t stream) {
    static int grid = 0;
    if (grid == 0) {
        if (n_in != 21 || in_sizes[0] != M_TOK * D_MODEL || out_size != M_TOK * D_MODEL || ws_size < WS_END) { fprintf(stderr, "kernel_launch: unexpected shapes (n_in %d, ws %zu); nothing launched\n", n_in, ws_size); grid = -1; return; }
        int dev = 0, cus = 0, per_cu = 0;
        if (hipGetDevice(&dev) != hipSuccess || hipDeviceGetAttribute(&cus, hipDeviceAttributeMultiprocessorCount, dev) != hipSuccess) { grid = -1; return; }
        if (hipFuncSetAttribute((const void*)hymba_fwd, hipFuncAttributeMaxDynamicSharedMemorySize, LDS_BYTES) != hipSuccess) { fprintf(stderr, "kernel_launch: hipFuncSetAttribute failed\n"); grid = -1; return; }
        if (hipOccupancyMaxActiveBlocksPerMultiprocessor(&per_cu, (const void*)hymba_fwd, NTHREADS, LDS_BYTES) != hipSuccess || per_cu < 1) { fprintf(stderr, "kernel_launch: occupancy query says %d\n", per_cu); per_cu = 1; }
        (void)hipGetLastError();
        grid = cus;
    }
    if (grid < 0) return;
    if (hipMemsetAsync((char*)d_ws + WS_CTL, 0, 16384, stream) != hipSuccess) { fprintf(stderr, "kernel_launch: memset failed\n"); return; }
    Args a{};
    const float** f = (const float**)&a;
    for (int i = 0; i < 21; ++i) f[i] = (const float*)d_in[i];
    a.out = (float*)d_out; a.ws = (unsigned char*)d_ws;
#if MK_PER_PHASE
    for (int ph = 0; ph < 8; ++ph) { a.ph_lo = ph; a.ph_hi = ph + 1; a.coop = 0; hipLaunchKernelGGL(hymba_fwd, dim3(grid), dim3(NTHREADS), LDS_BYTES, stream, a); }
#else
    a.ph_lo = 0; a.ph_hi = 8; a.coop = 1;
    void* args[] = {&a};
    hipError_t e = hipLaunchCooperativeKernel((const void*)hymba_fwd, dim3(grid), dim3(NTHREADS), args, LDS_BYTES, stream);
    if (e != hipSuccess) fprintf(stderr, "kernel_launch: cooperative launch failed: %s (grid %d)\n", hipGetErrorString(e), grid);
#endif
}
```

```cpp
#include <hip/hip_runtime.h>
#include <hip/hip_cooperative_groups.h>
#include <cstdio>
#include <cstdint>
namespace cg = cooperative_groups;
namespace pg8 {
#define PG8_LAS __attribute__((address_space(3)))
typedef unsigned short bf16_t;
typedef short bf16x8 __attribute__((ext_vector_type(8)));
typedef float f32x4 __attribute__((ext_vector_type(4)));
typedef unsigned u32x4 __attribute__((ext_vector_type(4)));
constexpr int BM = 256, BK = 64, HALF = 128, HTB = HALF * BK * 2  , STAGE_BYTES = 8 * HTB, NXCD = 8, WGM = 8;

__host__ __device__ __forceinline__ int lds_byte(int r, int c) { const int st = (r >> 4) * 2 + (c >> 5), rr = r & 15, cc = c & 31, ob = rr * 64 + cc * 2; return st * 1024 + (ob ^ (((ob >> 9) & 1) << 5)); }
__host__ __device__ __forceinline__ void stage_rc(int b, int& R, int& C) { const int st = b / 1024, sb = b % 1024, swz = sb ^ (((sb >> 9) & 1) << 5); R = (st >> 1) * 16 + swz / 64; C = (st & 1) * 32 + (swz % 64) / 2; }
__host__ __device__ __forceinline__ int perm32(int rho) { const int n = rho >> 4, i = rho & 15; return 8 * (i >> 2) + 4 * n + (i & 3); }

struct Unit { int pm, pn; };
struct Gemm { const bf16_t* A; const bf16_t* Bt; int M, N, K; };

struct StaticOrder {
    int nM, nN, nwg, G, c;
    __host__ __device__ void init(int M, int N, int G_, int c_) { nM = M / BM; nN = N / BM; nwg = nM * nN; G = G_; c = c_; }
    __host__ __device__ bool next(int i, Unit& u) const {
        const long L = (long)i * G + c; if (L >= nwg) return false;
        int wgid = (int)L; { const int q = nwg / NXCD, r = nwg % NXCD, xcd = wgid % NXCD, off = wgid / NXCD; wgid = (xcd < r ? xcd * (q + 1) : r * (q + 1) + (xcd - r) * q) + off; }
        const int nig = WGM * nN, gid = wgid / nig, fm = gid * WGM, gsz = (nM - fm) < WGM ? (nM - fm) : WGM;
        u.pm = fm + ((wgid % nig) % gsz); u.pn = (wgid % nig) / gsz; return true;
    }
    __device__ __forceinline__ void a_ready(const Unit&) const {}
    __device__ __forceinline__ void done(const Unit&) const {}
};

__device__ __forceinline__ unsigned cvt_pk_bf16(float lo, float hi) { unsigned r; asm volatile("v_cvt_pk_bf16_f32 %0, %1, %2" : "=v"(r) : "v"(lo), "v"(hi)); return r; }
typedef float f32x2 __attribute__((ext_vector_type(2)));
constexpr float RMS_EPS = 1e-6f;
__device__ __forceinline__ u32x4 pack8(const f32x4 v0, const f32x4 v1) { u32x4 w; w.x = cvt_pk_bf16(v0[0], v0[1]); w.y = cvt_pk_bf16(v0[2], v0[3]); w.z = cvt_pk_bf16(v1[0], v1[1]); w.w = cvt_pk_bf16(v1[2], v1[3]); return w; }
__device__ __forceinline__ float bf_lo(unsigned w) { return __uint_as_float(w << 16); }
__device__ __forceinline__ float bf_hi(unsigned w) { return __uint_as_float(w & 0xffff0000u); }

struct EpiPlain {
    static constexpr bool PERM = true, AFTER_DRAIN = false;
    bf16_t* O; int ldc;
    __device__ __forceinline__ void operator()(const f32x4 (&acc)[2][2][4][2], const Unit& u, int wr, int wc, int fr, int fq) const {
        const int row0 = u.pm * BM + wr * 64 + fr, col0 = u.pn * BM + wc * 32 + 8 * fq;
#pragma unroll
        for (int ai = 0; ai < 2; ++ai)
#pragma unroll
            for (int m = 0; m < 4; ++m) { bf16_t* rowp = O + (size_t)(row0 + ai * HALF + m * 16) * ldc + col0;
#pragma unroll
                for (int bj = 0; bj < 2; ++bj) *(u32x4*)(rowp + bj * HALF) = pack8(acc[ai][bj][m][0], acc[ai][bj][m][1]); }
    }
};
struct EpiPle {
    static constexpr bool PERM = true, AFTER_DRAIN = false;
    bf16_t* O; int ldc; float* rowss;
    __device__ __forceinline__ void operator()(const f32x4 (&acc)[2][2][4][2], const Unit& u, int wr, int wc, int fr, int fq) const {
        const int row0 = u.pm * BM + wr * 64 + fr, col0 = u.pn * BM + wc * 32 + 8 * fq;
#pragma unroll
        for (int ai = 0; ai < 2; ++ai)
#pragma unroll
            for (int m = 0; m < 4; ++m) { const int row = row0 + ai * HALF + m * 16; bf16_t* rowp = O + (size_t)row * ldc + col0; float ss = 0.f;
#pragma unroll
                for (int bj = 0; bj < 2; ++bj) { const f32x4 v0 = acc[ai][bj][m][0], v1 = acc[ai][bj][m][1];
                    ss += (v0[0] * v0[0] + v0[1] * v0[1]) + (v0[2] * v0[2] + v0[3] * v0[3]) + (v1[0] * v1[0] + v1[1] * v1[1]) + (v1[2] * v1[2] + v1[3] * v1[3]);
                    *(u32x4*)(rowp + bj * HALF) = pack8(v0, v1); }
                ss += __shfl_xor(ss, 16); ss += __shfl_xor(ss, 32);
                if (fq == 0) atomicAdd(rowss + row, ss); }
    }
};
struct EpiUp {
    static constexpr bool PERM = true, AFTER_DRAIN = false;
    bf16_t* O; int ldc; const float* rowss; float inv_nfeat;
    __device__ __forceinline__ void operator()(const f32x4 (&acc)[2][2][4][2], const Unit& u, int wr, int wc, int fr, int fq) const {
        const int row0 = u.pm * BM + wr * 64 + fr, col0 = u.pn * BM + wc * 32 + 8 * fq;
#pragma unroll
        for (int ai = 0; ai < 2; ++ai)
#pragma unroll
            for (int m = 0; m < 4; ++m) { const int row = row0 + ai * HALF + m * 16; bf16_t* rowp = O + (size_t)row * ldc + col0;
                const float r2 = 1.0f / (rowss[row] * inv_nfeat + RMS_EPS);
#pragma unroll
                for (int bj = 0; bj < 2; ++bj) { f32x4 v0 = acc[ai][bj][m][0], v1 = acc[ai][bj][m][1];
#pragma unroll
                    for (int e = 0; e < 4; ++e) { const float a = fmaxf(v0[e], 0.f), b = fmaxf(v1[e], 0.f); v0[e] = a * a * r2; v1[e] = b * b * r2; }
                    *(u32x4*)(rowp + bj * HALF) = pack8(v0, v1); } }
    }
};
struct EpiRes {
    static constexpr bool PERM = true, AFTER_DRAIN = false;
    const float* base; float* out; bf16_t* hb; int ldc; const float* gain; float* rowss;
    __device__ __forceinline__ void operator()(const f32x4 (&acc)[2][2][4][2], const Unit& u, int wr, int wc, int fr, int fq) const {
        const int row0 = u.pm * BM + wr * 64 + fr, col0 = u.pn * BM + wc * 32 + 8 * fq;
        f32x4 g[2][2];
#pragma unroll
        for (int bj = 0; bj < 2; ++bj)
#pragma unroll
            for (int n = 0; n < 2; ++n) g[bj][n] = gain ? *(const f32x4*)(gain + col0 + bj * HALF + 4 * n) : (f32x4){1.f, 1.f, 1.f, 1.f};
#pragma unroll
        for (int ai = 0; ai < 2; ++ai)
#pragma unroll
            for (int m = 0; m < 4; ++m) { const int row = row0 + ai * HALF + m * 16; const size_t off = (size_t)row * ldc + col0; float ss = 0.f;
#pragma unroll
                for (int bj = 0; bj < 2; ++bj) { const f32x4 b0 = *(const f32x4*)(base + off + bj * HALF), b1 = *(const f32x4*)(base + off + bj * HALF + 4);
                    const f32x4 v0 = acc[ai][bj][m][0] + b0, v1 = acc[ai][bj][m][1] + b1;
                    *(f32x4*)(out + off + bj * HALF) = v0; *(f32x4*)(out + off + bj * HALF + 4) = v1;
                    ss += (v0[0] * v0[0] + v0[1] * v0[1]) + (v0[2] * v0[2] + v0[3] * v0[3]) + (v1[0] * v1[0] + v1[1] * v1[1]) + (v1[2] * v1[2] + v1[3] * v1[3]);
                    *(u32x4*)(hb + off + bj * HALF) = pack8(v0 * g[bj][0], v1 * g[bj][1]); }
                if (rowss) { ss += __shfl_xor(ss, 16); ss += __shfl_xor(ss, 32); if (fq == 0) atomicAdd(rowss + row, ss); } }
    }
};
struct EpiFinal {
    static constexpr bool PERM = true, AFTER_DRAIN = false;
    float* out; const bf16_t* pe; int ldc; const float* rowss; const float* gple; float inv_nfeat;
    __device__ __forceinline__ void operator()(const f32x4 (&acc)[2][2][4][2], const Unit& u, int wr, int wc, int fr, int fq) const {
        const int row0 = u.pm * BM + wr * 64 + fr, col0 = u.pn * BM + wc * 32 + 8 * fq;
        f32x4 g[2][2];
#pragma unroll
        for (int bj = 0; bj < 2; ++bj)
#pragma unroll
            for (int n = 0; n < 2; ++n) g[bj][n] = *(const f32x4*)(gple + col0 + bj * HALF + 4 * n);
#pragma unroll
        for (int ai = 0; ai < 2; ++ai)
#pragma unroll
            for (int m = 0; m < 4; ++m) { const int row = row0 + ai * HALF + m * 16; const size_t off = (size_t)row * ldc + col0;
                const float rs = 1.0f / sqrtf(rowss[row] * inv_nfeat + RMS_EPS);
#pragma unroll
                for (int bj = 0; bj < 2; ++bj) { const f32x4 b0 = *(const f32x4*)(out + off + bj * HALF), b1 = *(const f32x4*)(out + off + bj * HALF + 4);
                    const u32x4 pw = *(const u32x4*)(pe + off + bj * HALF);
                    const f32x4 p0 = (f32x4){bf_lo(pw.x), bf_hi(pw.x), bf_lo(pw.y), bf_hi(pw.y)}, p1 = (f32x4){bf_lo(pw.z), bf_hi(pw.z), bf_lo(pw.w), bf_hi(pw.w)};
                    f32x4 v0 = acc[ai][bj][m][0], v1 = acc[ai][bj][m][1];
#pragma unroll
                    for (int e = 0; e < 4; ++e) { v0[e] = 1.0f / (1.0f + __expf(-v0[e])); v1[e] = 1.0f / (1.0f + __expf(-v1[e])); }
                    v0 = b0 + v0 * (p0 * g[bj][0]) * rs; v1 = b1 + v1 * (p1 * g[bj][1]) * rs;
                    *(f32x4*)(out + off + bj * HALF) = v0; *(f32x4*)(out + off + bj * HALF + 4) = v1; } }
    }
};
template <class Epi, class Sched, bool ALIGN_EPI = false, bool SP2 = false>
__device__ __forceinline__ void gemm_phase(PG8_LAS unsigned char* lds, const Gemm g, const Sched& S, const Epi& E) {
    const int tid = threadIdx.x, wid = __builtin_amdgcn_readfirstlane(tid >> 6), lane = tid & 63, wr = wid >> 2, wc = wid & 3, fr = lane & 15, fq = lane >> 4;
    const int K = g.K, nt = K / BK;
    unsigned voffA[2], voffB[2];
#pragma unroll
    for (int i = 0; i < 2; ++i) { int R, C; stage_rc(tid * 16 + i * 8192, R, C); const int Rb = Epi::PERM ? ((R & ~31) + perm32(R & 31)) : R;
        voffA[i] = (unsigned)(R * K + C) * 2u; voffB[i] = (unsigned)(Rb * K + C) * 2u; }
    const size_t kstep = (size_t)(BK * 2);
    const size_t hstep = (size_t)HALF * K * 2;
    const size_t tstep = 2 * hstep;
    const unsigned ldsw = (unsigned)wid * 1024u;
    const int aoff = lds_byte(wr * 64 + fr, fq * 8), boff = lds_byte(wc * 32 + fr, fq * 8);
#define PG8_SA(b, h) (((b) * 2 + (h)) * HTB)
#define PG8_SB(b, h) ((4 + (b) * 2 + (h)) * HTB)
#define PG8_STAGE(bufoff, gbase, voff) do { _Pragma("unroll") for (int _i = 0; _i < 2; ++_i) \
        __builtin_amdgcn_global_load_lds((const unsigned*)((const char*)(gbase) + (voff)[_i]), (PG8_LAS unsigned*)(lds + (bufoff) + ldsw + _i * 8192), 16, 0, 0); } while (0)
#define PG8_LDA(dst, b, h) do { _Pragma("unroll") for (int m = 0; m < 4; ++m) _Pragma("unroll") for (int k = 0; k < 2; ++k) dst[m][k] = *(const PG8_LAS bf16x8*)(lds + PG8_SA(b, h) + aoff + m * 2048 + k * 1024); } while (0)
#define PG8_LDB(dst, b, h) do { _Pragma("unroll") for (int n = 0; n < 2; ++n) _Pragma("unroll") for (int k = 0; k < 2; ++k) dst[n][k] = *(const PG8_LAS bf16x8*)(lds + PG8_SB(b, h) + boff + n * 2048 + k * 1024); } while (0)
#define PG8_MMA(ai, bj, At, Bt) do { __builtin_amdgcn_s_setprio(1); _Pragma("unroll") for (int m = 0; m < 4; ++m) _Pragma("unroll") for (int n = 0; n < 2; ++n) _Pragma("unroll") for (int k = 0; k < 2; ++k) \
        acc[ai][bj][m][n] = __builtin_amdgcn_mfma_f32_16x16x32_bf16(Bt[n][k], At[m][k], acc[ai][bj][m][n], 0, 0, 0); __builtin_amdgcn_s_setprio(0); } while (0)
#define PG8_WAIT_V(n) asm volatile("s_waitcnt vmcnt(" #n ")" ::: "memory")
#define PG8_WAIT_L(n) asm volatile("s_waitcnt lgkmcnt(" #n ")" ::: "memory")
#define PG8_BAR __builtin_amdgcn_s_barrier()
#define PG8_SCHED __builtin_amdgcn_sched_barrier(0)
    Unit cur, nxt; int ui = 0;
    if (!S.next(0, cur)) return;
    f32x4 acc[2][2][4][2];
#pragma unroll
    for (int a = 0; a < 2; ++a)
#pragma unroll
        for (int b = 0; b < 2; ++b)
#pragma unroll
            for (int m = 0; m < 4; ++m)
#pragma unroll
                for (int n = 0; n < 2; ++n) acc[a][b][m][n] = (f32x4){0.f, 0.f, 0.f, 0.f};
    bf16x8 At[4][2], B0[2][2], B1[2][2];
    const char* cA = (const char*)g.A + (size_t)cur.pm * tstep; const char* cB = (const char*)g.Bt + (size_t)cur.pn * tstep;
    S.a_ready(cur);
    if constexpr (SP2) {
        PG8_STAGE(PG8_SB(0, 0), cB, voffB); PG8_STAGE(PG8_SB(0, 1), cB + hstep, voffB); PG8_STAGE(PG8_SA(0, 0), cA, voffA); PG8_STAGE(PG8_SA(0, 1), cA + hstep, voffA);
        if (wr == 1) PG8_BAR;
        PG8_WAIT_V(2); PG8_BAR;
        PG8_STAGE(PG8_SB(1, 0), cB + kstep, voffB); PG8_STAGE(PG8_SA(1, 0), cA + kstep, voffA); PG8_STAGE(PG8_SB(1, 1), cB + hstep + kstep, voffB);
        PG8_WAIT_V(6); PG8_BAR;
    } else {
        PG8_STAGE(PG8_SB(0, 0), cB, voffB); PG8_STAGE(PG8_SA(0, 0), cA, voffA); PG8_STAGE(PG8_SB(0, 1), cB + hstep, voffB); PG8_STAGE(PG8_SA(0, 1), cA + hstep, voffA);
        if (wr == 1) PG8_BAR;
        PG8_WAIT_V(4); PG8_BAR;
        PG8_STAGE(PG8_SB(1, 0), cB + kstep, voffB); PG8_STAGE(PG8_SA(1, 0), cA + kstep, voffA); PG8_STAGE(PG8_SB(1, 1), cB + hstep + kstep, voffB);
        PG8_WAIT_V(6); PG8_BAR;
    }
    for (;;) {
        const bool has_next = S.next(ui + 1, nxt);
        const char* nA = has_next ? (const char*)g.A + (size_t)nxt.pm * tstep : cA; const char* nB = has_next ? (const char*)g.Bt + (size_t)nxt.pn * tstep : cB;
        for (int t = 0; t < nt; t += 2) {
            const bool last = (t == nt - 2);
            const char* a1 = cA + (size_t)(t + 1) * kstep;
            const char* a2 = last ? nA : cA + (size_t)(t + 2) * kstep; const char* b2 = last ? nB : cB + (size_t)(t + 2) * kstep;
            const char* a3 = a2 + kstep; const char* b3 = b2 + kstep;
            if (last && has_next) S.a_ready(nxt);
            if constexpr (SP2) {
            PG8_LDB(B0, 0, 0); PG8_LDB(B1, 0, 1); PG8_SCHED; PG8_LDA(At, 0, 0); PG8_STAGE(PG8_SA(1, 1), a1 + hstep, voffA);
            PG8_WAIT_V(8); PG8_WAIT_L(0); PG8_BAR; PG8_MMA(0, 0, At, B0); PG8_MMA(0, 1, At, B1); PG8_BAR; PG8_SCHED;
            PG8_LDA(At, 0, 1); PG8_STAGE(PG8_SB(0, 0), b2, voffB); PG8_STAGE(PG8_SB(0, 1), b2 + hstep, voffB); PG8_STAGE(PG8_SA(0, 0), a2, voffA);
            PG8_WAIT_V(8); PG8_WAIT_L(0); PG8_BAR; PG8_MMA(1, 0, At, B0); PG8_MMA(1, 1, At, B1); PG8_BAR; PG8_SCHED;
            PG8_LDB(B0, 1, 0); PG8_LDB(B1, 1, 1); PG8_SCHED; PG8_LDA(At, 1, 0); PG8_STAGE(PG8_SA(0, 1), a2 + hstep, voffA);
            PG8_WAIT_V(8); PG8_WAIT_L(0); PG8_BAR; PG8_MMA(0, 0, At, B0); PG8_MMA(0, 1, At, B1); PG8_BAR; PG8_SCHED;
            PG8_LDA(At, 1, 1); PG8_STAGE(PG8_SB(1, 0), b3, voffB); PG8_STAGE(PG8_SB(1, 1), b3 + hstep, voffB); PG8_STAGE(PG8_SA(1, 0), a3, voffA);
            PG8_WAIT_V(8); PG8_WAIT_L(0); PG8_BAR; PG8_MMA(1, 0, At, B0); PG8_MMA(1, 1, At, B1); PG8_BAR; PG8_SCHED;
            } else {
            PG8_LDB(B0, 0, 0); PG8_SCHED; PG8_LDA(At, 0, 0); PG8_STAGE(PG8_SA(1, 1), a1 + hstep, voffA);
            PG8_WAIT_L(8); PG8_BAR; PG8_WAIT_L(0); PG8_MMA(0, 0, At, B0); PG8_BAR; PG8_SCHED;
            PG8_LDB(B1, 0, 1); PG8_STAGE(PG8_SB(0, 0), b2, voffB);
            PG8_BAR; PG8_WAIT_L(0); PG8_MMA(0, 1, At, B1); PG8_BAR;
            PG8_LDA(At, 0, 1); PG8_STAGE(PG8_SA(0, 0), a2, voffA);
            PG8_BAR; PG8_WAIT_L(0); PG8_MMA(1, 0, At, B0); PG8_BAR; PG8_SCHED;
            PG8_STAGE(PG8_SB(0, 1), b2 + hstep, voffB);
            PG8_WAIT_V(6); PG8_BAR; PG8_MMA(1, 1, At, B1); PG8_BAR;
            PG8_LDB(B0, 1, 0); PG8_SCHED; PG8_LDA(At, 1, 0); PG8_STAGE(PG8_SA(0, 1), a2 + hstep, voffA);
            PG8_WAIT_L(8); PG8_BAR; PG8_WAIT_L(0); PG8_MMA(0, 0, At, B0); PG8_BAR; PG8_SCHED;
            PG8_LDB(B1, 1, 1); PG8_STAGE(PG8_SB(1, 0), b3, voffB);
            PG8_BAR; PG8_WAIT_L(0); PG8_MMA(0, 1, At, B1); PG8_BAR;
            PG8_LDA(At, 1, 1); PG8_STAGE(PG8_SA(1, 0), a3, voffA);
            PG8_BAR; PG8_WAIT_L(0); PG8_MMA(1, 0, At, B0); PG8_BAR; PG8_SCHED;
            PG8_STAGE(PG8_SB(1, 1), b3 + hstep, voffB);
            PG8_WAIT_V(6); PG8_BAR; PG8_MMA(1, 1, At, B1); PG8_BAR;
            }
        }
        if constexpr (ALIGN_EPI) { if (wr == 0) PG8_BAR; }
        if constexpr (!Epi::AFTER_DRAIN) { E(acc, cur, wr, wc, fr, fq); S.done(cur); }
        if (!has_next) break;
#pragma unroll
        for (int a = 0; a < 2; ++a)
#pragma unroll
            for (int b = 0; b < 2; ++b)
#pragma unroll
                for (int m = 0; m < 4; ++m)
#pragma unroll
                    for (int n = 0; n < 2; ++n) acc[a][b][m][n] = (f32x4){0.f, 0.f, 0.f, 0.f};
        cur = nxt; cA = nA; cB = nB; ++ui;
        if constexpr (ALIGN_EPI) { if (wr == 1) PG8_BAR; }
    }
    PG8_WAIT_V(0);
    if constexpr (!ALIGN_EPI) { if (wr == 0) PG8_BAR; }
    PG8_BAR;
    if constexpr (Epi::AFTER_DRAIN) { E.fused(acc, cur, wr, wc, fr, fq, lds, wid, lane); S.done(cur); }
#undef PG8_SA
#undef PG8_SB
#undef PG8_STAGE
#undef PG8_LDA
#undef PG8_LDB
#undef PG8_MMA
#undef PG8_WAIT_V
#undef PG8_WAIT_L
#undef PG8_BAR
#undef PG8_SCHED
}
}

constexpr int NWAVES = 8, NTHREADS = 512;
constexpr int D_MODEL = 4096, BATCH = 4, SEQ = 2048, M_TOK = BATCH * SEQ, IN_COLS = 9216, D_FF = 16384, PLE_DIM = 256;
constexpr int COL_QA = 0, COL_KA = 2048, COL_VA = 2560, COL_QB = 3072, COL_KB = 5120, COL_VB = 7168;
constexpr float NORM_EPS = 1e-6f;
constexpr float LOG2E = 1.4426950408889634f;
constexpr size_t MiB = 1u << 20;
constexpr size_t WS_CTL = 0;
constexpr size_t WS_ROWSS_MLP = 64 * 1024, WS_ROWSS_PLE = 128 * 1024;
constexpr size_t WS_TAB128 = 1 * MiB;
constexpr size_t WS_TAB64 = 2 * MiB;
constexpr size_t WS_WIN = 4 * MiB, WS_WO = 76 * MiB, WS_WUP = 108 * MiB, WS_WDN = 236 * MiB, WS_WG = 364 * MiB, WS_WPLE = 396 * MiB;
constexpr size_t WS_PB = 398 * MiB;
constexpr size_t WS_XN = 402 * MiB;
constexpr size_t WS_PE = 466 * MiB;
constexpr size_t WS_PROJ = 530 * MiB;
constexpr size_t WS_VTA = 674 * MiB, WS_VTB = 682 * MiB;
constexpr size_t WS_CAT = 714 * MiB;
constexpr size_t WS_U = 530 * MiB;
constexpr size_t WS_OSCR = 786 * MiB;
constexpr size_t WS_END = 818 * MiB;
constexpr int LDS_BYTES = 147456;

#define GAS __attribute__((address_space(1)))
#define LAS __attribute__((address_space(3)))
typedef unsigned short bf16;
typedef unsigned v4u __attribute__((ext_vector_type(4)));
typedef unsigned v2u __attribute__((ext_vector_type(2)));
typedef float f32x4 __attribute__((ext_vector_type(4)));
typedef float f32x2 __attribute__((ext_vector_type(2)));
typedef short bf16x8 __attribute__((ext_vector_type(8)));
#define LDS_WAIT() asm volatile("s_waitcnt lgkmcnt(0)" ::: "memory")

__device__ __forceinline__ unsigned pk2(float lo, float hi) { unsigned r; asm("v_cvt_pk_bf16_f32 %0, %1, %2" : "=v"(r) : "v"(lo), "v"(hi)); return r; }
__device__ __forceinline__ float bflo(unsigned w) { return __uint_as_float(w << 16); }
__device__ __forceinline__ float bfhi(unsigned w) { return __uint_as_float(w & 0xffff0000u); }
__device__ __forceinline__ float wave_sum(float v) {
#pragma unroll
    for (int o = 1; o < 64; o <<= 1) v += __shfl_xor(v, o);
    return v;
}

struct Args {
    const float *x, *p, *attn_g, *w_in, *qa_g, *ka_g, *sinks, *qb_g, *kb_g, *lq1, *lk1, *lq2, *lk2, *subln_g, *w_o, *mlp_g, *w_up, *w_down, *w_ple, *ple_g, *w_gate;
    float* out; unsigned char* ws; int ph_lo, ph_hi, coop, pad;
};

__device__ __forceinline__ void p0_transpose_item(const float* W, int K, int N, bf16* WT, LAS unsigned* scr, int item, int lane) {
    const int nblk = N / 64, kb = item / nblk, nb = item % nblk, k0 = 128 * kb, n0 = 64 * nb;
    const float* src = W + (size_t)k0 * N + n0 + lane;
#pragma unroll 1
    for (int kp0 = 0; kp0 < 64; kp0 += 16) { float a[16], b[16];
#pragma unroll
        for (int i = 0; i < 16; ++i) { a[i] = __builtin_nontemporal_load(src + (size_t)(2 * (kp0 + i)) * N); b[i] = __builtin_nontemporal_load(src + (size_t)(2 * (kp0 + i) + 1) * N); }
#pragma unroll
        for (int i = 0; i < 16; ++i) scr[(kp0 + i) * 65 + lane] = pk2(a[i], b[i]); }
    LDS_WAIT(); asm volatile("" ::: "memory");
    const int c = lane & 15;
#pragma unroll
    for (int j = 0; j < 16; ++j) { const int n = (lane >> 4) + 4 * j; const LAS unsigned* s = scr + (4 * c) * 65 + n;
        v4u o; o.x = s[0 * 65]; o.y = s[1 * 65]; o.z = s[2 * 65]; o.w = s[3 * 65];
        *(v4u*)(WT + (size_t)(n0 + n) * K + k0 + 8 * c) = o; }
    LDS_WAIT(); asm volatile("" ::: "memory");
}
__device__ __forceinline__ void convert_wdown(const Args& A, LAS unsigned char* lds, int gw, int NGW, int wave, int lane) {
    LAS unsigned* scr = (LAS unsigned*)(lds + wave * 16640);
    constexpr int I_DN = (D_FF / 128) * (D_MODEL / 64);
    for (int it = gw; it < I_DN; it += NGW) p0_transpose_item(A.w_down, D_FF, D_MODEL, (bf16*)(A.ws + WS_WDN), scr, it, lane);
}
__device__ __forceinline__ void p0_prologue(const Args& A, LAS unsigned char* lds, int gw, int NGW, int wave, int lane) {
    unsigned char* ws = A.ws;
    LAS unsigned* scr = (LAS unsigned*)(lds + wave * 16640);
    constexpr int I_IN = (D_MODEL / 128) * (IN_COLS / 64), I_O = (D_MODEL / 128) * (D_MODEL / 64), I_UP = (D_MODEL / 128) * (D_FF / 64), I_G = I_O, I_PLE = (PLE_DIM / 128) * (D_MODEL / 64);
    constexpr int NITEMS = I_IN + I_O + I_UP + I_G + I_PLE;
    for (int it = gw; it < NITEMS; it += NGW) {
        int r = it;
        if (r < I_IN) { p0_transpose_item(A.w_in, D_MODEL, IN_COLS, (bf16*)(ws + WS_WIN), scr, r, lane); continue; } r -= I_IN;
        if (r < I_O) { p0_transpose_item(A.w_o, D_MODEL, D_MODEL, (bf16*)(ws + WS_WO), scr, r, lane); continue; } r -= I_O;
        if (r < I_UP) { p0_transpose_item(A.w_up, D_MODEL, D_FF, (bf16*)(ws + WS_WUP), scr, r, lane); continue; } r -= I_UP;
        if (r < I_G) { p0_transpose_item(A.w_gate, D_MODEL, D_MODEL, (bf16*)(ws + WS_WG), scr, r, lane); continue; } r -= I_G;
        p0_transpose_item(A.w_ple, PLE_DIM, D_MODEL, (bf16*)(ws + WS_WPLE), scr, r, lane);
    }
    for (int m = gw; m < M_TOK; m += NGW) {
        const f32x4* xr = (const f32x4*)(A.x + (size_t)m * D_MODEL) + lane;
        f32x4 v[16]; float s = 0.f;
#pragma unroll
        for (int j = 0; j < 16; ++j) { v[j] = xr[64 * j]; s += (v[j].x * v[j].x + v[j].y * v[j].y) + (v[j].z * v[j].z + v[j].w * v[j].w); }
        const float rstd = 1.0f / sqrtf(wave_sum(s) * (1.0f / D_MODEL) + NORM_EPS);
        v2u* o8 = (v2u*)((bf16*)(ws + WS_XN) + (size_t)m * D_MODEL) + lane;
        const f32x4* gr = (const f32x4*)A.attn_g + lane;
#pragma unroll
        for (int j = 0; j < 16; ++j) { const f32x4 g = gr[64 * j]; v2u o; o.x = pk2(v[j].x * rstd * g.x, v[j].y * rstd * g.y); o.y = pk2(v[j].z * rstd * g.z, v[j].w * rstd * g.w); o8[64 * j] = o; }
    }
    { const int gt = gw * 64 + lane, NGT = NGW * 64;
      for (int i = gt; i < M_TOK * PLE_DIM / 8; i += NGT) { const f32x4 a = ((const f32x4*)A.p)[2 * i], b = ((const f32x4*)A.p)[2 * i + 1];
          v4u o; o.x = pk2(a.x, a.y); o.y = pk2(a.z, a.w); o.z = pk2(b.x, b.y); o.w = pk2(b.z, b.w); ((v4u*)(ws + WS_PB))[i] = o; }
      for (int i = gt; i < SEQ * 64; i += NGT) { const int pos = i >> 6, j = i & 63;
          const float inv = __builtin_amdgcn_exp2f(-(float)(2 * j) * (1.0f / 128.0f) * 13.287712379549449f); const float ang = (float)pos * inv;
          double xr = (double)ang * 0.15915494309189535; xr -= __builtin_rint(xr); const float fx = (float)xr;
          ((f32x2*)(ws + WS_TAB128))[i] = (f32x2){__builtin_amdgcn_cosf(fx), __builtin_amdgcn_sinf(fx)}; }
      for (int i = gt; i < SEQ * 32; i += NGT) { const int pos = i >> 5, j = i & 31;
          const float inv = __builtin_amdgcn_exp2f(-(float)(2 * j) * (1.0f / 64.0f) * 13.287712379549449f); const float ang = (float)pos * inv;
          double xr = (double)ang * 0.15915494309189535; xr -= __builtin_rint(xr); const float fx = (float)xr;
          ((f32x2*)(ws + WS_TAB64))[i] = (f32x2){__builtin_amdgcn_cosf(fx), __builtin_amdgcn_sinf(fx)}; }
      for (int i = gt; i < M_TOK; i += NGT) { ((float*)(ws + WS_ROWSS_MLP))[i] = 0.f; ((float*)(ws + WS_ROWSS_PLE))[i] = 0.f; }
    }
}

__device__ __forceinline__ void p2_qknorm_rope(const Args& A, LAS unsigned char* lds, int gw, int NGW, int tid, int lane) {
    unsigned char* ws = A.ws; bf16* proj = (bf16*)(ws + WS_PROJ);
    const f32x2* tab128 = (const f32x2*)(ws + WS_TAB128); const f32x2* tab64 = (const f32x2*)(ws + WS_TAB64);
    const float qs128 = 0.08838834764831845f * LOG2E, qs64 = 0.125f * LOG2E;
    for (int row = gw; row < M_TOK; row += NGW) {
        const int pos = row & (SEQ - 1); bf16* prow = proj + (size_t)row * IN_COLS;
#pragma unroll 1
        for (int it = 0; it < 5; ++it) { const int ch = it * 64 + lane, col = ch * 8, i = ch & 15; const bool isq = col < COL_KA;
            const v4u w = *(const v4u*)(prow + col);
            float x[8] = {bflo(w.x), bfhi(w.x), bflo(w.y), bfhi(w.y), bflo(w.z), bfhi(w.z), bflo(w.w), bfhi(w.w)};
            float ss = 0.f;
#pragma unroll
            for (int e = 0; e < 8; ++e) ss += x[e] * x[e];
            ss += __shfl_xor(ss, 1); ss += __shfl_xor(ss, 2); ss += __shfl_xor(ss, 4); ss += __shfl_xor(ss, 8);
            const float rstd = 1.0f / sqrtf(ss * (1.0f / 128.0f) + NORM_EPS);
            const float* gp = (isq ? A.qa_g : A.ka_g) + i * 8; const f32x4 g0 = *(const f32x4*)gp, g1 = *(const f32x4*)(gp + 4);
            const float g[8] = {g0.x, g0.y, g0.z, g0.w, g1.x, g1.y, g1.z, g1.w};
            const f32x2* tb = tab128 + pos * 64 + (i & 7) * 8; const float sgn = (i < 8) ? -1.f : 1.f, sc = isq ? qs128 : 1.f;
            float o[8];
#pragma unroll
            for (int e = 0; e < 8; ++e) { const float y = x[e] * rstd * g[e]; const float py = __shfl_xor(y, 8); const f32x2 cs = tb[e]; o[e] = (y * cs.x + sgn * py * cs.y) * sc; }
            v4u ow; ow.x = pk2(o[0], o[1]); ow.y = pk2(o[2], o[3]); ow.z = pk2(o[4], o[5]); ow.w = pk2(o[6], o[7]);
            *(v4u*)(prow + col) = ow; }
#pragma unroll 1
        for (int it = 0; it < 8; ++it) { const int ch = it * 64 + lane, col = COL_QB + ch * 8, i = ch & 7; const bool isq = ch < 256;
            const v4u w = *(const v4u*)(prow + col);
            float x[8] = {bflo(w.x), bfhi(w.x), bflo(w.y), bfhi(w.y), bflo(w.z), bfhi(w.z), bflo(w.w), bfhi(w.w)};
            float ss = 0.f;
#pragma unroll
            for (int e = 0; e < 8; ++e) ss += x[e] * x[e];
            ss += __shfl_xor(ss, 1); ss += __shfl_xor(ss, 2); ss += __shfl_xor(ss, 4);
            const float rstd = 1.0f / sqrtf(ss * (1.0f / 64.0f) + NORM_EPS);
            const float* gp = (isq ? A.qb_g : A.kb_g) + i * 8; const f32x4 g0 = *(const f32x4*)gp, g1 = *(const f32x4*)(gp + 4);
            const float g[8] = {g0.x, g0.y, g0.z, g0.w, g1.x, g1.y, g1.z, g1.w};
            const f32x2* tb = tab64 + pos * 32 + (i & 3) * 8; const float sgn = (i < 4) ? -1.f : 1.f, sc = isq ? qs64 : 1.f;
            float o[8];
#pragma unroll
            for (int e = 0; e < 8; ++e) { const float y = x[e] * rstd * g[e]; const float py = __shfl_xor(y, 4); const f32x2 cs = tb[e]; o[e] = (y * cs.x + sgn * py * cs.y) * sc; }
            v4u ow; ow.x = pk2(o[0], o[1]); ow.y = pk2(o[2], o[3]); ow.z = pk2(o[4], o[5]); ow.w = pk2(o[6], o[7]);
            *(v4u*)(prow + col) = ow; }
    }
    LAS bf16* T = (LAS bf16*)lds;
    for (int tile = blockIdx.x; tile < (M_TOK / 64) * 20; tile += gridDim.x) {
        const int tb = tile / 20, hd = tile % 20, b = tb / (SEQ / 64), s0 = (tb % (SEQ / 64)) * 64;
        const int vcol = hd < 4 ? COL_VA + hd * 128 : COL_VB + (hd - 4) * 128;
        bf16* dst = hd < 4 ? (bf16*)(ws + WS_VTA) + (size_t)(b * 4 + hd) * 128 * SEQ : (bf16*)(ws + WS_VTB) + (size_t)(b * 16 + (hd - 4)) * 128 * SEQ;
#pragma unroll
        for (int k = 0; k < 2; ++k) { const int ci = tid + 512 * k, tok = ci >> 4, dc = ci & 15;
            const v4u w = *(const v4u*)(proj + (size_t)(tb * 64 + tok) * IN_COLS + vcol + dc * 8);
            LAS bf16* t = T + (dc * 8) * 72 + tok;
            t[0 * 72] = (bf16)(w.x & 0xffff); t[1 * 72] = (bf16)(w.x >> 16); t[2 * 72] = (bf16)(w.y & 0xffff); t[3 * 72] = (bf16)(w.y >> 16);
            t[4 * 72] = (bf16)(w.z & 0xffff); t[5 * 72] = (bf16)(w.z >> 16); t[6 * 72] = (bf16)(w.w & 0xffff); t[7 * 72] = (bf16)(w.w >> 16); }
        __syncthreads();
#pragma unroll
        for (int k = 0; k < 2; ++k) { const int ci = tid + 512 * k, d = ci >> 3, tc = ci & 7;
            const v4u w = *(const LAS v4u*)(T + d * 72 + tc * 8);
            *(v4u*)(dst + (size_t)d * SEQ + s0 + tc * 8) = w; }
        __syncthreads();
    }
}

namespace att {
constexpr int BUF_BYTES = 32768, K_OFF = 0, V_OFF = 16384;
constexpr float NEG = -1e30f;
__device__ __forceinline__ int swz(int rr, int fq) { const int ob = rr * 64 + fq * 16; return ob ^ (((ob >> 9) & 1) << 5); }

template <int DK> struct Stage { v4u k[DK / 64]; v4u v[2]; };

template <int DK>
__device__ __forceinline__ void stage_load(Stage<DK>& st, const bf16* Kb, int ldk, const bf16* Vt, int kt0, int tid) {
#pragma unroll
    for (int k = 0; k < DK / 64; ++k) { const int ci = tid + 512 * k, kl = ci / (DK / 8), c8 = ci % (DK / 8); st.k[k] = *(const v4u*)(Kb + (size_t)(kt0 + kl) * ldk + c8 * 8); }
#pragma unroll
    for (int k = 0; k < 2; ++k) { const int ci = tid + 512 * k, d = ci >> 3, kc = ci & 7; st.v[k] = *(const v4u*)(Vt + (size_t)d * SEQ + kt0 + kc * 8); }
}
template <int DK>
__device__ __forceinline__ void stage_write(const Stage<DK>& st, LAS unsigned char* buf, int tid) {
#pragma unroll
    for (int k = 0; k < DK / 64; ++k) { const int ci = tid + 512 * k, kl = ci / (DK / 8), c8 = ci % (DK / 8);
        const int u = kl >> 5, g = (kl >> 3) & 3, e = (kl >> 2) & 1, i = kl & 3, t = 2 * u + e, rr = 4 * g + i, c = c8 >> 2, fq = c8 & 3;
        *(LAS v4u*)(buf + K_OFF + (t * (DK / 32) + c) * 1024 + swz(rr, fq)) = st.k[k]; }
#pragma unroll
    for (int k = 0; k < 2; ++k) { const int ci = tid + 512 * k, d = ci >> 3, kc = ci & 7; const int dt = d >> 4, rr = d & 15, u = kc >> 2, fq = kc & 3;
        *(LAS v4u*)(buf + V_OFF + (dt * 2 + u) * 1024 + swz(rr, fq)) = st.v[k]; }
}

template <int DK, bool SWA>
__device__ __forceinline__ void pass(LAS unsigned char* lds, const bf16* Q, int ldq, const bf16* Kb, int ldk, const bf16* Vt, int q0, int jt_lo, int jt_hi,
                                     float (&mrow)[2], float (&lrow)[2], f32x4 (&O)[2][8], int tid, int wave, int lane) {
    const int fr = lane & 15, fq = lane >> 4, qw = q0 + 32 * wave;
    bf16x8 qf[2][DK / 32];
#pragma unroll
    for (int rg = 0; rg < 2; ++rg)
#pragma unroll
        for (int c = 0; c < DK / 32; ++c) qf[rg][c] = *(const bf16x8*)(Q + (size_t)(qw + 16 * rg + fr) * ldq + 32 * c + 8 * fq);
    const int fro = swz(fr, fq);
    Stage<DK> st;
    stage_load<DK>(st, Kb, ldk, Vt, jt_lo * 64, tid);
    stage_write<DK>(st, lds, tid);
    __syncthreads();
    for (int jt = jt_lo; jt <= jt_hi; ++jt) {
        LAS unsigned char* buf = lds + ((jt - jt_lo) & 1) * BUF_BYTES;
        if (jt < jt_hi) stage_load<DK>(st, Kb, ldk, Vt, (jt + 1) * 64, tid);
        const int kt0 = jt * 64;
        bool need = kt0 <= qw + 31; if (SWA) need = need && (kt0 + 63 >= qw - 127);
        if (need) {
            f32x4 s[2][4];
#pragma unroll
            for (int t = 0; t < 4; ++t) {
#pragma unroll
                for (int rg = 0; rg < 2; ++rg) s[rg][t] = (f32x4){0.f, 0.f, 0.f, 0.f};
#pragma unroll
                for (int c = 0; c < DK / 32; ++c) { const bf16x8 kf = *(const LAS bf16x8*)(buf + K_OFF + (t * (DK / 32) + c) * 1024 + fro);
#pragma unroll
                    for (int rg = 0; rg < 2; ++rg) s[rg][t] = __builtin_amdgcn_mfma_f32_16x16x32_bf16(kf, qf[rg][c], s[rg][t], 0, 0, 0); }
                if (t & 1) __builtin_amdgcn_sched_barrier(0);
            }
            const bool domask = SWA || (kt0 + 63 > qw);
            if (domask) {
#pragma unroll
                for (int rg = 0; rg < 2; ++rg) { const int q = qw + 16 * rg + fr;
#pragma unroll
                    for (int t = 0; t < 4; ++t)
#pragma unroll
                        for (int i = 0; i < 4; ++i) { const int key = kt0 + 32 * (t >> 1) + 8 * fq + 4 * (t & 1) + i;
                            bool ok = key <= q; if (SWA) ok = ok && (q - key < 128);
                            s[rg][t][i] = ok ? s[rg][t][i] : NEG; } }
            }
            bf16x8 pf[2][2];
#pragma unroll
            for (int rg = 0; rg < 2; ++rg) {
                float mx = NEG;
#pragma unroll
                for (int t = 0; t < 4; ++t) mx = fmaxf(mx, fmaxf(fmaxf(s[rg][t][0], s[rg][t][1]), fmaxf(s[rg][t][2], s[rg][t][3])));
                mx = fmaxf(mx, __shfl_xor(mx, 16)); mx = fmaxf(mx, __shfl_xor(mx, 32));
                const float mnew = fmaxf(mrow[rg], mx), alpha = __builtin_amdgcn_exp2f(mrow[rg] - mnew); mrow[rg] = mnew;
                float ps = 0.f;
#pragma unroll
                for (int t = 0; t < 4; ++t)
#pragma unroll
                    for (int i = 0; i < 4; ++i) { const float p = __builtin_amdgcn_exp2f(s[rg][t][i] - mnew); s[rg][t][i] = p; ps += p; }
                lrow[rg] = lrow[rg] * alpha + ps;
#pragma unroll
                for (int dt = 0; dt < 8; ++dt) O[rg][dt] = O[rg][dt] * alpha;
#pragma unroll
                for (int u = 0; u < 2; ++u) { v4u w; w.x = pk2(s[rg][2 * u][0], s[rg][2 * u][1]); w.y = pk2(s[rg][2 * u][2], s[rg][2 * u][3]);
                    w.z = pk2(s[rg][2 * u + 1][0], s[rg][2 * u + 1][1]); w.w = pk2(s[rg][2 * u + 1][2], s[rg][2 * u + 1][3]); pf[rg][u] = __builtin_bit_cast(bf16x8, w); }
            }
#pragma unroll
            for (int dt = 0; dt < 8; ++dt)
#pragma unroll
                for (int u = 0; u < 2; ++u) { const bf16x8 vf = *(const LAS bf16x8*)(buf + V_OFF + (dt * 2 + u) * 1024 + fro);
#pragma unroll
                    for (int rg = 0; rg < 2; ++rg) O[rg][dt] = __builtin_amdgcn_mfma_f32_16x16x32_bf16(vf, pf[rg][u], O[rg][dt], 0, 0, 0);
                    if (u == 1 && (dt & 1)) __builtin_amdgcn_sched_barrier(0); }
        }
        if (jt < jt_hi) stage_write<DK>(st, lds + (((jt - jt_lo) & 1) ^ 1) * BUF_BYTES, tid);
        __syncthreads();
    }
}

__device__ __forceinline__ void init_state(float (&m)[2], float (&l)[2], f32x4 (&O)[2][8]) {
#pragma unroll
    for (int rg = 0; rg < 2; ++rg) { m[rg] = NEG; l[rg] = 0.f;
#pragma unroll
        for (int dt = 0; dt < 8; ++dt) O[rg][dt] = (f32x4){0.f, 0.f, 0.f, 0.f}; }
}

__device__ __forceinline__ void swa_unit(const Args& A, LAS unsigned char* lds, int unit) {
    const int tid = threadIdx.x, lane = tid & 63, wave = __builtin_amdgcn_readfirstlane(tid >> 6);
    unsigned char* ws = A.ws; const bf16* proj = (const bf16*)(ws + WS_PROJ);
    const int qb = unit & 7, hq = (unit >> 3) & 15, b = unit >> 7, kvh = hq >> 2, q0 = qb * 256;
    const bf16* Q = proj + (size_t)b * SEQ * IN_COLS + COL_QA + hq * 128;
    const bf16* Kb = proj + (size_t)b * SEQ * IN_COLS + COL_KA + kvh * 128;
    const bf16* Vt = (const bf16*)(ws + WS_VTA) + (size_t)(b * 4 + kvh) * 128 * SEQ;
    float m[2], l[2]; f32x4 O[2][8]; init_state(m, l, O);
    const int jt_lo = (4 * qb - 2) > 0 ? 4 * qb - 2 : 0, jt_hi = 4 * qb + 3;
    pass<128, true>(lds, Q, IN_COLS, Kb, IN_COLS, Vt, q0, jt_lo, jt_hi, m, l, O, tid, wave, lane);
    const int fr = lane & 15, fq = lane >> 4; const float sink2 = A.sinks[hq] * LOG2E;
    bf16* cat = (bf16*)(ws + WS_CAT);
#pragma unroll
    for (int rg = 0; rg < 2; ++rg) { float lt = l[rg]; lt += __shfl_xor(lt, 16); lt += __shfl_xor(lt, 32);
        lt += __builtin_amdgcn_exp2f(sink2 - m[rg]); const float inv = 1.0f / lt;
        bf16* orow = cat + (size_t)(b * SEQ + q0 + 32 * wave + 16 * rg + fr) * D_MODEL + hq * 128 + 4 * fq;
#pragma unroll
        for (int dt = 0; dt < 8; ++dt) { const f32x4 o = O[rg][dt] * inv; v2u w; w.x = pk2(o[0], o[1]); w.y = pk2(o[2], o[3]); *(v2u*)(orow + 16 * dt) = w; } }
}
__device__ __forceinline__ void diff_unit(const Args& A, LAS unsigned char* lds, int b, int h, int qb, float lam) {
    const int tid = threadIdx.x, lane = tid & 63, wave = __builtin_amdgcn_readfirstlane(tid >> 6);
    unsigned char* ws = A.ws; const bf16* proj = (const bf16*)(ws + WS_PROJ);
    const int q0 = qb * 256; const size_t boff = (size_t)b * SEQ * IN_COLS;
    const bf16* Vt = (const bf16*)(ws + WS_VTB) + (size_t)(b * 16 + h) * 128 * SEQ;
    const int jt_hi = 4 * qb + 3;
    float m[2], l[2]; f32x4 O1[2][8], O0[2][8];
    f32x4* oscr = (f32x4*)(ws + WS_OSCR) + (size_t)blockIdx.x * 16 * 512 + tid;
#pragma unroll 1
    for (int mp = 0; mp < 2; ++mp) {
        init_state(m, l, O1);
        pass<64, false>(lds, proj + boff + COL_QB + mp * 1024 + h * 64, IN_COLS, proj + boff + COL_KB + mp * 1024 + h * 64, IN_COLS, Vt, q0, 0, jt_hi, m, l, O1, tid, wave, lane);
        if (mp == 0) {
#pragma unroll
            for (int rg = 0; rg < 2; ++rg) { float lt = l[rg]; lt += __shfl_xor(lt, 16); lt += __shfl_xor(lt, 32); const float inv = 1.0f / lt;
#pragma unroll
                for (int dt = 0; dt < 8; ++dt) oscr[(rg * 8 + dt) * 512] = O1[rg][dt] * inv; }
        }
    }
#pragma unroll
    for (int rg = 0; rg < 2; ++rg)
#pragma unroll
        for (int dt = 0; dt < 8; ++dt) O0[rg][dt] = oscr[(rg * 8 + dt) * 512];
    const int fr = lane & 15, fq = lane >> 4;
    bf16* cat = (bf16*)(ws + WS_CAT);
#pragma unroll
    for (int rg = 0; rg < 2; ++rg) { float lt = l[rg]; lt += __shfl_xor(lt, 16); lt += __shfl_xor(lt, 32); const float sc = -lam / lt;
        float ss = 0.f;
#pragma unroll
        for (int dt = 0; dt < 8; ++dt) { const f32x4 o = O0[rg][dt] + O1[rg][dt] * sc; O0[rg][dt] = o; ss += (o[0] * o[0] + o[1] * o[1]) + (o[2] * o[2] + o[3] * o[3]); }
        ss += __shfl_xor(ss, 16); ss += __shfl_xor(ss, 32);
        const float rs = 0.8f / sqrtf(ss * (1.0f / 128.0f) + NORM_EPS);
        bf16* orow = cat + (size_t)(b * SEQ + q0 + 32 * wave + 16 * rg + fr) * D_MODEL + 2048 + h * 128 + 4 * fq;
#pragma unroll
        for (int dt = 0; dt < 8; ++dt) { const f32x4 g = *(const f32x4*)(A.subln_g + 16 * dt + 4 * fq); const f32x4 o = O0[rg][dt] * g * rs;
            v2u w; w.x = pk2(o[0], o[1]); w.y = pk2(o[2], o[3]); *(v2u*)(orow + 16 * dt) = w; } }
}
}

#define RLX_AGENT __ATOMIC_RELAXED, __HIP_MEMORY_SCOPE_AGENT
#define XB_TMO      128
#define XB_XCNT(j)  (256  + 64 * (j))
#define XB_XSUB(j)  (1280 + 64 * (j))
#define XB_XGEN(j)  (2304 + 64 * (j))
#define XB_TOP      3328
#define XB_TOPGEN   3392
#define XCD_BAR_WORDS 3456
#define XB_SPIN_CAP (1u << 18)

__device__ __forceinline__ unsigned xb_ld(unsigned* p)              { return __hip_atomic_load(p, __ATOMIC_RELAXED, __HIP_MEMORY_SCOPE_AGENT); }
__device__ __forceinline__ unsigned xb_add(unsigned* p, unsigned v) { return __hip_atomic_fetch_add(p, v, __ATOMIC_RELAXED, __HIP_MEMORY_SCOPE_AGENT); }
__device__ __forceinline__ unsigned xb_xcc_id() { return (unsigned)__builtin_amdgcn_s_getreg((3 << 11) | 20) & 0xFu; }
#define XB_SPIN(cond, bar) do { unsigned _sp = 0; while (cond) { __builtin_amdgcn_s_sleep(1); \
    if ((++_sp & 255u) == 0u) { if (xb_ld(&(bar)[XB_TMO])) break; if (_sp > XB_SPIN_CAP) { atomicAdd(&(bar)[XB_TMO], 1u); break; } } } } while (0)

struct XcdBarrier {
    unsigned* bar; unsigned x;
    volatile LAS unsigned* st;
};

__device__ __forceinline__ XcdBarrier xcd_barrier_post(unsigned* bar, volatile LAS unsigned* st) {
    XcdBarrier b; b.bar = bar; b.x = xb_xcc_id(); b.st = st;
    if (threadIdx.x == 0) (void)xb_add(&bar[XB_XCNT(b.x)], 1u);
    return b;
}
__device__ __forceinline__ void xcd_barrier_complete(unsigned* bar, unsigned x, unsigned& nloc, unsigned& nx) {
    const unsigned G = gridDim.x * gridDim.y * gridDim.z;
    unsigned sum, cnt, mine, sp = 0u;
    for (;;) {
        sum = 0u; cnt = 0u; mine = 0u;
#pragma unroll
        for (unsigned j = 0; j < 16; ++j) { const unsigned c = xb_ld(&bar[XB_XCNT(j)]); sum += c; cnt += (c > 0u) ? 1u : 0u; mine = (j == x) ? c : mine; }
        if (sum == G) break;
        __builtin_amdgcn_s_sleep(1);
        if ((++sp & 255u) == 0u) { if (xb_ld(&bar[XB_TMO])) break; if (sp > XB_SPIN_CAP) { atomicAdd(&bar[XB_TMO], 1u); break; } }
    }
    nloc = mine > 0u ? mine : 1u; nx = cnt > 0u ? cnt : 1u;
}

__device__ __forceinline__ void xcd_barrier(const XcdBarrier& b) {
    asm volatile("s_waitcnt vmcnt(0)" ::: "memory");
    __syncthreads();
    if (threadIdx.x == 0) {
        unsigned* bar = b.bar;
        __builtin_amdgcn_s_waitcnt(0);
        unsigned nloc = b.st[0], nx = b.st[1];
        if (nloc == 0u) { xcd_barrier_complete(bar, b.x, nloc, nx); b.st[0] = nloc; b.st[1] = nx; }
        const unsigned old = xb_add(&bar[XB_XSUB(b.x)], 1u);
        const unsigned gen = old / nloc;
        if (old + 1u == (gen + 1u) * nloc) {
            __builtin_amdgcn_fence(__ATOMIC_RELEASE, "agent");
            asm volatile("s_waitcnt vmcnt(0)" ::: "memory");
            const unsigned og = xb_add(&bar[XB_TOP], 1u);
            const unsigned tg = og / nx;
            if (og + 1u == (tg + 1u) * nx) xb_add(&bar[XB_TOPGEN], 1u);
            else XB_SPIN(xb_ld(&bar[XB_TOPGEN]) == tg, bar);
            __builtin_amdgcn_fence(__ATOMIC_ACQUIRE, "agent");
            xb_add(&bar[XB_XGEN(b.x)], 1u);
            asm volatile("s_waitcnt vmcnt(0)" ::: "memory");
        } else {
            XB_SPIN(xb_ld(&bar[XB_XGEN(b.x)]) == gen, bar);
            __builtin_amdgcn_fence(__ATOMIC_ACQUIRE, "agent");
            asm volatile("s_waitcnt vmcnt(0)" ::: "memory");
        }
    }
    __syncthreads();
}

#define PG8_SP2 true
#define PG8_ALIGN true
__global__ void __launch_bounds__(NTHREADS, 2) hymba_fwd(Args A) {
    extern __shared__ __attribute__((aligned(16))) unsigned char lds_raw[];
    LAS unsigned char* lds = (LAS unsigned char*)lds_raw;
    const int tid = threadIdx.x, lane = tid & 63, wave = __builtin_amdgcn_readfirstlane(tid >> 6);
    const int G = gridDim.x, gw = blockIdx.x * NWAVES + wave, NGW = G * NWAVES;
    unsigned char* ws = A.ws;
    const int lo = A.ph_lo, hi = A.ph_hi;
#ifndef PHMASK
#define PHMASK 0xff
#endif
#define IN(k) (((PHMASK >> (k)) & 1) && lo <= (k) && (k) < hi)
#define SEAM(k) do { if (IN(k) && IN((k) + 1)) { if ((k) == 0) cg::this_grid().sync(); else xcd_barrier(bar); } } while (0)
    volatile LAS unsigned* MISC = (volatile LAS unsigned*)(lds + LDS_BYTES - 64);
    if (tid < 16) MISC[tid] = 0u;
    __syncthreads();
    XcdBarrier bar; bar.bar = (unsigned*)(ws + WS_CTL); bar.x = 0; bar.st = nullptr;
    if (A.coop) bar = xcd_barrier_post((unsigned*)(ws + WS_CTL), MISC);

#ifndef REP0
#define REP0 1
#endif
#ifndef REP3
#define REP3 1
#endif
#ifndef REP5
#define REP5 1
#endif
#ifndef WDOWN_IN_P1
#define WDOWN_IN_P1 1
#endif
    const int p1_rem = WDOWN_IN_P1 ? ((M_TOK / 256) * (IN_COLS / 256)) % G : 0;
    if (IN(0)) { for (int rep = 0; rep < REP0; ++rep) p0_prologue(A, lds, gw, NGW, wave, lane); if (p1_rem == 0) convert_wdown(A, lds, gw, NGW, wave, lane); }
    SEAM(0);
    if (IN(1)) {
        { pg8::Gemm g{(const bf16*)(ws + WS_XN), (const bf16*)(ws + WS_WIN), M_TOK, IN_COLS, D_MODEL}; pg8::StaticOrder S; S.init(M_TOK, IN_COLS, G, (int)blockIdx.x);
          pg8::EpiPlain E{(bf16*)(ws + WS_PROJ), IN_COLS};
          pg8::gemm_phase<pg8::EpiPlain, pg8::StaticOrder, PG8_ALIGN, PG8_SP2>(lds, g, S, E); }
        { pg8::Gemm g{(const bf16*)(ws + WS_PB), (const bf16*)(ws + WS_WPLE), M_TOK, D_MODEL, PLE_DIM}; pg8::StaticOrder S; S.init(M_TOK, D_MODEL, G, (int)blockIdx.x);
          pg8::EpiPle E{(bf16*)(ws + WS_PE), D_MODEL, (float*)(ws + WS_ROWSS_PLE)};
          pg8::gemm_phase<pg8::EpiPle, pg8::StaticOrder, PG8_ALIGN, PG8_SP2>(lds, g, S, E); }
        if (p1_rem != 0 && (int)blockIdx.x >= p1_rem) convert_wdown(A, lds, ((int)blockIdx.x - p1_rem) * NWAVES + wave, (G - p1_rem) * NWAVES, wave, lane);
    }
    SEAM(1);
    if (IN(2)) { p2_qknorm_rope(A, lds, gw, NGW, tid, lane); }
    SEAM(2);
    if (IN(3)) {
        const float s1 = wave_sum(A.lq1[lane] * A.lk1[lane]), s2 = wave_sum(A.lq2[lane] * A.lk2[lane]);
        const float lam = __expf(s1) - __expf(s2) + 0.2f;
        for (int rep = 0; rep < REP3; ++rep) {
#ifndef NO_DIFF
#pragma unroll 1
        for (int pr2 = 2 * blockIdx.x; pr2 < 512; pr2 += 2 * G)
#pragma unroll 1
            for (int k = 0; k < 2; ++k) { const int pr = pr2 >> 1, b = pr >> 6, h = (pr >> 2) & 15, pi = pr & 3;
                att::diff_unit(A, lds, b, h, k ? pi : 7 - pi, lam); }
#endif
#ifndef NO_SWA
#pragma unroll 1
        for (int un = blockIdx.x; un < 512; un += G) att::swa_unit(A, lds, un);
#endif
        }
    }
    SEAM(3);
    if (IN(4)) {
        pg8::Gemm g{(const bf16*)(ws + WS_CAT), (const bf16*)(ws + WS_WO), M_TOK, D_MODEL, D_MODEL}; pg8::StaticOrder S; S.init(M_TOK, D_MODEL, G, (int)blockIdx.x);
        pg8::EpiRes E{A.x, A.out, (bf16*)(ws + WS_XN), D_MODEL, A.mlp_g, (float*)(ws + WS_ROWSS_MLP)};
        pg8::gemm_phase<pg8::EpiRes, pg8::StaticOrder, PG8_ALIGN, PG8_SP2>(lds, g, S, E);
    }
    SEAM(4);
    if (IN(5)) {
        pg8::Gemm g{(const bf16*)(ws + WS_XN), (const bf16*)(ws + WS_WUP), M_TOK, D_FF, D_MODEL}; pg8::StaticOrder S; S.init(M_TOK, D_FF, G, (int)blockIdx.x);
        pg8::EpiUp E{(bf16*)(ws + WS_U), D_FF, (const float*)(ws + WS_ROWSS_MLP), 1.0f / D_MODEL};
        for (int rep = 0; rep < REP5; ++rep) pg8::gemm_phase<pg8::EpiUp, pg8::StaticOrder, PG8_ALIGN, PG8_SP2>(lds, g, S, E);
    }
    SEAM(5);
    if (IN(6)) {
        pg8::Gemm g{(const bf16*)(ws + WS_U), (const bf16*)(ws + WS_WDN), M_TOK, D_MODEL, D_FF}; pg8::StaticOrder S; S.init(M_TOK, D_MODEL, G, (int)blockIdx.x);
        pg8::EpiRes E{A.out, A.out, (bf16*)(ws + WS_XN), D_MODEL, nullptr, nullptr};
        pg8::gemm_phase<pg8::EpiRes, pg8::StaticOrder, PG8_ALIGN, PG8_SP2>(lds, g, S, E);
    }
    SEAM(6);
    if (IN(7)) {
        pg8::Gemm g{(const bf16*)(ws + WS_XN), (const bf16*)(ws + WS_WG), M_TOK, D_MODEL, D_MODEL}; pg8::StaticOrder S; S.init(M_TOK, D_MODEL, G, (int)blockIdx.x);
        pg8::EpiFinal E{A.out, (const bf16*)(ws + WS_PE), D_MODEL, (const float*)(ws + WS_ROWSS_PLE), A.ple_g, 1.0f / D_MODEL};
        pg8::gemm_phase<pg8::EpiFinal, pg8::StaticOrder, PG8_ALIGN, PG8_SP2>(lds, g, S, E);
    }
#undef IN
#undef SEAM
}

#ifndef MK_PER_PHASE
#define MK_PER_PHASE 0
#endif
extern "C" void kernel_launch(void* const* d_in, const int* in_sizes, int n_in, void* d_out, int out_size, void* d_ws, size_t ws_size, hipStream_t stream) {
    static int grid = 0;
    if (grid == 0) {
        if (n_in != 21 || in_sizes[0] != M_TOK * D_MODEL || out_size != M_TOK * D_MODEL || ws_size < WS_END) { fprintf(stderr, "kernel_launch: unexpected shapes (n_in %d, ws %zu); nothing launched\n", n_in, ws_size); grid = -1; return; }
        int dev = 0, cus = 0, per_cu = 0;
        if (hipGetDevice(&dev) != hipSuccess || hipDeviceGetAttribute(&cus, hipDeviceAttributeMultiprocessorCount, dev) != hipSuccess) { grid = -1; return; }
        if (hipFuncSetAttribute((const void*)hymba_fwd, hipFuncAttributeMaxDynamicSharedMemorySize, LDS_BYTES) != hipSuccess) { fprintf(stderr, "kernel_launch: hipFuncSetAttribute failed\n"); grid = -1; return; }
        if (hipOccupancyMaxActiveBlocksPerMultiprocessor(&per_cu, (const void*)hymba_fwd, NTHREADS, LDS_BYTES) != hipSuccess || per_cu < 1) { fprintf(stderr, "kernel_launch: occupancy query says %d\n", per_cu); per_cu = 1; }
        (void)hipGetLastError();
        grid = cus;
    }
    if (grid < 0) return;
    if (hipMemsetAsync((char*)d_ws + WS_CTL, 0, 16384, stream) != hipSuccess) { fprintf(stderr, "kernel_launch: memset failed\n"); return; }
    Args a{};
    const float** f = (const float**)&a;
    for (int i = 0; i < 21; ++i) f[i] = (const float*)d_in[i];
    a.out = (float*)d_out; a.ws = (unsigned char*)d_ws;
#if MK_PER_PHASE
    for (int ph = 0; ph < 8; ++ph) { a.ph_lo = ph; a.ph_hi = ph + 1; a.coop = 0; hipLaunchKernelGGL(hymba_fwd, dim3(grid), dim3(NTHREADS), LDS_BYTES, stream, a); }
#else
    a.ph_lo = 0; a.ph_hi = 8; a.coop = 1;
    void* args[] = {&a};
    hipError_t e = hipLaunchCooperativeKernel((const void*)hymba_fwd, dim3(grid), dim3(NTHREADS), args, LDS_BYTES, stream);
    if (e != hipSuccess) fprintf(stderr, "kernel_launch: cooperative launch failed: %s (grid %d)\n", hipGetErrorString(e), grid);
#endif
}
```

```cpp
#include <hip/hip_runtime.h>
#include <hip/hip_cooperative_groups.h>
#include <cstdio>
#include <cstdint>
namespace cg = cooperative_groups;
namespace pg8 {
#define PG8_LAS __attribute__((address_space(3)))
typedef unsigned short bf16_t;
typedef short bf16x8 __attribute__((ext_vector_type(8)));
typedef float f32x4 __attribute__((ext_vector_type(4)));
typedef unsigned u32x4 __attribute__((ext_vector_type(4)));
constexpr int BM = 256, BK = 64, HALF = 128, HTB = HALF * BK * 2  , STAGE_BYTES = 8 * HTB, NXCD = 8, WGM = 8;

__host__ __device__ __forceinline__ int lds_byte(int r, int c) { const int st = (r >> 4) * 2 + (c >> 5), rr = r & 15, cc = c & 31, ob = rr * 64 + cc * 2; return st * 1024 + (ob ^ (((ob >> 9) & 1) << 5)); }
__host__ __device__ __forceinline__ void stage_rc(int b, int& R, int& C) { const int st = b / 1024, sb = b % 1024, swz = sb ^ (((sb >> 9) & 1) << 5); R = (st >> 1) * 16 + swz / 64; C = (st & 1) * 32 + (swz % 64) / 2; }
__host__ __device__ __forceinline__ int perm32(int rho) { const int n = rho >> 4, i = rho & 15; return 8 * (i >> 2) + 4 * n + (i & 3); }

struct Unit { int pm, pn; };
struct Gemm { const bf16_t* A; const bf16_t* Bt; int M, N, K; };

struct StaticOrder {
    int nM, nN, nwg, G, c;
    __host__ __device__ void init(int M, int N, int G_, int c_) { nM = M / BM; nN = N / BM; nwg = nM * nN; G = G_; c = c_; }
    __host__ __device__ bool next(int i, Unit& u) const {
        const long L = (long)i * G + c; if (L >= nwg) return false;
        int wgid = (int)L; { const int q = nwg / NXCD, r = nwg % NXCD, xcd = wgid % NXCD, off = wgid / NXCD; wgid = (xcd < r ? xcd * (q + 1) : r * (q + 1) + (xcd - r) * q) + off; }
        const int nig = WGM * nN, gid = wgid / nig, fm = gid * WGM, gsz = (nM - fm) < WGM ? (nM - fm) : WGM;
        u.pm = fm + ((wgid % nig) % gsz); u.pn = (wgid % nig) / gsz; return true;
    }
    __device__ __forceinline__ void a_ready(const Unit&) const {}
    __device__ __forceinline__ void done(const Unit&) const {}
};

__device__ __forceinline__ unsigned cvt_pk_bf16(float lo, float hi) { unsigned r; asm volatile("v_cvt_pk_bf16_f32 %0, %1, %2" : "=v"(r) : "v"(lo), "v"(hi)); return r; }
typedef float f32x2 __attribute__((ext_vector_type(2)));
constexpr float RMS_EPS = 1e-6f;
__device__ __forceinline__ u32x4 pack8(const f32x4 v0, const f32x4 v1) { u32x4 w; w.x = cvt_pk_bf16(v0[0], v0[1]); w.y = cvt_pk_bf16(v0[2], v0[3]); w.z = cvt_pk_bf16(v1[0], v1[1]); w.w = cvt_pk_bf16(v1[2], v1[3]); return w; }
__device__ __forceinline__ float bf_lo(unsigned w) { return __uint_as_float(w << 16); }
__device__ __forceinline__ float bf_hi(unsigned w) { return __uint_as_float(w & 0xffff0000u); }

struct EpiPlain {
    static constexpr bool PERM = true, AFTER_DRAIN = false;
    bf16_t* O; int ldc;
    __device__ __forceinline__ void operator()(const f32x4 (&acc)[2][2][4][2], const Unit& u, int wr, int wc, int fr, int fq) const {
        const int row0 = u.pm * BM + wr * 64 + fr, col0 = u.pn * BM + wc * 32 + 8 * fq;
#pragma unroll
        for (int ai = 0; ai < 2; ++ai)
#pragma unroll
            for (int m = 0; m < 4; ++m) { bf16_t* rowp = O + (size_t)(row0 + ai * HALF + m * 16) * ldc + col0;
#pragma unroll
                for (int bj = 0; bj < 2; ++bj) *(u32x4*)(rowp + bj * HALF) = pack8(acc[ai][bj][m][0], acc[ai][bj][m][1]); }
    }
};
struct EpiPle {
    static constexpr bool PERM = true, AFTER_DRAIN = false;
    bf16_t* O; int ldc; float* rowss;
    __device__ __forceinline__ void operator()(const f32x4 (&acc)[2][2][4][2], const Unit& u, int wr, int wc, int fr, int fq) const {
        const int row0 = u.pm * BM + wr * 64 + fr, col0 = u.pn * BM + wc * 32 + 8 * fq;
#pragma unroll
        for (int ai = 0; ai < 2; ++ai)
#pragma unroll
            for (int m = 0; m < 4; ++m) { const int row = row0 + ai * HALF + m * 16; bf16_t* rowp = O + (size_t)row * ldc + col0; float ss = 0.f;
#pragma unroll
                for (int bj = 0; bj < 2; ++bj) { const f32x4 v0 = acc[ai][bj][m][0], v1 = acc[ai][bj][m][1];
                    ss += (v0[0] * v0[0] + v0[1] * v0[1]) + (v0[2] * v0[2] + v0[3] * v0[3]) + (v1[0] * v1[0] + v1[1] * v1[1]) + (v1[2] * v1[2] + v1[3] * v1[3]);
                    *(u32x4*)(rowp + bj * HALF) = pack8(v0, v1); }
                ss += __shfl_xor(ss, 16); ss += __shfl_xor(ss, 32);
                if (fq == 0) atomicAdd(rowss + row, ss); }
    }
};
struct EpiUp {
    static constexpr bool PERM = true, AFTER_DRAIN = false;
    bf16_t* O; int ldc; const float* rowss; float inv_nfeat;
    __device__ __forceinline__ void operator()(const f32x4 (&acc)[2][2][4][2], const Unit& u, int wr, int wc, int fr, int fq) const {
        const int row0 = u.pm * BM + wr * 64 + fr, col0 = u.pn * BM + wc * 32 + 8 * fq;
#pragma unroll
        for (int ai = 0; ai < 2; ++ai)
#pragma unroll
            for (int m = 0; m < 4; ++m) { const int row = row0 + ai * HALF + m * 16; bf16_t* rowp = O + (size_t)row * ldc + col0;
                const float r2 = 1.0f / (rowss[row] * inv_nfeat + RMS_EPS);
#pragma unroll
                for (int bj = 0; bj < 2; ++bj) { f32x4 v0 = acc[ai][bj][m][0], v1 = acc[ai][bj][m][1];
#pragma unroll
                    for (int e = 0; e < 4; ++e) { const float a = fmaxf(v0[e], 0.f), b = fmaxf(v1[e], 0.f); v0[e] = a * a * r2; v1[e] = b * b * r2; }
                    *(u32x4*)(rowp + bj * HALF) = pack8(v0, v1); } }
    }
};
struct EpiRes {
    static constexpr bool PERM = true, AFTER_DRAIN = false;
    const float* base; float* out; bf16_t* hb; int ldc; const float* gain; float* rowss;
    __device__ __forceinline__ void operator()(const f32x4 (&acc)[2][2][4][2], const Unit& u, int wr, int wc, int fr, int fq) const {
        const int row0 = u.pm * BM + wr * 64 + fr, col0 = u.pn * BM + wc * 32 + 8 * fq;
        f32x4 g[2][2];
#pragma unroll
        for (int bj = 0; bj < 2; ++bj)
#pragma unroll
            for (int n = 0; n < 2; ++n) g[bj][n] = gain ? *(const f32x4*)(gain + col0 + bj * HALF + 4 * n) : (f32x4){1.f, 1.f, 1.f, 1.f};
#pragma unroll
        for (int ai = 0; ai < 2; ++ai)
#pragma unroll
            for (int m = 0; m < 4; ++m) { const int row = row0 + ai * HALF + m * 16; const size_t off = (size_t)row * ldc + col0; float ss = 0.f;
#pragma unroll
                for (int bj = 0; bj < 2; ++bj) { const f32x4 b0 = *(const f32x4*)(base + off + bj * HALF), b1 = *(const f32x4*)(base + off + bj * HALF + 4);
                    const f32x4 v0 = acc[ai][bj][m][0] + b0, v1 = acc[ai][bj][m][1] + b1;
                    *(f32x4*)(out + off + bj * HALF) = v0; *(f32x4*)(out + off + bj * HALF + 4) = v1;
                    ss += (v0[0] * v0[0] + v0[1] * v0[1]) + (v0[2] * v0[2] + v0[3] * v0[3]) + (v1[0] * v1[0] + v1[1] * v1[1]) + (v1[2] * v1[2] + v1[3] * v1[3]);
                    *(u32x4*)(hb + off + bj * HALF) = pack8(v0 * g[bj][0], v1 * g[bj][1]); }
                if (rowss) { ss += __shfl_xor(ss, 16); ss += __shfl_xor(ss, 32); if (fq == 0) atomicAdd(rowss + row, ss); } }
    }
};
struct EpiFinal {
    static constexpr bool PERM = true, AFTER_DRAIN = false;
    float* out; const bf16_t* pe; int ldc; const float* rowss; const float* gple; float inv_nfeat;
    __device__ __forceinline__ void operator()(const f32x4 (&acc)[2][2][4][2], const Unit& u, int wr, int wc, int fr, int fq) const {
        const int row0 = u.pm * BM + wr * 64 + fr, col0 = u.pn * BM + wc * 32 + 8 * fq;
        f32x4 g[2][2];
#pragma unroll
        for (int bj = 0; bj < 2; ++bj)
#pragma unroll
            for (int n = 0; n < 2; ++n) g[bj][n] = *(const f32x4*)(gple + col0 + bj * HALF + 4 * n);
#pragma unroll
        for (int ai = 0; ai < 2; ++ai)
#pragma unroll
            for (int m = 0; m < 4; ++m) { const int row = row0 + ai * HALF + m * 16; const size_t off = (size_t)row * ldc + col0;
                const float rs = 1.0f / sqrtf(rowss[row] * inv_nfeat + RMS_EPS);
#pragma unroll
                for (int bj = 0; bj < 2; ++bj) { const f32x4 b0 = *(const f32x4*)(out + off + bj * HALF), b1 = *(const f32x4*)(out + off + bj * HALF + 4);
                    const u32x4 pw = *(const u32x4*)(pe + off + bj * HALF);
                    const f32x4 p0 = (f32x4){bf_lo(pw.x), bf_hi(pw.x), bf_lo(pw.y), bf_hi(pw.y)}, p1 = (f32x4){bf_lo(pw.z), bf_hi(pw.z), bf_lo(pw.w), bf_hi(pw.w)};
                    f32x4 v0 = acc[ai][bj][m][0], v1 = acc[ai][bj][m][1];
#pragma unroll
                    for (int e = 0; e < 4; ++e) { v0[e] = 1.0f / (1.0f + __expf(-v0[e])); v1[e] = 1.0f / (1.0f + __expf(-v1[e])); }
                    v0 = b0 + v0 * (p0 * g[bj][0]) * rs; v1 = b1 + v1 * (p1 * g[bj][1]) * rs;
                    *(f32x4*)(out + off + bj * HALF) = v0; *(f32x4*)(out + off + bj * HALF + 4) = v1; } }
    }
};

struct EpiResX {
    static constexpr bool PERM = true, AFTER_DRAIN = false;
    const float* base; bf16_t* hb; int ldc; float* rowss;
    __device__ __forceinline__ void operator()(const f32x4 (&acc)[2][2][4][2], const Unit& u, int wr, int wc, int fr, int fq) const {
        const int row0 = u.pm * BM + wr * 64 + fr, col0 = u.pn * BM + wc * 32 + 8 * fq;
#pragma unroll
        for (int ai = 0; ai < 2; ++ai)
#pragma unroll
            for (int m = 0; m < 4; ++m) { const int row = row0 + ai * HALF + m * 16; const size_t off = (size_t)row * ldc + col0; float ss = 0.f;
#pragma unroll
                for (int bj = 0; bj < 2; ++bj) { const f32x4 b0 = *(const f32x4*)(base + off + bj * HALF), b1 = *(const f32x4*)(base + off + bj * HALF + 4);
                    const f32x4 v0 = acc[ai][bj][m][0] + b0, v1 = acc[ai][bj][m][1] + b1;
                    ss += (v0[0] * v0[0] + v0[1] * v0[1]) + (v0[2] * v0[2] + v0[3] * v0[3]) + (v1[0] * v1[0] + v1[1] * v1[1]) + (v1[2] * v1[2] + v1[3] * v1[3]);
                    *(u32x4*)(hb + off + bj * HALF) = pack8(v0, v1); }
                ss += __shfl_xor(ss, 16); ss += __shfl_xor(ss, 32); if (fq == 0) atomicAdd(rowss + row, ss); }
    }
};
struct EpiResB {
    static constexpr bool PERM = true, AFTER_DRAIN = false;
    bf16_t* hb; int ldc;
    __device__ __forceinline__ void operator()(const f32x4 (&acc)[2][2][4][2], const Unit& u, int wr, int wc, int fr, int fq) const {
        const int row0 = u.pm * BM + wr * 64 + fr, col0 = u.pn * BM + wc * 32 + 8 * fq;
#pragma unroll
        for (int ai = 0; ai < 2; ++ai)
#pragma unroll
            for (int m = 0; m < 4; ++m) { const size_t off = (size_t)(row0 + ai * HALF + m * 16) * ldc + col0;
#pragma unroll
                for (int bj = 0; bj < 2; ++bj) { const u32x4 bw = *(const u32x4*)(hb + off + bj * HALF);
                    const f32x4 b0 = (f32x4){bf_lo(bw.x), bf_hi(bw.x), bf_lo(bw.y), bf_hi(bw.y)}, b1 = (f32x4){bf_lo(bw.z), bf_hi(bw.z), bf_lo(bw.w), bf_hi(bw.w)};
                    *(u32x4*)(hb + off + bj * HALF) = pack8(acc[ai][bj][m][0] + b0, acc[ai][bj][m][1] + b1); } }
    }
};
struct EpiFinalB {
    static constexpr bool PERM = true, AFTER_DRAIN = false;
    float* out; const bf16_t* h2; const bf16_t* pe; int ldc; const float* rowss; const float* gple; float inv_nfeat;
    __device__ __forceinline__ void operator()(const f32x4 (&acc)[2][2][4][2], const Unit& u, int wr, int wc, int fr, int fq) const {
        const int row0 = u.pm * BM + wr * 64 + fr, col0 = u.pn * BM + wc * 32 + 8 * fq;
        f32x4 g[2][2];
#pragma unroll
        for (int bj = 0; bj < 2; ++bj)
#pragma unroll
            for (int n = 0; n < 2; ++n) g[bj][n] = *(const f32x4*)(gple + col0 + bj * HALF + 4 * n);
#pragma unroll
        for (int ai = 0; ai < 2; ++ai)
#pragma unroll
            for (int m = 0; m < 4; ++m) { const int row = row0 + ai * HALF + m * 16; const size_t off = (size_t)row * ldc + col0;
                const float rs = 1.0f / sqrtf(rowss[row] * inv_nfeat + RMS_EPS);
#pragma unroll
                for (int bj = 0; bj < 2; ++bj) { const u32x4 bw = *(const u32x4*)(h2 + off + bj * HALF); const u32x4 pw = *(const u32x4*)(pe + off + bj * HALF);
                    const f32x4 b0 = (f32x4){bf_lo(bw.x), bf_hi(bw.x), bf_lo(bw.y), bf_hi(bw.y)}, b1 = (f32x4){bf_lo(bw.z), bf_hi(bw.z), bf_lo(bw.w), bf_hi(bw.w)};
                    const f32x4 p0 = (f32x4){bf_lo(pw.x), bf_hi(pw.x), bf_lo(pw.y), bf_hi(pw.y)}, p1 = (f32x4){bf_lo(pw.z), bf_hi(pw.z), bf_lo(pw.w), bf_hi(pw.w)};
                    f32x4 v0 = acc[ai][bj][m][0], v1 = acc[ai][bj][m][1];
#pragma unroll
                    for (int e = 0; e < 4; ++e) { v0[e] = 1.0f / (1.0f + __expf(-v0[e])); v1[e] = 1.0f / (1.0f + __expf(-v1[e])); }
                    v0 = b0 + v0 * (p0 * g[bj][0]) * rs; v1 = b1 + v1 * (p1 * g[bj][1]) * rs;
                    *(f32x4*)(out + off + bj * HALF) = v0; *(f32x4*)(out + off + bj * HALF + 4) = v1; } }
    }
};
template <class Epi, class Sched, bool ALIGN_EPI = false, bool SP2 = false>
__device__ __forceinline__ void gemm_phase(PG8_LAS unsigned char* lds, const Gemm g, const Sched& S, const Epi& E) {
    const int tid = threadIdx.x, wid = __builtin_amdgcn_readfirstlane(tid >> 6), lane = tid & 63, wr = wid >> 2, wc = wid & 3, fr = lane & 15, fq = lane >> 4;
    const int K = g.K, nt = K / BK;
    unsigned voffA[2], voffB[2];
#pragma unroll
    for (int i = 0; i < 2; ++i) { int R, C; stage_rc(tid * 16 + i * 8192, R, C); const int Rb = Epi::PERM ? ((R & ~31) + perm32(R & 31)) : R;
        voffA[i] = (unsigned)(R * K + C) * 2u; voffB[i] = (unsigned)(Rb * K + C) * 2u; }
    const size_t kstep = (size_t)(BK * 2);
    const size_t hstep = (size_t)HALF * K * 2;
    const size_t tstep = 2 * hstep;
    const unsigned ldsw = (unsigned)wid * 1024u;
    const int aoff = lds_byte(wr * 64 + fr, fq * 8), boff = lds_byte(wc * 32 + fr, fq * 8);
#define PG8_SA(b, h) (((b) * 2 + (h)) * HTB)
#define PG8_SB(b, h) ((4 + (b) * 2 + (h)) * HTB)
#define PG8_STAGE(bufoff, gbase, voff) do { _Pragma("unroll") for (int _i = 0; _i < 2; ++_i) \
        __builtin_amdgcn_global_load_lds((const unsigned*)((const char*)(gbase) + (voff)[_i]), (PG8_LAS unsigned*)(lds + (bufoff) + ldsw + _i * 8192), 16, 0, 0); } while (0)
#define PG8_LDA(dst, b, h) do { _Pragma("unroll") for (int m = 0; m < 4; ++m) _Pragma("unroll") for (int k = 0; k < 2; ++k) dst[m][k] = *(const PG8_LAS bf16x8*)(lds + PG8_SA(b, h) + aoff + m * 2048 + k * 1024); } while (0)
#define PG8_LDB(dst, b, h) do { _Pragma("unroll") for (int n = 0; n < 2; ++n) _Pragma("unroll") for (int k = 0; k < 2; ++k) dst[n][k] = *(const PG8_LAS bf16x8*)(lds + PG8_SB(b, h) + boff + n * 2048 + k * 1024); } while (0)
#define PG8_MMA(ai, bj, At, Bt) do { __builtin_amdgcn_s_setprio(1); _Pragma("unroll") for (int m = 0; m < 4; ++m) _Pragma("unroll") for (int n = 0; n < 2; ++n) _Pragma("unroll") for (int k = 0; k < 2; ++k) \
        acc[ai][bj][m][n] = __builtin_amdgcn_mfma_f32_16x16x32_bf16(Bt[n][k], At[m][k], acc[ai][bj][m][n], 0, 0, 0); __builtin_amdgcn_s_setprio(0); } while (0)
#define PG8_WAIT_V(n) asm volatile("s_waitcnt vmcnt(" #n ")" ::: "memory")
#define PG8_WAIT_L(n) asm volatile("s_waitcnt lgkmcnt(" #n ")" ::: "memory")
#define PG8_BAR __builtin_amdgcn_s_barrier()
#define PG8_SCHED __builtin_amdgcn_sched_barrier(0)
    Unit cur, nxt; int ui = 0;
    if (!S.next(0, cur)) return;
    f32x4 acc[2][2][4][2];
#pragma unroll
    for (int a = 0; a < 2; ++a)
#pragma unroll
        for (int b = 0; b < 2; ++b)
#pragma unroll
            for (int m = 0; m < 4; ++m)
#pragma unroll
                for (int n = 0; n < 2; ++n) acc[a][b][m][n] = (f32x4){0.f, 0.f, 0.f, 0.f};
    bf16x8 At[4][2], B0[2][2], B1[2][2];
    const char* cA = (const char*)g.A + (size_t)cur.pm * tstep; const char* cB = (const char*)g.Bt + (size_t)cur.pn * tstep;
    S.a_ready(cur);
    if constexpr (SP2) {
        PG8_STAGE(PG8_SB(0, 0), cB, voffB); PG8_STAGE(PG8_SB(0, 1), cB + hstep, voffB); PG8_STAGE(PG8_SA(0, 0), cA, voffA); PG8_STAGE(PG8_SA(0, 1), cA + hstep, voffA);
        if (wr == 1) PG8_BAR;
        PG8_WAIT_V(2); PG8_BAR;
        PG8_STAGE(PG8_SB(1, 0), cB + kstep, voffB); PG8_STAGE(PG8_SA(1, 0), cA + kstep, voffA); PG8_STAGE(PG8_SB(1, 1), cB + hstep + kstep, voffB);
        PG8_WAIT_V(6); PG8_BAR;
    } else {
        PG8_STAGE(PG8_SB(0, 0), cB, voffB); PG8_STAGE(PG8_SA(0, 0), cA, voffA); PG8_STAGE(PG8_SB(0, 1), cB + hstep, voffB); PG8_STAGE(PG8_SA(0, 1), cA + hstep, voffA);
        if (wr == 1) PG8_BAR;
        PG8_WAIT_V(4); PG8_BAR;
        PG8_STAGE(PG8_SB(1, 0), cB + kstep, voffB); PG8_STAGE(PG8_SA(1, 0), cA + kstep, voffA); PG8_STAGE(PG8_SB(1, 1), cB + hstep + kstep, voffB);
        PG8_WAIT_V(6); PG8_BAR;
    }
    for (;;) {
        const bool has_next = S.next(ui + 1, nxt);
        const char* nA = has_next ? (const char*)g.A + (size_t)nxt.pm * tstep : cA; const char* nB = has_next ? (const char*)g.Bt + (size_t)nxt.pn * tstep : cB;
        for (int t = 0; t < nt; t += 2) {
            const bool last = (t == nt - 2);
            const char* a1 = cA + (size_t)(t + 1) * kstep;
            const char* a2 = last ? nA : cA + (size_t)(t + 2) * kstep; const char* b2 = last ? nB : cB + (size_t)(t + 2) * kstep;
            const char* a3 = a2 + kstep; const char* b3 = b2 + kstep;
            if (last && has_next) S.a_ready(nxt);
            if constexpr (SP2) {
            PG8_LDB(B0, 0, 0); PG8_LDB(B1, 0, 1); PG8_SCHED; PG8_LDA(At, 0, 0); PG8_STAGE(PG8_SA(1, 1), a1 + hstep, voffA);
            PG8_WAIT_V(8); PG8_WAIT_L(0); PG8_BAR; PG8_MMA(0, 0, At, B0); PG8_MMA(0, 1, At, B1); PG8_BAR; PG8_SCHED;
            PG8_LDA(At, 0, 1); PG8_STAGE(PG8_SB(0, 0), b2, voffB); PG8_STAGE(PG8_SB(0, 1), b2 + hstep, voffB); PG8_STAGE(PG8_SA(0, 0), a2, voffA);
            PG8_WAIT_V(8); PG8_WAIT_L(0); PG8_BAR; PG8_MMA(1, 0, At, B0); PG8_MMA(1, 1, At, B1); PG8_BAR; PG8_SCHED;
            PG8_LDB(B0, 1, 0); PG8_LDB(B1, 1, 1); PG8_SCHED; PG8_LDA(At, 1, 0); PG8_STAGE(PG8_SA(0, 1), a2 + hstep, voffA);
            PG8_WAIT_V(8); PG8_WAIT_L(0); PG8_BAR; PG8_MMA(0, 0, At, B0); PG8_MMA(0, 1, At, B1); PG8_BAR; PG8_SCHED;
            PG8_LDA(At, 1, 1); PG8_STAGE(PG8_SB(1, 0), b3, voffB); PG8_STAGE(PG8_SB(1, 1), b3 + hstep, voffB); PG8_STAGE(PG8_SA(1, 0), a3, voffA);
            PG8_WAIT_V(8); PG8_WAIT_L(0); PG8_BAR; PG8_MMA(1, 0, At, B0); PG8_MMA(1, 1, At, B1); PG8_BAR; PG8_SCHED;
            } else {
            PG8_LDB(B0, 0, 0); PG8_SCHED; PG8_LDA(At, 0, 0); PG8_STAGE(PG8_SA(1, 1), a1 + hstep, voffA);
            PG8_WAIT_L(8); PG8_BAR; PG8_WAIT_L(0); PG8_MMA(0, 0, At, B0); PG8_BAR; PG8_SCHED;
            PG8_LDB(B1, 0, 1); PG8_STAGE(PG8_SB(0, 0), b2, voffB);
            PG8_BAR; PG8_WAIT_L(0); PG8_MMA(0, 1, At, B1); PG8_BAR;
            PG8_LDA(At, 0, 1); PG8_STAGE(PG8_SA(0, 0), a2, voffA);
            PG8_BAR; PG8_WAIT_L(0); PG8_MMA(1, 0, At, B0); PG8_BAR; PG8_SCHED;
            PG8_STAGE(PG8_SB(0, 1), b2 + hstep, voffB);
            PG8_WAIT_V(6); PG8_BAR; PG8_MMA(1, 1, At, B1); PG8_BAR;
            PG8_LDB(B0, 1, 0); PG8_SCHED; PG8_LDA(At, 1, 0); PG8_STAGE(PG8_SA(0, 1), a2 + hstep, voffA);
            PG8_WAIT_L(8); PG8_BAR; PG8_WAIT_L(0); PG8_MMA(0, 0, At, B0); PG8_BAR; PG8_SCHED;
            PG8_LDB(B1, 1, 1); PG8_STAGE(PG8_SB(1, 0), b3, voffB);
            PG8_BAR; PG8_WAIT_L(0); PG8_MMA(0, 1, At, B1); PG8_BAR;
            PG8_LDA(At, 1, 1); PG8_STAGE(PG8_SA(1, 0), a3, voffA);
            PG8_BAR; PG8_WAIT_L(0); PG8_MMA(1, 0, At, B0); PG8_BAR; PG8_SCHED;
            PG8_STAGE(PG8_SB(1, 1), b3 + hstep, voffB);
            PG8_WAIT_V(6); PG8_BAR; PG8_MMA(1, 1, At, B1); PG8_BAR;
            }
        }
        if constexpr (ALIGN_EPI) { if (wr == 0) PG8_BAR; }
        if constexpr (!Epi::AFTER_DRAIN) { E(acc, cur, wr, wc, fr, fq); S.done(cur); }
        if (!has_next) break;
#pragma unroll
        for (int a = 0; a < 2; ++a)
#pragma unroll
            for (int b = 0; b < 2; ++b)
#pragma unroll
                for (int m = 0; m < 4; ++m)
#pragma unroll
                    for (int n = 0; n < 2; ++n) acc[a][b][m][n] = (f32x4){0.f, 0.f, 0.f, 0.f};
        cur = nxt; cA = nA; cB = nB; ++ui;
        if constexpr (ALIGN_EPI) { if (wr == 1) PG8_BAR; }
    }
    PG8_WAIT_V(0);
    if constexpr (!ALIGN_EPI) { if (wr == 0) PG8_BAR; }
    PG8_BAR;
    if constexpr (Epi::AFTER_DRAIN) { E.fused(acc, cur, wr, wc, fr, fq, lds, wid, lane); S.done(cur); }
#undef PG8_SA
#undef PG8_SB
#undef PG8_STAGE
#undef PG8_LDA
#undef PG8_LDB
#undef PG8_MMA
#undef PG8_WAIT_V
#undef PG8_WAIT_L
#undef PG8_BAR
#undef PG8_SCHED
}
}

constexpr int NWAVES = 8, NTHREADS = 512;
constexpr int D_MODEL = 4096, BATCH = 4, SEQ = 2048, M_TOK = BATCH * SEQ, IN_COLS = 9216, D_FF = 16384, PLE_DIM = 256;
constexpr int COL_QA = 0, COL_KA = 2048, COL_VA = 2560, COL_QB = 3072, COL_KB = 5120, COL_VB = 7168;
constexpr float NORM_EPS = 1e-6f;
constexpr float LOG2E = 1.4426950408889634f;
constexpr size_t MiB = 1u << 20;
constexpr size_t WS_CTL = 0;
constexpr size_t WS_ROWSS_MLP = 64 * 1024, WS_ROWSS_PLE = 128 * 1024;
constexpr size_t WS_TAB128 = 1 * MiB;
constexpr size_t WS_TAB64 = 2 * MiB;
constexpr size_t WS_WIN = 4 * MiB, WS_WO = 76 * MiB, WS_WUP = 108 * MiB, WS_WDN = 236 * MiB, WS_WG = 364 * MiB, WS_WPLE = 396 * MiB;
constexpr size_t WS_PB = 398 * MiB;
constexpr size_t WS_XN = 402 * MiB;
constexpr size_t WS_PE = 466 * MiB;
constexpr size_t WS_PROJ = 530 * MiB;
constexpr size_t WS_VTA = 674 * MiB, WS_VTB = 682 * MiB;
constexpr size_t WS_CAT = 714 * MiB;
constexpr size_t WS_U = 530 * MiB;
constexpr size_t WS_OSCR = 786 * MiB;
constexpr size_t WS_KIMG128 = 818 * MiB;
constexpr size_t WS_KIMG64 = 826 * MiB;
constexpr size_t WS_END = 858 * MiB;
constexpr int LDS_BYTES = 147456;

#define GAS __attribute__((address_space(1)))
#define LAS __attribute__((address_space(3)))
typedef unsigned short bf16;
typedef unsigned v4u __attribute__((ext_vector_type(4)));
typedef unsigned v2u __attribute__((ext_vector_type(2)));
typedef float f32x4 __attribute__((ext_vector_type(4)));
typedef float f32x2 __attribute__((ext_vector_type(2)));
typedef short bf16x8 __attribute__((ext_vector_type(8)));
#define LDS_WAIT() asm volatile("s_waitcnt lgkmcnt(0)" ::: "memory")

__device__ __forceinline__ unsigned pk2(float lo, float hi) { unsigned r; asm("v_cvt_pk_bf16_f32 %0, %1, %2" : "=v"(r) : "v"(lo), "v"(hi)); return r; }
__device__ __forceinline__ float bflo(unsigned w) { return __uint_as_float(w << 16); }
__device__ __forceinline__ float bfhi(unsigned w) { return __uint_as_float(w & 0xffff0000u); }
__device__ __forceinline__ float wave_max(float v) {
#pragma unroll
    for (int o = 1; o < 64; o <<= 1) v = fmaxf(v, __shfl_xor(v, o));
    return v;
}
__device__ __forceinline__ float wave_sum(float v) {
#pragma unroll
    for (int o = 1; o < 64; o <<= 1) v += __shfl_xor(v, o);
    return v;
}

struct Args {
    const float *x, *p, *attn_g, *w_in, *qa_g, *ka_g, *sinks, *qb_g, *kb_g, *lq1, *lk1, *lq2, *lk2, *subln_g, *w_o, *mlp_g, *w_up, *w_down, *w_ple, *ple_g, *w_gate;
    float* out; unsigned char* ws; int ph_lo, ph_hi, coop, pad;
};

template <bool NT>
__device__ __forceinline__ void p0_transpose_item(const float* W, int K, int N, bf16* WT, LAS unsigned* scr, int item, int lane, const float* kgain = nullptr) {
    const int nblk = N / 64, kb = item / nblk, nb = item % nblk, k0 = 128 * kb, n0 = 64 * nb;
    const float* src = W + (size_t)k0 * N + n0 + lane;
#pragma unroll 1
    for (int kp0 = 0; kp0 < 64; kp0 += 32) { float a[32], b[32];
#pragma unroll
        for (int i = 0; i < 32; ++i) { const float* pa = src + (size_t)(2 * (kp0 + i)) * N; const float* pb = pa + N; a[i] = NT ? __builtin_nontemporal_load(pa) : *pa; b[i] = NT ? __builtin_nontemporal_load(pb) : *pb; }
#pragma unroll
        for (int i = 0; i < 32; ++i) { float ga = 1.f, gb = 1.f; if (kgain) { ga = kgain[k0 + 2 * (kp0 + i)]; gb = kgain[k0 + 2 * (kp0 + i) + 1]; } scr[(kp0 + i) * 65 + lane] = pk2(a[i] * ga, b[i] * gb); } }
    LDS_WAIT(); asm volatile("" ::: "memory");
    const int c = lane & 15;
#pragma unroll
    for (int j = 0; j < 16; ++j) { const int n = (lane >> 4) + 4 * j; const LAS unsigned* s = scr + (4 * c) * 65 + n;
        v4u o; o.x = s[0 * 65]; o.y = s[1 * 65]; o.z = s[2 * 65]; o.w = s[3 * 65];
        *(v4u*)(WT + (size_t)(n0 + n) * K + k0 + 8 * c) = o; }
    LDS_WAIT(); asm volatile("" ::: "memory");
}
template <bool NT>
__device__ __forceinline__ void convert_wdown(const Args& A, LAS unsigned char* lds, int gw, int NGW, int wave, int lane) {
    LAS unsigned* scr = (LAS unsigned*)(lds + wave * 16640);
    constexpr int I_DN = (D_FF / 128) * (D_MODEL / 64);
    for (int it = gw; it < I_DN; it += NGW) p0_transpose_item<NT>(A.w_down, D_FF, D_MODEL, (bf16*)(A.ws + WS_WDN), scr, it, lane);
}
__device__ __forceinline__ void p0_prologue(const Args& A, LAS unsigned char* lds, int gw, int NGW, int wave, int lane) {
    unsigned char* ws = A.ws;
    LAS unsigned* scr = (LAS unsigned*)(lds + wave * 16640);
    constexpr int I_IN = (D_MODEL / 128) * (IN_COLS / 64), I_O = (D_MODEL / 128) * (D_MODEL / 64), I_UP = (D_MODEL / 128) * (D_FF / 64), I_G = I_O, I_PLE = (PLE_DIM / 128) * (D_MODEL / 64);
    constexpr int NITEMS = I_IN + I_O + I_UP + I_G + I_PLE;
    for (int it = gw; it < NITEMS; it += NGW) {
        int r = it;
        if (r < I_IN) { p0_transpose_item<false>(A.w_in, D_MODEL, IN_COLS, (bf16*)(ws + WS_WIN), scr, r, lane); continue; } r -= I_IN;
        if (r < I_O) { p0_transpose_item<false>(A.w_o, D_MODEL, D_MODEL, (bf16*)(ws + WS_WO), scr, r, lane); continue; } r -= I_O;
        if (r < I_UP) { p0_transpose_item<false>(A.w_up, D_MODEL, D_FF, (bf16*)(ws + WS_WUP), scr, r, lane, A.mlp_g); continue; } r -= I_UP;
        if (r < I_G) { p0_transpose_item<false>(A.w_gate, D_MODEL, D_MODEL, (bf16*)(ws + WS_WG), scr, r, lane); continue; } r -= I_G;
        p0_transpose_item<false>(A.w_ple, PLE_DIM, D_MODEL, (bf16*)(ws + WS_WPLE), scr, r, lane);
    }
    for (int m = gw; m < M_TOK; m += NGW) {
        const f32x4* xr = (const f32x4*)(A.x + (size_t)m * D_MODEL) + lane;
        f32x4 v[16]; float s = 0.f;
#pragma unroll
        for (int j = 0; j < 16; ++j) { v[j] = xr[64 * j]; s += (v[j].x * v[j].x + v[j].y * v[j].y) + (v[j].z * v[j].z + v[j].w * v[j].w); }
        const float rstd = 1.0f / sqrtf(wave_sum(s) * (1.0f / D_MODEL) + NORM_EPS);
        v2u* o8 = (v2u*)((bf16*)(ws + WS_XN) + (size_t)m * D_MODEL) + lane;
        const f32x4* gr = (const f32x4*)A.attn_g + lane;
#pragma unroll
        for (int j = 0; j < 16; ++j) { const f32x4 g = gr[64 * j]; v2u o; o.x = pk2(v[j].x * rstd * g.x, v[j].y * rstd * g.y); o.y = pk2(v[j].z * rstd * g.z, v[j].w * rstd * g.w); o8[64 * j] = o; }
    }
    { const int gt = gw * 64 + lane, NGT = NGW * 64;
      for (int i = gt; i < M_TOK * PLE_DIM / 8; i += NGT) { const f32x4 a = ((const f32x4*)A.p)[2 * i], b = ((const f32x4*)A.p)[2 * i + 1];
          v4u o; o.x = pk2(a.x, a.y); o.y = pk2(a.z, a.w); o.z = pk2(b.x, b.y); o.w = pk2(b.z, b.w); ((v4u*)(ws + WS_PB))[i] = o; }
      for (int i = gt; i < SEQ * 64; i += NGT) { const int pos = i >> 6, j = i & 63;
          const float inv = __builtin_amdgcn_exp2f(-(float)(2 * j) * (1.0f / 128.0f) * 13.287712379549449f); const float ang = (float)pos * inv;
          double xr = (double)ang * 0.15915494309189535; xr -= __builtin_rint(xr); const float fx = (float)xr;
          ((f32x2*)(ws + WS_TAB128))[i] = (f32x2){__builtin_amdgcn_cosf(fx), __builtin_amdgcn_sinf(fx)}; }
      for (int i = gt; i < SEQ * 32; i += NGT) { const int pos = i >> 5, j = i & 31;
          const float inv = __builtin_amdgcn_exp2f(-(float)(2 * j) * (1.0f / 64.0f) * 13.287712379549449f); const float ang = (float)pos * inv;
          double xr = (double)ang * 0.15915494309189535; xr -= __builtin_rint(xr); const float fx = (float)xr;
          ((f32x2*)(ws + WS_TAB64))[i] = (f32x2){__builtin_amdgcn_cosf(fx), __builtin_amdgcn_sinf(fx)}; }
      for (int i = gt; i < M_TOK; i += NGT) { ((float*)(ws + WS_ROWSS_MLP))[i] = 0.f; ((float*)(ws + WS_ROWSS_PLE))[i] = 0.f; }
    }
}

__device__ __forceinline__ void p2_qknorm_rope(const Args& A, LAS unsigned char* lds, int gw, int NGW, int tid, int lane) {
    unsigned char* ws = A.ws; bf16* proj = (bf16*)(ws + WS_PROJ);
    const f32x2* tab128 = (const f32x2*)(ws + WS_TAB128); const f32x2* tab64 = (const f32x2*)(ws + WS_TAB64);
    for (int row = gw; row < M_TOK; row += NGW) {
        const int pos = row & (SEQ - 1); bf16* prow = proj + (size_t)row * IN_COLS;
        { const int ch = lane, col = COL_KA + ch * 8, i = ch & 15;
            const v4u w = *(const v4u*)(prow + col);
            float x[8] = {bflo(w.x), bfhi(w.x), bflo(w.y), bfhi(w.y), bflo(w.z), bfhi(w.z), bflo(w.w), bfhi(w.w)};
            float ss = 0.f;
#pragma unroll
            for (int e = 0; e < 8; ++e) ss += x[e] * x[e];
            ss += __shfl_xor(ss, 1); ss += __shfl_xor(ss, 2); ss += __shfl_xor(ss, 4); ss += __shfl_xor(ss, 8);
            const float rstd = 1.0f / sqrtf(ss * (1.0f / 128.0f) + NORM_EPS);
            const float* gp = A.ka_g + i * 8; const f32x4 g0 = *(const f32x4*)gp, g1 = *(const f32x4*)(gp + 4);
            const float g[8] = {g0.x, g0.y, g0.z, g0.w, g1.x, g1.y, g1.z, g1.w};
            const f32x2* tb = tab128 + pos * 64 + (i & 7) * 8; const float sgn = (i < 8) ? -1.f : 1.f;
            float o[8];
#pragma unroll
            for (int e = 0; e < 8; ++e) { const float y = x[e] * rstd * g[e]; const float py = __shfl_xor(y, 8); const f32x2 cs = tb[e]; o[e] = y * cs.x + sgn * py * cs.y; }
            v4u ow; ow.x = pk2(o[0], o[1]); ow.y = pk2(o[2], o[3]); ow.z = pk2(o[4], o[5]); ow.w = pk2(o[6], o[7]);
            { const int b = row / SEQ, jt = pos >> 6, kl = pos & 63, kvh = ch >> 4, t = 2 * (kl >> 5) + ((kl >> 2) & 1), rr = 4 * ((kl >> 3) & 3) + (kl & 3), c = i >> 2, fq = i & 3;
              int ob = rr * 64 + fq * 16; ob ^= ((ob >> 9) & 1) << 5;
              *(v4u*)(ws + WS_KIMG128 + ((size_t)(((b * 4 + kvh) * 32 + jt) * 16 + t * 4 + c)) * 1024 + ob) = ow; } }
#pragma unroll
        for (int it = 0; it < 4; ++it) { const int ch = it * 64 + lane, col = COL_KB + ch * 8, i = ch & 7;
            const v4u w = *(const v4u*)(prow + col);
            float x[8] = {bflo(w.x), bfhi(w.x), bflo(w.y), bfhi(w.y), bflo(w.z), bfhi(w.z), bflo(w.w), bfhi(w.w)};
            float ss = 0.f;
#pragma unroll
            for (int e = 0; e < 8; ++e) ss += x[e] * x[e];
            ss += __shfl_xor(ss, 1); ss += __shfl_xor(ss, 2); ss += __shfl_xor(ss, 4);
            const float rstd = 1.0f / sqrtf(ss * (1.0f / 64.0f) + NORM_EPS);
            const float* gp = A.kb_g + i * 8; const f32x4 g0 = *(const f32x4*)gp, g1 = *(const f32x4*)(gp + 4);
            const float g[8] = {g0.x, g0.y, g0.z, g0.w, g1.x, g1.y, g1.z, g1.w};
            const f32x2* tb = tab64 + pos * 32 + (i & 3) * 8; const float sgn = (i < 4) ? -1.f : 1.f;
            float o[8];
#pragma unroll
            for (int e = 0; e < 8; ++e) { const float y = x[e] * rstd * g[e]; const float py = __shfl_xor(y, 4); const f32x2 cs = tb[e]; o[e] = y * cs.x + sgn * py * cs.y; }
            v4u ow; ow.x = pk2(o[0], o[1]); ow.y = pk2(o[2], o[3]); ow.z = pk2(o[4], o[5]); ow.w = pk2(o[6], o[7]);
            { const int b = row / SEQ, jt = pos >> 6, kl = pos & 63, mh = ch >> 3, t = 2 * (kl >> 5) + ((kl >> 2) & 1), rr = 4 * ((kl >> 3) & 3) + (kl & 3), c = i >> 2, fq = i & 3;
              int ob = rr * 64 + fq * 16; ob ^= ((ob >> 9) & 1) << 5;
              *(v4u*)(ws + WS_KIMG64 + ((size_t)(((b * 32 + mh) * 32 + jt) * 8 + t * 2 + c)) * 1024 + ob) = ow; } }
    }
    LAS bf16* T = (LAS bf16*)lds;
    for (int tile = blockIdx.x; tile < (M_TOK / 64) * 20; tile += gridDim.x) {
        const int tb = tile / 20, hd = tile % 20, b = tb / (SEQ / 64), s0 = (tb % (SEQ / 64)) * 64;
        const int vcol = hd < 4 ? COL_VA + hd * 128 : COL_VB + (hd - 4) * 128;
        unsigned char* dst = hd < 4 ? ws + WS_VTA + ((size_t)(b * 4 + hd) * 32 + (s0 >> 6)) * 16384 : ws + WS_VTB + ((size_t)(b * 16 + (hd - 4)) * 32 + (s0 >> 6)) * 16384;
#pragma unroll
        for (int k = 0; k < 2; ++k) { const int ci = tid + 512 * k, tok = ci >> 4, dc = ci & 15;
            const v4u w = *(const v4u*)(proj + (size_t)(tb * 64 + tok) * IN_COLS + vcol + dc * 8);
            LAS bf16* t = T + (dc * 8) * 72 + tok;
            t[0 * 72] = (bf16)(w.x & 0xffff); t[1 * 72] = (bf16)(w.x >> 16); t[2 * 72] = (bf16)(w.y & 0xffff); t[3 * 72] = (bf16)(w.y >> 16);
            t[4 * 72] = (bf16)(w.z & 0xffff); t[5 * 72] = (bf16)(w.z >> 16); t[6 * 72] = (bf16)(w.w & 0xffff); t[7 * 72] = (bf16)(w.w >> 16); }
        __syncthreads();
#pragma unroll
        for (int k = 0; k < 2; ++k) { const int ci = tid + 512 * k, d = ci >> 3, tc = ci & 7;
            const v4u w = *(const LAS v4u*)(T + d * 72 + tc * 8);
            const int dtp = 2 * (d >> 5) + ((d >> 2) & 1), rrp = 4 * ((d >> 3) & 3) + (d & 3);
            int ob = rrp * 64 + (tc & 3) * 16; ob ^= ((ob >> 9) & 1) << 5;
            *(v4u*)(dst + (dtp * 2 + (tc >> 2)) * 1024 + ob) = w; }
        __syncthreads();
    }
}

namespace att {
constexpr int BUF_BYTES = 32768, K_OFF = 0, V_OFF = 16384;
constexpr float NEG = -1e30f;
__device__ __forceinline__ int swz(int rr, int fq) { const int ob = rr * 64 + fq * 16; return ob ^ (((ob >> 9) & 1) << 5); }

template <int DK>
__device__ __forceinline__ void dma_tile(LAS unsigned char* buf, const unsigned char* ktile, const unsigned char* vtile, int wave, unsigned lane16) {
    constexpr int NK = 4 * (DK / 32), PER = (NK + 16) / 8;
#pragma unroll
    for (int i = 0; i < PER; ++i) { const int st = wave * PER + i;
        const unsigned char* gp; LAS unsigned char* dst;
        if (st < NK) { gp = ktile + st * 1024 + lane16; dst = buf + K_OFF + st * 1024; }
        else { gp = vtile + (st - NK) * 1024 + lane16; dst = buf + V_OFF + (st - NK) * 1024; }
        __builtin_amdgcn_global_load_lds((const unsigned*)gp, (LAS unsigned*)dst, 16, 0, 0); }
}

template <int DK, bool SWA>
__device__ __forceinline__ void pass(LAS unsigned char* lds, const bf16* Q, int ldq, const float* qgain, const f32x2* qtab, const float qscale, const unsigned char* kimg, const unsigned char* vimg, int q0, int jt_lo, int jt_hi,
                                     float (&mrow)[2], float (&lrow)[2], f32x4 (&O)[2][8], const bool online, const float mfix, int tid, int wave, int lane) {
    constexpr int PER = (4 * (DK / 32) + 16) / 8;
    const int fr = lane & 15, fq = lane >> 4, qw = q0 + 32 * wave;
    const int ntile = jt_hi - jt_lo + 1;
    constexpr int KT_BYTES = 4 * (DK / 32) * 1024; const unsigned lane16 = (unsigned)lane * 16u;
#pragma unroll
    for (int p = 0; p < 2; ++p) if (p < ntile) dma_tile<DK>(lds + p * BUF_BYTES, kimg + (size_t)(jt_lo + p) * KT_BYTES, vimg + (size_t)(jt_lo + p) * 16384, wave, lane16);
    bf16x8 qf[2][DK / 32];
#pragma unroll
    for (int rg = 0; rg < 2; ++rg) {
        const int qrow = qw + 16 * rg + fr;
        float x[DK / 32][8]; float ss = 0.f;
#pragma unroll
        for (int c = 0; c < DK / 32; ++c) { const v4u w = *(const v4u*)(Q + (size_t)qrow * ldq + 32 * c + 8 * fq);
            x[c][0] = bflo(w.x); x[c][1] = bfhi(w.x); x[c][2] = bflo(w.y); x[c][3] = bfhi(w.y); x[c][4] = bflo(w.z); x[c][5] = bfhi(w.z); x[c][6] = bflo(w.w); x[c][7] = bfhi(w.w);
#pragma unroll
            for (int e = 0; e < 8; ++e) ss += x[c][e] * x[c][e]; }
        ss += __shfl_xor(ss, 16); ss += __shfl_xor(ss, 32);
        const float rq = qscale / sqrtf(ss * (1.0f / DK) + NORM_EPS);
#pragma unroll
        for (int c = 0; c < DK / 64; ++c) { const int ch = c + DK / 64;
            const f32x4 ga = *(const f32x4*)(qgain + 32 * c + 8 * fq), gb = *(const f32x4*)(qgain + 32 * c + 8 * fq + 4), gc = *(const f32x4*)(qgain + 32 * ch + 8 * fq), gd = *(const f32x4*)(qgain + 32 * ch + 8 * fq + 4);
            const float gl[8] = {ga.x, ga.y, ga.z, ga.w, gb.x, gb.y, gb.z, gb.w}, gh[8] = {gc.x, gc.y, gc.z, gc.w, gd.x, gd.y, gd.z, gd.w};
            const f32x4* tp = (const f32x4*)(qtab + (size_t)qrow * (DK / 2) + 32 * c + 8 * fq);
            const f32x4 t0 = tp[0], t1 = tp[1], t2 = tp[2], t3 = tp[3];
            const float cs[8] = {t0.x, t0.z, t1.x, t1.z, t2.x, t2.z, t3.x, t3.z}, sn[8] = {t0.y, t0.w, t1.y, t1.w, t2.y, t2.w, t3.y, t3.w};
            float ol[8], oh[8];
#pragma unroll
            for (int e = 0; e < 8; ++e) { const float yl = x[c][e] * gl[e], yh = x[ch][e] * gh[e]; ol[e] = (yl * cs[e] - yh * sn[e]) * rq; oh[e] = (yh * cs[e] + yl * sn[e]) * rq; }
            v4u wl, wh; wl.x = pk2(ol[0], ol[1]); wl.y = pk2(ol[2], ol[3]); wl.z = pk2(ol[4], ol[5]); wl.w = pk2(ol[6], ol[7]);
            wh.x = pk2(oh[0], oh[1]); wh.y = pk2(oh[2], oh[3]); wh.z = pk2(oh[4], oh[5]); wh.w = pk2(oh[6], oh[7]);
            qf[rg][c] = __builtin_bit_cast(bf16x8, wl); qf[rg][ch] = __builtin_bit_cast(bf16x8, wh); }
    }
    const int fro = swz(fr, fq);
    const float sinit = online ? 0.f : -mfix;
#define ATT_PV(pvbuf) do { bf16x8 vfa[4][2], vfb[4][2]; \
        _Pragma("unroll") for (int dt = 0; dt < 4; ++dt) _Pragma("unroll") for (int u = 0; u < 2; ++u) vfa[dt][u] = *(const LAS bf16x8*)((pvbuf) + V_OFF + (dt * 2 + u) * 1024 + fro); \
        _Pragma("unroll") for (int dt = 0; dt < 4; ++dt) _Pragma("unroll") for (int u = 0; u < 2; ++u) vfb[dt][u] = *(const LAS bf16x8*)((pvbuf) + V_OFF + ((dt + 4) * 2 + u) * 1024 + fro); \
        __builtin_amdgcn_s_setprio(1); \
        _Pragma("unroll") for (int dt = 0; dt < 8; ++dt) _Pragma("unroll") for (int u = 0; u < 2; ++u) _Pragma("unroll") for (int rg = 0; rg < 2; ++rg) \
            O[rg][dt] = __builtin_amdgcn_mfma_f32_16x16x32_bf16(dt < 4 ? vfa[dt][u] : vfb[dt - 4][u], pf[rg][u], O[rg][dt], 0, 0, 0); \
        __builtin_amdgcn_s_setprio(0); } while (0)
    const bool lagB = wave >= 4;
    bool pend = false;
    bf16x8 pf[2][2];
#pragma unroll
    for (int rg = 0; rg < 2; ++rg)
#pragma unroll
        for (int u = 0; u < 2; ++u) pf[rg][u] = (bf16x8){0, 0, 0, 0, 0, 0, 0, 0};
    for (int i = 0; i < ntile; ++i) {
        const int jt = jt_lo + i, rem = ntile - 1 - i;
        if (rem >= 1) asm volatile("s_waitcnt vmcnt(%0)" :: "n"(PER) : "memory");
        else asm volatile("s_waitcnt vmcnt(0)" ::: "memory");
        __builtin_amdgcn_s_barrier(); asm volatile("" ::: "memory");
        if (i + 2 < ntile) dma_tile<DK>(lds + ((i + 2) & 3) * BUF_BYTES, kimg + (size_t)(jt + 2) * KT_BYTES, vimg + (size_t)(jt + 2) * 16384, wave, lane16);
        if (lagB && pend) { ATT_PV(lds + ((i - 1) & 3) * BUF_BYTES); pend = false; }
        LAS unsigned char* buf = lds + (i & 3) * BUF_BYTES;
        const int kt0 = jt * 64;
        bool need = kt0 <= qw + 31; if (SWA) need = need && (kt0 + 63 >= qw - 127);
        if (need) {
            f32x4 s[2][4];
            {
                bf16x8 kf[4][DK / 32];
#pragma unroll
                for (int t = 0; t < 4; ++t)
#pragma unroll
                    for (int c = 0; c < DK / 32; ++c) kf[t][c] = *(const LAS bf16x8*)(buf + K_OFF + (t * (DK / 32) + c) * 1024 + fro);
                __builtin_amdgcn_s_setprio(1);
#pragma unroll
                for (int t = 0; t < 4; ++t) {
#pragma unroll
                    for (int rg = 0; rg < 2; ++rg) s[rg][t] = (f32x4){sinit, sinit, sinit, sinit};
#pragma unroll
                    for (int c = 0; c < DK / 32; ++c)
#pragma unroll
                        for (int rg = 0; rg < 2; ++rg) s[rg][t] = __builtin_amdgcn_mfma_f32_16x16x32_bf16(kf[t][c], qf[rg][c], s[rg][t], 0, 0, 0); }
                __builtin_amdgcn_s_setprio(0);
            }
            const bool domask = SWA || (kt0 + 63 > qw);
            if (domask) {
#pragma unroll
                for (int rg = 0; rg < 2; ++rg) { const int q = qw + 16 * rg + fr;
#pragma unroll
                    for (int t = 0; t < 4; ++t)
#pragma unroll
                        for (int i2 = 0; i2 < 4; ++i2) { const int key = kt0 + 32 * (t >> 1) + 8 * fq + 4 * (t & 1) + i2;
                            bool ok = key <= q; if (SWA) ok = ok && (q - key < 128);
                            s[rg][t][i2] = ok ? s[rg][t][i2] : NEG; } }
            }
            if (!online) {
#pragma unroll
                for (int rg = 0; rg < 2; ++rg) {
                    float ps = 0.f;
#pragma unroll
                    for (int t = 0; t < 4; ++t)
#pragma unroll
                        for (int i2 = 0; i2 < 4; ++i2) { const float p = __builtin_amdgcn_exp2f(s[rg][t][i2]); s[rg][t][i2] = p; ps += p; }
                    lrow[rg] += ps;
#pragma unroll
                    for (int u = 0; u < 2; ++u) { v4u w; w.x = pk2(s[rg][2 * u][0], s[rg][2 * u][1]); w.y = pk2(s[rg][2 * u][2], s[rg][2 * u][3]);
                        w.z = pk2(s[rg][2 * u + 1][0], s[rg][2 * u + 1][1]); w.w = pk2(s[rg][2 * u + 1][2], s[rg][2 * u + 1][3]); pf[rg][u] = __builtin_bit_cast(bf16x8, w); }
                }
            } else
#pragma unroll
            for (int rg = 0; rg < 2; ++rg) {
                float mx = NEG;
#pragma unroll
                for (int t = 0; t < 4; ++t) mx = fmaxf(mx, fmaxf(fmaxf(s[rg][t][0], s[rg][t][1]), fmaxf(s[rg][t][2], s[rg][t][3])));
                mx = fmaxf(mx, __shfl_xor(mx, 16)); mx = fmaxf(mx, __shfl_xor(mx, 32));
                const float mnew = fmaxf(mrow[rg], mx), alpha = __builtin_amdgcn_exp2f(mrow[rg] - mnew); mrow[rg] = mnew;
                float ps = 0.f;
#pragma unroll
                for (int t = 0; t < 4; ++t)
#pragma unroll
                    for (int i2 = 0; i2 < 4; ++i2) { const float p = __builtin_amdgcn_exp2f(s[rg][t][i2] - mnew); s[rg][t][i2] = p; ps += p; }
                lrow[rg] = lrow[rg] * alpha + ps;
#pragma unroll
                for (int dt = 0; dt < 8; ++dt) O[rg][dt] = O[rg][dt] * alpha;
#pragma unroll
                for (int u = 0; u < 2; ++u) { v4u w; w.x = pk2(s[rg][2 * u][0], s[rg][2 * u][1]); w.y = pk2(s[rg][2 * u][2], s[rg][2 * u][3]);
                    w.z = pk2(s[rg][2 * u + 1][0], s[rg][2 * u + 1][1]); w.w = pk2(s[rg][2 * u + 1][2], s[rg][2 * u + 1][3]); pf[rg][u] = __builtin_bit_cast(bf16x8, w); }
            }
            if (lagB) pend = true; else ATT_PV(buf);
        }
    }
    if (lagB && pend) ATT_PV(lds + ((ntile - 1) & 3) * BUF_BYTES);
#undef ATT_PV
    __builtin_amdgcn_s_barrier(); asm volatile("" ::: "memory");
}

__device__ __forceinline__ void init_state(float (&m)[2], float (&l)[2], f32x4 (&O)[2][8], float m0) {
#pragma unroll
    for (int rg = 0; rg < 2; ++rg) { m[rg] = m0; l[rg] = 0.f;
#pragma unroll
        for (int dt = 0; dt < 8; ++dt) O[rg][dt] = (f32x4){0.f, 0.f, 0.f, 0.f}; }
}

__device__ __forceinline__ void swa_unit(const Args& A, LAS unsigned char* lds, int unit, const bool online, const float mfix) {
    int tid_ = threadIdx.x; asm volatile("" : "+v"(tid_));
    const int tid = tid_, lane = tid & 63, wave = __builtin_amdgcn_readfirstlane(tid >> 6);
    unsigned char* ws = A.ws; const bf16* proj = (const bf16*)(ws + WS_PROJ);
    const int qb = unit & 7, hq = (unit >> 3) & 15, b = unit >> 7, kvh = hq >> 2, q0 = qb * 256;
    const bf16* Q = proj + (size_t)b * SEQ * IN_COLS + COL_QA + hq * 128;
    const unsigned char* kimg = ws + WS_KIMG128 + (size_t)(b * 4 + kvh) * 32 * 16384;
    const unsigned char* vimg = ws + WS_VTA + (size_t)(b * 4 + kvh) * 32 * 16384;
    float m[2], l[2]; f32x4 O[2][8]; init_state(m, l, O, online ? NEG : mfix);
    const int jt_lo = (4 * qb - 2) > 0 ? 4 * qb - 2 : 0, jt_hi = 4 * qb + 3;
    pass<128, true>(lds, Q, IN_COLS, A.qa_g, (const f32x2*)(ws + WS_TAB128), 0.08838834764831845f * LOG2E, kimg, vimg, q0, jt_lo, jt_hi, m, l, O, online, mfix, tid, wave, lane);
    int lane2 = lane; asm volatile("" : "+v"(lane2));
    const int fr = lane2 & 15, fq = lane2 >> 4; const float sink2 = A.sinks[hq] * LOG2E;
    bf16* cat = (bf16*)(ws + WS_CAT);
#pragma unroll
    for (int rg = 0; rg < 2; ++rg) { float lt = l[rg]; lt += __shfl_xor(lt, 16); lt += __shfl_xor(lt, 32);
        lt += __builtin_amdgcn_exp2f(sink2 - m[rg]); const float inv = 1.0f / lt;
        bf16* orow = cat + (size_t)(b * SEQ + q0 + 32 * wave + 16 * rg + fr) * D_MODEL + hq * 128 + 8 * fq;
#pragma unroll
        for (int k = 0; k < 4; ++k) { const f32x4 o0 = O[rg][2 * k] * inv, o1 = O[rg][2 * k + 1] * inv; v4u w; w.x = pk2(o0[0], o0[1]); w.y = pk2(o0[2], o0[3]); w.z = pk2(o1[0], o1[1]); w.w = pk2(o1[2], o1[3]); *(v4u*)(orow + 32 * k) = w; } }
}
__device__ __forceinline__ void diff_unit(const Args& A, LAS unsigned char* lds, int b, int h, int qb, float lam, const bool online, const float mfix) {
    int tid_ = threadIdx.x; asm volatile("" : "+v"(tid_));
    const int tid = tid_, lane = tid & 63, wave = __builtin_amdgcn_readfirstlane(tid >> 6);
    unsigned char* ws = A.ws; const bf16* proj = (const bf16*)(ws + WS_PROJ);
    const int q0 = qb * 256; const size_t boff = (size_t)b * SEQ * IN_COLS;
    const unsigned char* vimg = ws + WS_VTB + (size_t)(b * 16 + h) * 32 * 16384;
    const int jt_hi = 4 * qb + 3;
    float m[2], l[2]; f32x4 O1[2][8], O0[2][8];
    unsigned char* oscr = ws + WS_OSCR + (size_t)blockIdx.x * 131072; const unsigned tid16 = (unsigned)tid * 16u;
#pragma unroll 1
    for (int mp = 0; mp < 2; ++mp) {
        init_state(m, l, O1, online ? NEG : mfix);
        pass<64, false>(lds, proj + boff + COL_QB + mp * 1024 + h * 64, IN_COLS, A.qb_g, (const f32x2*)(ws + WS_TAB64), 0.125f * LOG2E, ws + WS_KIMG64 + (size_t)((b * 2 + mp) * 16 + h) * 32 * 8192, vimg, q0, 0, jt_hi, m, l, O1, online, mfix, tid, wave, lane);
        if (mp == 0) {
#pragma unroll
            for (int rg = 0; rg < 2; ++rg) { float lt = l[rg]; lt += __shfl_xor(lt, 16); lt += __shfl_xor(lt, 32); const float inv = 1.0f / lt;
#pragma unroll
                for (int dt = 0; dt < 8; ++dt) *(f32x4*)(oscr + (rg * 8 + dt) * 8192 + tid16) = O1[rg][dt] * inv; }
        }
    }
#pragma unroll
    for (int rg = 0; rg < 2; ++rg)
#pragma unroll
        for (int dt = 0; dt < 8; ++dt) O0[rg][dt] = *(const f32x4*)(oscr + (rg * 8 + dt) * 8192 + tid16);
    int lane2 = lane; asm volatile("" : "+v"(lane2));
    const int fr = lane2 & 15, fq = lane2 >> 4;
    bf16* cat = (bf16*)(ws + WS_CAT);
#pragma unroll
    for (int rg = 0; rg < 2; ++rg) { float lt = l[rg]; lt += __shfl_xor(lt, 16); lt += __shfl_xor(lt, 32); const float sc = -lam / lt;
        float ss = 0.f;
#pragma unroll
        for (int dt = 0; dt < 8; ++dt) { const f32x4 o = O0[rg][dt] + O1[rg][dt] * sc; O0[rg][dt] = o; ss += (o[0] * o[0] + o[1] * o[1]) + (o[2] * o[2] + o[3] * o[3]); }
        ss += __shfl_xor(ss, 16); ss += __shfl_xor(ss, 32);
        const float rs = 0.8f / sqrtf(ss * (1.0f / 128.0f) + NORM_EPS);
        bf16* orow = cat + (size_t)(b * SEQ + q0 + 32 * wave + 16 * rg + fr) * D_MODEL + 2048 + h * 128 + 8 * fq;
#pragma unroll
        for (int k = 0; k < 4; ++k) { const f32x4 g0 = *(const f32x4*)(A.subln_g + 32 * k + 8 * fq), g1 = *(const f32x4*)(A.subln_g + 32 * k + 8 * fq + 4); const f32x4 o0 = O0[rg][2 * k] * g0 * rs, o1 = O0[rg][2 * k + 1] * g1 * rs;
            v4u w; w.x = pk2(o0[0], o0[1]); w.y = pk2(o0[2], o0[3]); w.z = pk2(o1[0], o1[1]); w.w = pk2(o1[2], o1[3]); *(v4u*)(orow + 32 * k) = w; } }
}
}

#define RLX_AGENT __ATOMIC_RELAXED, __HIP_MEMORY_SCOPE_AGENT
#define XB_TMO      128
#define XB_XCNT(j)  (256  + 64 * (j))
#define XB_XSUB(j)  (1280 + 64 * (j))
#define XB_XGEN(j)  (2304 + 64 * (j))
#define XB_TOP      3328
#define XB_TOPGEN   3392
#define XCD_BAR_WORDS 3456
#define XB_SPIN_CAP (1u << 18)

__device__ __forceinline__ unsigned xb_ld(unsigned* p)              { return __hip_atomic_load(p, __ATOMIC_RELAXED, __HIP_MEMORY_SCOPE_AGENT); }
__device__ __forceinline__ unsigned xb_add(unsigned* p, unsigned v) { return __hip_atomic_fetch_add(p, v, __ATOMIC_RELAXED, __HIP_MEMORY_SCOPE_AGENT); }
__device__ __forceinline__ unsigned xb_xcc_id() { return (unsigned)__builtin_amdgcn_s_getreg((3 << 11) | 20) & 0xFu; }
#define XB_SPIN(cond, bar) do { unsigned _sp = 0; while (cond) { __builtin_amdgcn_s_sleep(1); \
    if ((++_sp & 255u) == 0u) { if (xb_ld(&(bar)[XB_TMO])) break; if (_sp > XB_SPIN_CAP) { atomicAdd(&(bar)[XB_TMO], 1u); break; } } } } while (0)

struct XcdBarrier {
    unsigned* bar; unsigned x;
    volatile LAS unsigned* st;
};

__device__ __forceinline__ XcdBarrier xcd_barrier_post(unsigned* bar, volatile LAS unsigned* st) {
    XcdBarrier b; b.bar = bar; b.x = xb_xcc_id(); b.st = st;
    if (threadIdx.x == 0) (void)xb_add(&bar[XB_XCNT(b.x)], 1u);
    return b;
}
__device__ __forceinline__ void xcd_barrier_complete(unsigned* bar, unsigned x, unsigned& nloc, unsigned& nx) {
    const unsigned G = gridDim.x * gridDim.y * gridDim.z;
    unsigned sum, cnt, mine, sp = 0u;
    for (;;) {
        sum = 0u; cnt = 0u; mine = 0u;
#pragma unroll
        for (unsigned j = 0; j < 16; ++j) { const unsigned c = xb_ld(&bar[XB_XCNT(j)]); sum += c; cnt += (c > 0u) ? 1u : 0u; mine = (j == x) ? c : mine; }
        if (sum == G) break;
        __builtin_amdgcn_s_sleep(1);
        if ((++sp & 255u) == 0u) { if (xb_ld(&bar[XB_TMO])) break; if (sp > XB_SPIN_CAP) { atomicAdd(&bar[XB_TMO], 1u); break; } }
    }
    nloc = mine > 0u ? mine : 1u; nx = cnt > 0u ? cnt : 1u;
}

__device__ __forceinline__ void xcd_barrier(const XcdBarrier& b) {
    asm volatile("s_waitcnt vmcnt(0)" ::: "memory");
    __syncthreads();
    if (threadIdx.x == 0) {
        unsigned* bar = b.bar;
        __builtin_amdgcn_s_waitcnt(0);
        unsigned nloc = b.st[0], nx = b.st[1];
        if (nloc == 0u) { xcd_barrier_complete(bar, b.x, nloc, nx); b.st[0] = nloc; b.st[1] = nx; }
        const unsigned old = xb_add(&bar[XB_XSUB(b.x)], 1u);
        const unsigned gen = old / nloc;
        if (old + 1u == (gen + 1u) * nloc) {
            __builtin_amdgcn_fence(__ATOMIC_RELEASE, "agent");
            asm volatile("s_waitcnt vmcnt(0)" ::: "memory");
            const unsigned og = xb_add(&bar[XB_TOP], 1u);
            const unsigned tg = og / nx;
            if (og + 1u == (tg + 1u) * nx) xb_add(&bar[XB_TOPGEN], 1u);
            else XB_SPIN(xb_ld(&bar[XB_TOPGEN]) == tg, bar);
            __builtin_amdgcn_fence(__ATOMIC_ACQUIRE, "agent");
            xb_add(&bar[XB_XGEN(b.x)], 1u);
            asm volatile("s_waitcnt vmcnt(0)" ::: "memory");
        } else {
            XB_SPIN(xb_ld(&bar[XB_XGEN(b.x)]) == gen, bar);
            __builtin_amdgcn_fence(__ATOMIC_ACQUIRE, "agent");
            asm volatile("s_waitcnt vmcnt(0)" ::: "memory");
        }
    }
    __syncthreads();
}

#define PG8_SP2 true
#define PG8_ALIGN true
__global__ void __launch_bounds__(NTHREADS, 2) hymba_fwd(Args A) {
    extern __shared__ __attribute__((aligned(16))) unsigned char lds_raw[];
    LAS unsigned char* lds = (LAS unsigned char*)lds_raw;
    const int tid = threadIdx.x, lane = tid & 63, wave = __builtin_amdgcn_readfirstlane(tid >> 6);
    const int G = gridDim.x, gw = blockIdx.x * NWAVES + wave, NGW = G * NWAVES;
    unsigned char* ws = A.ws;
    const int lo = A.ph_lo, hi = A.ph_hi;
#ifndef PHMASK
#define PHMASK 0xff
#endif
#define IN(k) (((PHMASK >> (k)) & 1) && lo <= (k) && (k) < hi)
#ifndef DIAG
#define DIAG 0
#endif
#define STAMP(k) do { if (DIAG && blockIdx.x == 0 && tid == 0) ((unsigned long long*)(ws + 32768))[k] = __builtin_amdgcn_s_memrealtime(); } while (0)
#define SEAM(k) do { if (IN(k) && IN((k) + 1)) { xcd_barrier(bar); } STAMP((k) + 1); } while (0)
    volatile LAS unsigned* MISC = (volatile LAS unsigned*)(lds + LDS_BYTES - 64);
    if (tid < 16) MISC[tid] = 0u;
    __syncthreads();
    XcdBarrier bar; bar.bar = (unsigned*)(ws + WS_CTL); bar.x = 0; bar.st = nullptr;
    if (A.coop) bar = xcd_barrier_post((unsigned*)(ws + WS_CTL), MISC);
    if (A.coop == 2) cg::this_grid().sync();

#ifndef REP0
#define REP0 1
#endif
#ifndef REP3
#define REP3 1
#endif
#ifndef REP5
#define REP5 1
#endif
#ifndef WDOWN_IN_P1
#define WDOWN_IN_P1 1
#endif
    const int p1_rem = WDOWN_IN_P1 ? ((M_TOK / 256) * (IN_COLS / 256)) % G : 0;
    STAMP(0);
    if (IN(0)) { for (int rep = 0; rep < REP0; ++rep) p0_prologue(A, lds, gw, NGW, wave, lane); if (p1_rem == 0) convert_wdown<false>(A, lds, gw, NGW, wave, lane); }
    SEAM(0);
    if (IN(1)) {
        { pg8::Gemm g{(const bf16*)(ws + WS_XN), (const bf16*)(ws + WS_WIN), M_TOK, IN_COLS, D_MODEL}; pg8::StaticOrder S; S.init(M_TOK, IN_COLS, G, (int)blockIdx.x);
          pg8::EpiPlain E{(bf16*)(ws + WS_PROJ), IN_COLS};
          pg8::gemm_phase<pg8::EpiPlain, pg8::StaticOrder, PG8_ALIGN, PG8_SP2>(lds, g, S, E); }
        { pg8::Gemm g{(const bf16*)(ws + WS_PB), (const bf16*)(ws + WS_WPLE), M_TOK, D_MODEL, PLE_DIM}; pg8::StaticOrder S; S.init(M_TOK, D_MODEL, G, (int)blockIdx.x);
          pg8::EpiPle E{(bf16*)(ws + WS_PE), D_MODEL, (float*)(ws + WS_ROWSS_PLE)};
          pg8::gemm_phase<pg8::EpiPle, pg8::StaticOrder, PG8_ALIGN, PG8_SP2>(lds, g, S, E); }
        if (p1_rem != 0 && (int)blockIdx.x >= p1_rem) convert_wdown<true>(A, lds, ((int)blockIdx.x - p1_rem) * NWAVES + wave, (G - p1_rem) * NWAVES, wave, lane);
    }
    SEAM(1);
    if (IN(2)) { p2_qknorm_rope(A, lds, gw, NGW, tid, lane); }
    SEAM(2);
    if (IN(3)) {
        const float s1 = wave_sum(A.lq1[lane] * A.lk1[lane]), s2 = wave_sum(A.lq2[lane] * A.lk2[lane]);
        const float lam = __expf(s1) - __expf(s2) + 0.2f;
        const float gqa = wave_max(fmaxf(fabsf(A.qa_g[lane]), fabsf(A.qa_g[lane + 64]))), gka = wave_max(fmaxf(fabsf(A.ka_g[lane]), fabsf(A.ka_g[lane + 64])));
        const float gqb = wave_max(fabsf(A.qb_g[lane])), gkb = wave_max(fabsf(A.kb_g[lane]));
        const float B128 = gqa * gka * 11.313708499f * LOG2E * 1.02f, B64 = gqb * gkb * 8.0f * LOG2E * 1.02f;
        const bool on128 = !(B128 <= 30.f), on64 = !(B64 <= 30.f);
        for (int rep = 0; rep < REP3; ++rep) {
#ifndef NO_DIFF
#pragma unroll 1
        for (int pr2 = 2 * blockIdx.x; pr2 < 512; pr2 += 2 * G)
#pragma unroll 1
            for (int k = 0; k < 2; ++k) { const int pr = pr2 >> 1, b = pr >> 6, h = (pr >> 2) & 15, pi = pr & 3;
                att::diff_unit(A, lds, b, h, k ? pi : 7 - pi, lam, on64, B64); }
#endif
#ifndef NO_SWA
#pragma unroll 1
        for (int un = blockIdx.x; un < 512; un += G) att::swa_unit(A, lds, un, on128, B128);
#endif
        }
    }
    SEAM(3);
    if (IN(4)) {
        pg8::Gemm g{(const bf16*)(ws + WS_CAT), (const bf16*)(ws + WS_WO), M_TOK, D_MODEL, D_MODEL}; pg8::StaticOrder S; S.init(M_TOK, D_MODEL, G, (int)blockIdx.x);
        pg8::EpiResX E{A.x, (bf16*)(ws + WS_XN), D_MODEL, (float*)(ws + WS_ROWSS_MLP)};
        pg8::gemm_phase<pg8::EpiResX, pg8::StaticOrder, PG8_ALIGN, PG8_SP2>(lds, g, S, E);
    }
    SEAM(4);
    if (IN(5)) {
        pg8::Gemm g{(const bf16*)(ws + WS_XN), (const bf16*)(ws + WS_WUP), M_TOK, D_FF, D_MODEL}; pg8::StaticOrder S; S.init(M_TOK, D_FF, G, (int)blockIdx.x);
        pg8::EpiUp E{(bf16*)(ws + WS_U), D_FF, (const float*)(ws + WS_ROWSS_MLP), 1.0f / D_MODEL};
        for (int rep = 0; rep < REP5; ++rep) pg8::gemm_phase<pg8::EpiUp, pg8::StaticOrder, PG8_ALIGN, PG8_SP2>(lds, g, S, E);
    }
    SEAM(5);
    if (IN(6)) {
        pg8::Gemm g{(const bf16*)(ws + WS_U), (const bf16*)(ws + WS_WDN), M_TOK, D_MODEL, D_FF}; pg8::StaticOrder S; S.init(M_TOK, D_MODEL, G, (int)blockIdx.x);
        pg8::EpiResB E{(bf16*)(ws + WS_XN), D_MODEL};
        pg8::gemm_phase<pg8::EpiResB, pg8::StaticOrder, PG8_ALIGN, PG8_SP2>(lds, g, S, E);
    }
    SEAM(6);
    if (IN(7)) {
        pg8::Gemm g{(const bf16*)(ws + WS_XN), (const bf16*)(ws + WS_WG), M_TOK, D_MODEL, D_MODEL}; pg8::StaticOrder S; S.init(M_TOK, D_MODEL, G, (int)blockIdx.x);
        pg8::EpiFinalB E{A.out, (const bf16*)(ws + WS_XN), (const bf16*)(ws + WS_PE), D_MODEL, (const float*)(ws + WS_ROWSS_PLE), A.ple_g, 1.0f / D_MODEL};
        pg8::gemm_phase<pg8::EpiFinalB, pg8::StaticOrder, PG8_ALIGN, PG8_SP2>(lds, g, S, E);
    }
#if DIAG
    STAMP(8); xcd_barrier(bar);
    if (blockIdx.x == 0 && tid == 0) { const unsigned long long* ts = (const unsigned long long*)(ws + 32768); A.out[0] = (float)(ts[DIAG_B] - ts[DIAG_A]) * 0.01f; }
#endif
#undef IN
#undef SEAM
}

#ifndef MK_PER_PHASE
#define MK_PER_PHASE 0
#endif
extern "C" void kernel_launch(void* const* d_in, const int* in_sizes, int n_in, void* d_out, int out_size, void* d_ws, size_t ws_size, hipStream_t stream) {
    static int grid = 0;
    if (grid == 0) {
        if (n_in != 21 || in_sizes[0] != M_TOK * D_MODEL || out_size != M_TOK * D_MODEL || ws_size < WS_END) { fprintf(stderr, "kernel_launch: unexpected shapes (n_in %d, ws %zu); nothing launched\n", n_in, ws_size); grid = -1; return; }
        int dev = 0, cus = 0, per_cu = 0;
        if (hipGetDevice(&dev) != hipSuccess || hipDeviceGetAttribute(&cus, hipDeviceAttributeMultiprocessorCount, dev) != hipSuccess) { grid = -1; return; }
        if (hipFuncSetAttribute((const void*)hymba_fwd, hipFuncAttributeMaxDynamicSharedMemorySize, LDS_BYTES) != hipSuccess) { fprintf(stderr, "kernel_launch: hipFuncSetAttribute failed\n"); grid = -1; return; }
        if (hipOccupancyMaxActiveBlocksPerMultiprocessor(&per_cu, (const void*)hymba_fwd, NTHREADS, LDS_BYTES) != hipSuccess || per_cu < 1) { fprintf(stderr, "kernel_launch: occupancy query says %d\n", per_cu); per_cu = 1; }
        (void)hipGetLastError();
        grid = cus;
    }
    if (grid < 0) return;
    if (hipMemsetAsync((char*)d_ws + WS_CTL, 0, 16384, stream) != hipSuccess) { fprintf(stderr, "kernel_launch: memset failed\n"); return; }
    Args a{};
    const float** f = (const float**)&a;
    for (int i = 0; i < 21; ++i) f[i] = (const float*)d_in[i];
    a.out = (float*)d_out; a.ws = (unsigned char*)d_ws;
#if MK_PER_PHASE
    for (int ph = 0; ph < 8; ++ph) { a.ph_lo = ph; a.ph_hi = ph + 1; a.coop = 0; hipLaunchKernelGGL(hymba_fwd, dim3(grid), dim3(NTHREADS), LDS_BYTES, stream, a); }
#else
    a.ph_lo = 0; a.ph_hi = 8; a.coop = 1;
    void* args[] = {&a};
    hipError_t e = hipLaunchCooperativeKernel((const void*)hymba_fwd, dim3(grid), dim3(NTHREADS), args, LDS_BYTES, stream);
    if (e != hipSuccess) fprintf(stderr, "kernel_launch: cooperative launch failed: %s (grid %d)\n", hipGetErrorString(e), grid);
#endif
}
```

```cpp
#include <hip/hip_runtime.h>
#include <hip/hip_cooperative_groups.h>
#include <cstdio>
#include <cstdint>
namespace cg = cooperative_groups;
namespace pg8 {
#define PG8_LAS __attribute__((address_space(3)))
typedef unsigned short bf16_t;
typedef short bf16x8 __attribute__((ext_vector_type(8)));
typedef float f32x4 __attribute__((ext_vector_type(4)));
typedef unsigned u32x4 __attribute__((ext_vector_type(4)));
constexpr int BM = 256, BK = 64, HALF = 128, HTB = HALF * BK * 2  , STAGE_BYTES = 8 * HTB, NXCD = 8, WGM = 8;

__host__ __device__ __forceinline__ int lds_byte(int r, int c) { const int st = (r >> 4) * 2 + (c >> 5), rr = r & 15, cc = c & 31, ob = rr * 64 + cc * 2; return st * 1024 + (ob ^ (((ob >> 9) & 1) << 5)); }
__host__ __device__ __forceinline__ void stage_rc(int b, int& R, int& C) { const int st = b / 1024, sb = b % 1024, swz = sb ^ (((sb >> 9) & 1) << 5); R = (st >> 1) * 16 + swz / 64; C = (st & 1) * 32 + (swz % 64) / 2; }
__host__ __device__ __forceinline__ int perm32(int rho) { const int n = rho >> 4, i = rho & 15; return 8 * (i >> 2) + 4 * n + (i & 3); }

struct Unit { int pm, pn; };
struct Gemm { const bf16_t* A; const bf16_t* Bt; int M, N, K; };

struct StaticOrder {
    int nM, nN, nwg, G, c;
    __host__ __device__ void init(int M, int N, int G_, int c_) { nM = M / BM; nN = N / BM; nwg = nM * nN; G = G_; c = c_; }
    __host__ __device__ bool next(int i, Unit& u) const {
        const long L = (long)i * G + c; if (L >= nwg) return false;
        int wgid = (int)L; { const int q = nwg / NXCD, r = nwg % NXCD, xcd = wgid % NXCD, off = wgid / NXCD; wgid = (xcd < r ? xcd * (q + 1) : r * (q + 1) + (xcd - r) * q) + off; }
        const int nig = WGM * nN, gid = wgid / nig, fm = gid * WGM, gsz = (nM - fm) < WGM ? (nM - fm) : WGM;
        u.pm = fm + ((wgid % nig) % gsz); u.pn = (wgid % nig) / gsz; return true;
    }
    __device__ __forceinline__ void a_ready(const Unit&) const {}
    __device__ __forceinline__ void done(const Unit&) const {}
};

__device__ __forceinline__ unsigned cvt_pk_bf16(float lo, float hi) { unsigned r; asm volatile("v_cvt_pk_bf16_f32 %0, %1, %2" : "=v"(r) : "v"(lo), "v"(hi)); return r; }
typedef float f32x2 __attribute__((ext_vector_type(2)));
constexpr float RMS_EPS = 1e-6f;
__device__ __forceinline__ u32x4 pack8(const f32x4 v0, const f32x4 v1) { u32x4 w; w.x = cvt_pk_bf16(v0[0], v0[1]); w.y = cvt_pk_bf16(v0[2], v0[3]); w.z = cvt_pk_bf16(v1[0], v1[1]); w.w = cvt_pk_bf16(v1[2], v1[3]); return w; }
__device__ __forceinline__ float bf_lo(unsigned w) { return __uint_as_float(w << 16); }
__device__ __forceinline__ float bf_hi(unsigned w) { return __uint_as_float(w & 0xffff0000u); }

struct EpiPlain {
    static constexpr bool PERM = true, AFTER_DRAIN = false;
    bf16_t* O; int ldc;
    __device__ __forceinline__ void operator()(const f32x4 (&acc)[2][2][4][2], const Unit& u, int wr, int wc, int fr, int fq) const {
        const int row0 = u.pm * BM + wr * 64 + fr, col0 = u.pn * BM + wc * 32 + 8 * fq;
#pragma unroll
        for (int ai = 0; ai < 2; ++ai)
#pragma unroll
            for (int m = 0; m < 4; ++m) { bf16_t* rowp = O + (size_t)(row0 + ai * HALF + m * 16) * ldc + col0;
#pragma unroll
                for (int bj = 0; bj < 2; ++bj) *(u32x4*)(rowp + bj * HALF) = pack8(acc[ai][bj][m][0], acc[ai][bj][m][1]); }
    }
};
struct EpiPle {
    static constexpr bool PERM = true, AFTER_DRAIN = false;
    bf16_t* O; int ldc; float* rowss;
    __device__ __forceinline__ void operator()(const f32x4 (&acc)[2][2][4][2], const Unit& u, int wr, int wc, int fr, int fq) const {
        const int row0 = u.pm * BM + wr * 64 + fr, col0 = u.pn * BM + wc * 32 + 8 * fq;
#pragma unroll
        for (int ai = 0; ai < 2; ++ai)
#pragma unroll
            for (int m = 0; m < 4; ++m) { const int row = row0 + ai * HALF + m * 16; bf16_t* rowp = O + (size_t)row * ldc + col0; float ss = 0.f;
#pragma unroll
                for (int bj = 0; bj < 2; ++bj) { const f32x4 v0 = acc[ai][bj][m][0], v1 = acc[ai][bj][m][1];
                    ss += (v0[0] * v0[0] + v0[1] * v0[1]) + (v0[2] * v0[2] + v0[3] * v0[3]) + (v1[0] * v1[0] + v1[1] * v1[1]) + (v1[2] * v1[2] + v1[3] * v1[3]);
                    *(u32x4*)(rowp + bj * HALF) = pack8(v0, v1); }
                ss += __shfl_xor(ss, 16); ss += __shfl_xor(ss, 32);
                if (fq == 0) atomicAdd(rowss + row, ss); }
    }
};
struct EpiUp {
    static constexpr bool PERM = true, AFTER_DRAIN = false;
    bf16_t* O; int ldc; const float* rowss; float inv_nfeat;
    __device__ __forceinline__ void operator()(const f32x4 (&acc)[2][2][4][2], const Unit& u, int wr, int wc, int fr, int fq) const {
        const int row0 = u.pm * BM + wr * 64 + fr, col0 = u.pn * BM + wc * 32 + 8 * fq;
#pragma unroll
        for (int ai = 0; ai < 2; ++ai)
#pragma unroll
            for (int m = 0; m < 4; ++m) { const int row = row0 + ai * HALF + m * 16; bf16_t* rowp = O + (size_t)row * ldc + col0;
                const float r2 = 1.0f / (rowss[row] * inv_nfeat + RMS_EPS);
#pragma unroll
                for (int bj = 0; bj < 2; ++bj) { f32x4 v0 = acc[ai][bj][m][0], v1 = acc[ai][bj][m][1];
#pragma unroll
                    for (int e = 0; e < 4; ++e) { const float a = fmaxf(v0[e], 0.f), b = fmaxf(v1[e], 0.f); v0[e] = a * a * r2; v1[e] = b * b * r2; }
                    *(u32x4*)(rowp + bj * HALF) = pack8(v0, v1); } }
    }
};
struct EpiRes {
    static constexpr bool PERM = true, AFTER_DRAIN = false;
    const float* base; float* out; bf16_t* hb; int ldc; const float* gain; float* rowss;
    __device__ __forceinline__ void operator()(const f32x4 (&acc)[2][2][4][2], const Unit& u, int wr, int wc, int fr, int fq) const {
        const int row0 = u.pm * BM + wr * 64 + fr, col0 = u.pn * BM + wc * 32 + 8 * fq;
        f32x4 g[2][2];
#pragma unroll
        for (int bj = 0; bj < 2; ++bj)
#pragma unroll
            for (int n = 0; n < 2; ++n) g[bj][n] = gain ? *(const f32x4*)(gain + col0 + bj * HALF + 4 * n) : (f32x4){1.f, 1.f, 1.f, 1.f};
#pragma unroll
        for (int ai = 0; ai < 2; ++ai)
#pragma unroll
            for (int m = 0; m < 4; ++m) { const int row = row0 + ai * HALF + m * 16; const size_t off = (size_t)row * ldc + col0; float ss = 0.f;
#pragma unroll
                for (int bj = 0; bj < 2; ++bj) { const f32x4 b0 = *(const f32x4*)(base + off + bj * HALF), b1 = *(const f32x4*)(base + off + bj * HALF + 4);
                    const f32x4 v0 = acc[ai][bj][m][0] + b0, v1 = acc[ai][bj][m][1] + b1;
                    *(f32x4*)(out + off + bj * HALF) = v0; *(f32x4*)(out + off + bj * HALF + 4) = v1;
                    ss += (v0[0] * v0[0] + v0[1] * v0[1]) + (v0[2] * v0[2] + v0[3] * v0[3]) + (v1[0] * v1[0] + v1[1] * v1[1]) + (v1[2] * v1[2] + v1[3] * v1[3]);
                    *(u32x4*)(hb + off + bj * HALF) = pack8(v0 * g[bj][0], v1 * g[bj][1]); }
                if (rowss) { ss += __shfl_xor(ss, 16); ss += __shfl_xor(ss, 32); if (fq == 0) atomicAdd(rowss + row, ss); } }
    }
};
struct EpiFinal {
    static constexpr bool PERM = true, AFTER_DRAIN = false;
    float* out; const bf16_t* pe; int ldc; const float* rowss; const float* gple; float inv_nfeat;
    __device__ __forceinline__ void operator()(const f32x4 (&acc)[2][2][4][2], const Unit& u, int wr, int wc, int fr, int fq) const {
        const int row0 = u.pm * BM + wr * 64 + fr, col0 = u.pn * BM + wc * 32 + 8 * fq;
        f32x4 g[2][2];
#pragma unroll
        for (int bj = 0; bj < 2; ++bj)
#pragma unroll
            for (int n = 0; n < 2; ++n) g[bj][n] = *(const f32x4*)(gple + col0 + bj * HALF + 4 * n);
#pragma unroll
        for (int ai = 0; ai < 2; ++ai)
#pragma unroll
            for (int m = 0; m < 4; ++m) { const int row = row0 + ai * HALF + m * 16; const size_t off = (size_t)row * ldc + col0;
                const float rs = 1.0f / sqrtf(rowss[row] * inv_nfeat + RMS_EPS);
#pragma unroll
                for (int bj = 0; bj < 2; ++bj) { const f32x4 b0 = *(const f32x4*)(out + off + bj * HALF), b1 = *(const f32x4*)(out + off + bj * HALF + 4);
                    const u32x4 pw = *(const u32x4*)(pe + off + bj * HALF);
                    const f32x4 p0 = (f32x4){bf_lo(pw.x), bf_hi(pw.x), bf_lo(pw.y), bf_hi(pw.y)}, p1 = (f32x4){bf_lo(pw.z), bf_hi(pw.z), bf_lo(pw.w), bf_hi(pw.w)};
                    f32x4 v0 = acc[ai][bj][m][0], v1 = acc[ai][bj][m][1];
#pragma unroll
                    for (int e = 0; e < 4; ++e) { v0[e] = 1.0f / (1.0f + __expf(-v0[e])); v1[e] = 1.0f / (1.0f + __expf(-v1[e])); }
                    v0 = b0 + v0 * (p0 * g[bj][0]) * rs; v1 = b1 + v1 * (p1 * g[bj][1]) * rs;
                    *(f32x4*)(out + off + bj * HALF) = v0; *(f32x4*)(out + off + bj * HALF + 4) = v1; } }
    }
};

struct EpiResX {
    static constexpr bool PERM = true, AFTER_DRAIN = false;
    const float* base; bf16_t* hb; int ldc; float* rowss;
    __device__ __forceinline__ void operator()(const f32x4 (&acc)[2][2][4][2], const Unit& u, int wr, int wc, int fr, int fq) const {
        const int row0 = u.pm * BM + wr * 64 + fr, col0 = u.pn * BM + wc * 32 + 8 * fq;
#pragma unroll
        for (int ai = 0; ai < 2; ++ai)
#pragma unroll
            for (int m = 0; m < 4; ++m) { const int row = row0 + ai * HALF + m * 16; const size_t off = (size_t)row * ldc + col0; float ss = 0.f;
#pragma unroll
                for (int bj = 0; bj < 2; ++bj) { const f32x4 b0 = *(const f32x4*)(base + off + bj * HALF), b1 = *(const f32x4*)(base + off + bj * HALF + 4);
                    const f32x4 v0 = acc[ai][bj][m][0] + b0, v1 = acc[ai][bj][m][1] + b1;
                    ss += (v0[0] * v0[0] + v0[1] * v0[1]) + (v0[2] * v0[2] + v0[3] * v0[3]) + (v1[0] * v1[0] + v1[1] * v1[1]) + (v1[2] * v1[2] + v1[3] * v1[3]);
                    *(u32x4*)(hb + off + bj * HALF) = pack8(v0, v1); }
                ss += __shfl_xor(ss, 16); ss += __shfl_xor(ss, 32); if (fq == 0) atomicAdd(rowss + row, ss); }
    }
};
struct EpiResB {
    static constexpr bool PERM = true, AFTER_DRAIN = false;
    bf16_t* hb; int ldc;
    __device__ __forceinline__ void operator()(const f32x4 (&acc)[2][2][4][2], const Unit& u, int wr, int wc, int fr, int fq) const {
        const int row0 = u.pm * BM + wr * 64 + fr, col0 = u.pn * BM + wc * 32 + 8 * fq;
#pragma unroll
        for (int ai = 0; ai < 2; ++ai)
#pragma unroll
            for (int m = 0; m < 4; ++m) { const size_t off = (size_t)(row0 + ai * HALF + m * 16) * ldc + col0;
#pragma unroll
                for (int bj = 0; bj < 2; ++bj) { const u32x4 bw = *(const u32x4*)(hb + off + bj * HALF);
                    const f32x4 b0 = (f32x4){bf_lo(bw.x), bf_hi(bw.x), bf_lo(bw.y), bf_hi(bw.y)}, b1 = (f32x4){bf_lo(bw.z), bf_hi(bw.z), bf_lo(bw.w), bf_hi(bw.w)};
                    *(u32x4*)(hb + off + bj * HALF) = pack8(acc[ai][bj][m][0] + b0, acc[ai][bj][m][1] + b1); } }
    }
};
struct EpiFinalB {
    static constexpr bool PERM = true, AFTER_DRAIN = false;
    float* out; const bf16_t* h2; const bf16_t* pe; int ldc; const float* rowss; const float* gple; float inv_nfeat;
    __device__ __forceinline__ void operator()(const f32x4 (&acc)[2][2][4][2], const Unit& u, int wr, int wc, int fr, int fq) const {
        const int row0 = u.pm * BM + wr * 64 + fr, col0 = u.pn * BM + wc * 32 + 8 * fq;
        f32x4 g[2][2];
#pragma unroll
        for (int bj = 0; bj < 2; ++bj)
#pragma unroll
            for (int n = 0; n < 2; ++n) g[bj][n] = *(const f32x4*)(gple + col0 + bj * HALF + 4 * n);
#pragma unroll
        for (int ai = 0; ai < 2; ++ai)
#pragma unroll
            for (int m = 0; m < 4; ++m) { const int row = row0 + ai * HALF + m * 16; const size_t off = (size_t)row * ldc + col0;
                const float rs = 1.0f / sqrtf(rowss[row] * inv_nfeat + RMS_EPS);
#pragma unroll
                for (int bj = 0; bj < 2; ++bj) { const u32x4 bw = *(const u32x4*)(h2 + off + bj * HALF); const u32x4 pw = *(const u32x4*)(pe + off + bj * HALF);
                    const f32x4 b0 = (f32x4){bf_lo(bw.x), bf_hi(bw.x), bf_lo(bw.y), bf_hi(bw.y)}, b1 = (f32x4){bf_lo(bw.z), bf_hi(bw.z), bf_lo(bw.w), bf_hi(bw.w)};
                    const f32x4 p0 = (f32x4){bf_lo(pw.x), bf_hi(pw.x), bf_lo(pw.y), bf_hi(pw.y)}, p1 = (f32x4){bf_lo(pw.z), bf_hi(pw.z), bf_lo(pw.w), bf_hi(pw.w)};
                    f32x4 v0 = acc[ai][bj][m][0], v1 = acc[ai][bj][m][1];
#pragma unroll
                    for (int e = 0; e < 4; ++e) { v0[e] = 1.0f / (1.0f + __expf(-v0[e])); v1[e] = 1.0f / (1.0f + __expf(-v1[e])); }
                    v0 = b0 + v0 * (p0 * g[bj][0]) * rs; v1 = b1 + v1 * (p1 * g[bj][1]) * rs;
                    *(f32x4*)(out + off + bj * HALF) = v0; *(f32x4*)(out + off + bj * HALF + 4) = v1; } }
    }
};
template <class Epi, class Sched, bool ALIGN_EPI = false, bool SP2 = false>
__device__ __forceinline__ void gemm_phase(PG8_LAS unsigned char* lds, const Gemm g, const Sched& S, const Epi& E) {
    const int tid = threadIdx.x, wid = __builtin_amdgcn_readfirstlane(tid >> 6), lane = tid & 63, wr = wid >> 2, wc = wid & 3, fr = lane & 15, fq = lane >> 4;
    const int K = g.K, nt = K / BK;
    unsigned voffA[2], voffB[2];
#pragma unroll
    for (int i = 0; i < 2; ++i) { int R, C; stage_rc(tid * 16 + i * 8192, R, C); const int Rb = Epi::PERM ? ((R & ~31) + perm32(R & 31)) : R;
        voffA[i] = (unsigned)(R * K + C) * 2u; voffB[i] = (unsigned)(Rb * K + C) * 2u; }
    const size_t kstep = (size_t)(BK * 2);
    const size_t hstep = (size_t)HALF * K * 2;
    const size_t tstep = 2 * hstep;
    const unsigned ldsw = (unsigned)wid * 1024u;
    const int aoff = lds_byte(wr * 64 + fr, fq * 8), boff = lds_byte(wc * 32 + fr, fq * 8);
#define PG8_SA(b, h) (((b) * 2 + (h)) * HTB)
#define PG8_SB(b, h) ((4 + (b) * 2 + (h)) * HTB)
#define PG8_STAGE(bufoff, gbase, voff) do { _Pragma("unroll") for (int _i = 0; _i < 2; ++_i) \
        __builtin_amdgcn_global_load_lds((const unsigned*)((const char*)(gbase) + (voff)[_i]), (PG8_LAS unsigned*)(lds + (bufoff) + ldsw + _i * 8192), 16, 0, 0); } while (0)
#define PG8_LDA(dst, b, h) do { _Pragma("unroll") for (int m = 0; m < 4; ++m) _Pragma("unroll") for (int k = 0; k < 2; ++k) dst[m][k] = *(const PG8_LAS bf16x8*)(lds + PG8_SA(b, h) + aoff + m * 2048 + k * 1024); } while (0)
#define PG8_LDB(dst, b, h) do { _Pragma("unroll") for (int n = 0; n < 2; ++n) _Pragma("unroll") for (int k = 0; k < 2; ++k) dst[n][k] = *(const PG8_LAS bf16x8*)(lds + PG8_SB(b, h) + boff + n * 2048 + k * 1024); } while (0)
#define PG8_MMA(ai, bj, At, Bt) do { __builtin_amdgcn_s_setprio(1); _Pragma("unroll") for (int m = 0; m < 4; ++m) _Pragma("unroll") for (int n = 0; n < 2; ++n) _Pragma("unroll") for (int k = 0; k < 2; ++k) \
        acc[ai][bj][m][n] = __builtin_amdgcn_mfma_f32_16x16x32_bf16(Bt[n][k], At[m][k], acc[ai][bj][m][n], 0, 0, 0); __builtin_amdgcn_s_setprio(0); } while (0)
#define PG8_WAIT_V(n) asm volatile("s_waitcnt vmcnt(" #n ")" ::: "memory")
#define PG8_WAIT_L(n) asm volatile("s_waitcnt lgkmcnt(" #n ")" ::: "memory")
#define PG8_BAR __builtin_amdgcn_s_barrier()
#define PG8_SCHED __builtin_amdgcn_sched_barrier(0)
    Unit cur, nxt; int ui = 0;
    if (!S.next(0, cur)) return;
    f32x4 acc[2][2][4][2];
#pragma unroll
    for (int a = 0; a < 2; ++a)
#pragma unroll
        for (int b = 0; b < 2; ++b)
#pragma unroll
            for (int m = 0; m < 4; ++m)
#pragma unroll
                for (int n = 0; n < 2; ++n) acc[a][b][m][n] = (f32x4){0.f, 0.f, 0.f, 0.f};
    bf16x8 At[4][2], B0[2][2], B1[2][2];
    const char* cA = (const char*)g.A + (size_t)cur.pm * tstep; const char* cB = (const char*)g.Bt + (size_t)cur.pn * tstep;
    S.a_ready(cur);
    if constexpr (SP2) {
        PG8_STAGE(PG8_SB(0, 0), cB, voffB); PG8_STAGE(PG8_SB(0, 1), cB + hstep, voffB); PG8_STAGE(PG8_SA(0, 0), cA, voffA); PG8_STAGE(PG8_SA(0, 1), cA + hstep, voffA);
        if (wr == 1) PG8_BAR;
        PG8_WAIT_V(2); PG8_BAR;
        PG8_STAGE(PG8_SB(1, 0), cB + kstep, voffB); PG8_STAGE(PG8_SA(1, 0), cA + kstep, voffA); PG8_STAGE(PG8_SB(1, 1), cB + hstep + kstep, voffB);
        PG8_WAIT_V(6); PG8_BAR;
    } else {
        PG8_STAGE(PG8_SB(0, 0), cB, voffB); PG8_STAGE(PG8_SA(0, 0), cA, voffA); PG8_STAGE(PG8_SB(0, 1), cB + hstep, voffB); PG8_STAGE(PG8_SA(0, 1), cA + hstep, voffA);
        if (wr == 1) PG8_BAR;
        PG8_WAIT_V(4); PG8_BAR;
        PG8_STAGE(PG8_SB(1, 0), cB + kstep, voffB); PG8_STAGE(PG8_SA(1, 0), cA + kstep, voffA); PG8_STAGE(PG8_SB(1, 1), cB + hstep + kstep, voffB);
        PG8_WAIT_V(6); PG8_BAR;
    }
    for (;;) {
        const bool has_next = S.next(ui + 1, nxt);
        const char* nA = has_next ? (const char*)g.A + (size_t)nxt.pm * tstep : cA; const char* nB = has_next ? (const char*)g.Bt + (size_t)nxt.pn * tstep : cB;
        for (int t = 0; t < nt; t += 2) {
            const bool last = (t == nt - 2);
            const char* a1 = cA + (size_t)(t + 1) * kstep;
            const char* a2 = last ? nA : cA + (size_t)(t + 2) * kstep; const char* b2 = last ? nB : cB + (size_t)(t + 2) * kstep;
            const char* a3 = a2 + kstep; const char* b3 = b2 + kstep;
            if (last && has_next) S.a_ready(nxt);
            if constexpr (SP2) {
            PG8_LDB(B0, 0, 0); PG8_LDB(B1, 0, 1); PG8_SCHED; PG8_LDA(At, 0, 0); PG8_STAGE(PG8_SA(1, 1), a1 + hstep, voffA);
            PG8_WAIT_V(8); PG8_WAIT_L(0); PG8_BAR; PG8_MMA(0, 0, At, B0); PG8_MMA(0, 1, At, B1); PG8_BAR; PG8_SCHED;
            PG8_LDA(At, 0, 1); PG8_STAGE(PG8_SB(0, 0), b2, voffB); PG8_STAGE(PG8_SB(0, 1), b2 + hstep, voffB); PG8_STAGE(PG8_SA(0, 0), a2, voffA);
            PG8_WAIT_V(8); PG8_WAIT_L(0); PG8_BAR; PG8_MMA(1, 0, At, B0); PG8_MMA(1, 1, At, B1); PG8_BAR; PG8_SCHED;
            PG8_LDB(B0, 1, 0); PG8_LDB(B1, 1, 1); PG8_SCHED; PG8_LDA(At, 1, 0); PG8_STAGE(PG8_SA(0, 1), a2 + hstep, voffA);
            PG8_WAIT_V(8); PG8_WAIT_L(0); PG8_BAR; PG8_MMA(0, 0, At, B0); PG8_MMA(0, 1, At, B1); PG8_BAR; PG8_SCHED;
            PG8_LDA(At, 1, 1); PG8_STAGE(PG8_SB(1, 0), b3, voffB); PG8_STAGE(PG8_SB(1, 1), b3 + hstep, voffB); PG8_STAGE(PG8_SA(1, 0), a3, voffA);
            PG8_WAIT_V(8); PG8_WAIT_L(0); PG8_BAR; PG8_MMA(1, 0, At, B0); PG8_MMA(1, 1, At, B1); PG8_BAR; PG8_SCHED;
            } else {
            PG8_LDB(B0, 0, 0); PG8_SCHED; PG8_LDA(At, 0, 0); PG8_STAGE(PG8_SA(1, 1), a1 + hstep, voffA);
            PG8_WAIT_L(8); PG8_BAR; PG8_WAIT_L(0); PG8_MMA(0, 0, At, B0); PG8_BAR; PG8_SCHED;
            PG8_LDB(B1, 0, 1); PG8_STAGE(PG8_SB(0, 0), b2, voffB);
            PG8_BAR; PG8_WAIT_L(0); PG8_MMA(0, 1, At, B1); PG8_BAR;
            PG8_LDA(At, 0, 1); PG8_STAGE(PG8_SA(0, 0), a2, voffA);
            PG8_BAR; PG8_WAIT_L(0); PG8_MMA(1, 0, At, B0); PG8_BAR; PG8_SCHED;
            PG8_STAGE(PG8_SB(0, 1), b2 + hstep, voffB);
            PG8_WAIT_V(6); PG8_BAR; PG8_MMA(1, 1, At, B1); PG8_BAR;
            PG8_LDB(B0, 1, 0); PG8_SCHED; PG8_LDA(At, 1, 0); PG8_STAGE(PG8_SA(0, 1), a2 + hstep, voffA);
            PG8_WAIT_L(8); PG8_BAR; PG8_WAIT_L(0); PG8_MMA(0, 0, At, B0); PG8_BAR; PG8_SCHED;
            PG8_LDB(B1, 1, 1); PG8_STAGE(PG8_SB(1, 0), b3, voffB);
            PG8_BAR; PG8_WAIT_L(0); PG8_MMA(0, 1, At, B1); PG8_BAR;
            PG8_LDA(At, 1, 1); PG8_STAGE(PG8_SA(1, 0), a3, voffA);
            PG8_BAR; PG8_WAIT_L(0); PG8_MMA(1, 0, At, B0); PG8_BAR; PG8_SCHED;
            PG8_STAGE(PG8_SB(1, 1), b3 + hstep, voffB);
            PG8_WAIT_V(6); PG8_BAR; PG8_MMA(1, 1, At, B1); PG8_BAR;
            }
        }
        if constexpr (ALIGN_EPI) { if (wr == 0) PG8_BAR; }
        if constexpr (!Epi::AFTER_DRAIN) { E(acc, cur, wr, wc, fr, fq); S.done(cur); }
        if (!has_next) break;
#pragma unroll
        for (int a = 0; a < 2; ++a)
#pragma unroll
            for (int b = 0; b < 2; ++b)
#pragma unroll
                for (int m = 0; m < 4; ++m)
#pragma unroll
                    for (int n = 0; n < 2; ++n) acc[a][b][m][n] = (f32x4){0.f, 0.f, 0.f, 0.f};
        cur = nxt; cA = nA; cB = nB; ++ui;
        if constexpr (ALIGN_EPI) { if (wr == 1) PG8_BAR; }
    }
    PG8_WAIT_V(0);
    if constexpr (!ALIGN_EPI) { if (wr == 0) PG8_BAR; }
    PG8_BAR;
    if constexpr (Epi::AFTER_DRAIN) { E.fused(acc, cur, wr, wc, fr, fq, lds, wid, lane); S.done(cur); }
#undef PG8_SA
#undef PG8_SB
#undef PG8_STAGE
#undef PG8_LDA
#undef PG8_LDB
#undef PG8_MMA
#undef PG8_WAIT_V
#undef PG8_WAIT_L
#undef PG8_BAR
#undef PG8_SCHED
}
}

constexpr int NWAVES = 8, NTHREADS = 512;
constexpr int D_MODEL = 4096, BATCH = 4, SEQ = 2048, M_TOK = BATCH * SEQ, IN_COLS = 9216, D_FF = 16384, PLE_DIM = 256;
constexpr int COL_QA = 0, COL_KA = 2048, COL_VA = 2560, COL_QB = 3072, COL_KB = 5120, COL_VB = 7168;
constexpr float NORM_EPS = 1e-6f;
constexpr float LOG2E = 1.4426950408889634f;
constexpr size_t MiB = 1u << 20;
constexpr size_t WS_CTL = 0;
constexpr size_t WS_ROWSS_MLP = 64 * 1024, WS_ROWSS_PLE = 128 * 1024;
constexpr size_t WS_TAB128 = 1 * MiB;
constexpr size_t WS_TAB64 = 2 * MiB;
constexpr size_t WS_WIN = 4 * MiB, WS_WO = 76 * MiB, WS_WUP = 108 * MiB, WS_WDN = 236 * MiB, WS_WG = 364 * MiB, WS_WPLE = 396 * MiB;
constexpr size_t WS_PB = 398 * MiB;
constexpr size_t WS_XN = 402 * MiB;
constexpr size_t WS_PE = 466 * MiB;
constexpr size_t WS_PROJ = 530 * MiB;
constexpr size_t WS_VTA = 674 * MiB, WS_VTB = 682 * MiB;
constexpr size_t WS_CAT = 714 * MiB;
constexpr size_t WS_U = 530 * MiB;
constexpr size_t WS_OSCR = 786 * MiB;
constexpr size_t WS_KIMG128 = 818 * MiB;
constexpr size_t WS_KIMG64 = 826 * MiB;
constexpr size_t WS_END = 858 * MiB;
constexpr int LDS_BYTES = 147456;

#define GAS __attribute__((address_space(1)))
#define LAS __attribute__((address_space(3)))
typedef unsigned short bf16;
typedef unsigned v4u __attribute__((ext_vector_type(4)));
typedef unsigned v2u __attribute__((ext_vector_type(2)));
typedef float f32x4 __attribute__((ext_vector_type(4)));
typedef float f32x2 __attribute__((ext_vector_type(2)));
typedef short bf16x8 __attribute__((ext_vector_type(8)));
#define LDS_WAIT() asm volatile("s_waitcnt lgkmcnt(0)" ::: "memory")

__device__ __forceinline__ unsigned pk2(float lo, float hi) { unsigned r; asm("v_cvt_pk_bf16_f32 %0, %1, %2" : "=v"(r) : "v"(lo), "v"(hi)); return r; }
__device__ __forceinline__ float bflo(unsigned w) { return __uint_as_float(w << 16); }
__device__ __forceinline__ float bfhi(unsigned w) { return __uint_as_float(w & 0xffff0000u); }
__device__ __forceinline__ float wave_max(float v) {
#pragma unroll
    for (int o = 1; o < 64; o <<= 1) v = fmaxf(v, __shfl_xor(v, o));
    return v;
}
__device__ __forceinline__ float wave_sum(float v) {
#pragma unroll
    for (int o = 1; o < 64; o <<= 1) v += __shfl_xor(v, o);
    return v;
}

struct Args {
    const float *x, *p, *attn_g, *w_in, *qa_g, *ka_g, *sinks, *qb_g, *kb_g, *lq1, *lk1, *lq2, *lk2, *subln_g, *w_o, *mlp_g, *w_up, *w_down, *w_ple, *ple_g, *w_gate;
    float* out; unsigned char* ws; int ph_lo, ph_hi, coop, pad;
};

template <bool NT>
__device__ __forceinline__ void p0_transpose_item(const float* W, int K, int N, bf16* WT, LAS unsigned* scr, int item, int lane, const float* kgain = nullptr) {
    const int nblk = N / 64, kb = item / nblk, nb = item % nblk, k0 = 128 * kb, n0 = 64 * nb;
    const float* src = W + (size_t)k0 * N + n0 + lane;
#pragma unroll 1
    for (int kp0 = 0; kp0 < 64; kp0 += 8) { float a[8], b[8];
#pragma unroll
        for (int i = 0; i < 8; ++i) { const float* pa = src + (size_t)(2 * (kp0 + i)) * N; const float* pb = pa + N; a[i] = NT ? __builtin_nontemporal_load(pa) : *pa; b[i] = NT ? __builtin_nontemporal_load(pb) : *pb; }
#pragma unroll
        for (int i = 0; i < 8; ++i) { float ga = 1.f, gb = 1.f; if (kgain) { ga = kgain[k0 + 2 * (kp0 + i)]; gb = kgain[k0 + 2 * (kp0 + i) + 1]; } scr[(kp0 + i) * 65 + lane] = pk2(a[i] * ga, b[i] * gb); } }
    LDS_WAIT(); asm volatile("" ::: "memory");
    const int c = lane & 15;
#pragma unroll
    for (int j = 0; j < 16; ++j) { const int n = (lane >> 4) + 4 * j; const LAS unsigned* s = scr + (4 * c) * 65 + n;
        v4u o; o.x = s[0 * 65]; o.y = s[1 * 65]; o.z = s[2 * 65]; o.w = s[3 * 65];
        *(v4u*)(WT + (size_t)(n0 + n) * K + k0 + 8 * c) = o; }
    LDS_WAIT(); asm volatile("" ::: "memory");
}
template <bool NT>
__device__ __forceinline__ void convert_wdown(const Args& A, LAS unsigned char* lds, int gw, int NGW, int wave, int lane) {
    LAS unsigned* scr = (LAS unsigned*)(lds + wave * 16640);
    constexpr int I_DN = (D_FF / 128) * (D_MODEL / 64);
    for (int it = gw; it < I_DN; it += NGW) p0_transpose_item<NT>(A.w_down, D_FF, D_MODEL, (bf16*)(A.ws + WS_WDN), scr, it, lane);
}
__device__ __forceinline__ void p0_prologue(const Args& A, LAS unsigned char* lds, int gw, int NGW, int wave, int lane) {
    unsigned char* ws = A.ws;
    LAS unsigned* scr = (LAS unsigned*)(lds + wave * 16640);
    constexpr int I_IN = (D_MODEL / 128) * (IN_COLS / 64), I_O = (D_MODEL / 128) * (D_MODEL / 64), I_UP = (D_MODEL / 128) * (D_FF / 64), I_G = I_O, I_PLE = (PLE_DIM / 128) * (D_MODEL / 64);
    constexpr int NITEMS = I_IN + I_O + I_UP + I_G + I_PLE;
    for (int it = gw; it < NITEMS; it += NGW) {
        int r = it;
        if (r < I_IN) { p0_transpose_item<false>(A.w_in, D_MODEL, IN_COLS, (bf16*)(ws + WS_WIN), scr, r, lane); continue; } r -= I_IN;
        if (r < I_O) { p0_transpose_item<false>(A.w_o, D_MODEL, D_MODEL, (bf16*)(ws + WS_WO), scr, r, lane); continue; } r -= I_O;
        if (r < I_UP) { p0_transpose_item<false>(A.w_up, D_MODEL, D_FF, (bf16*)(ws + WS_WUP), scr, r, lane, A.mlp_g); continue; } r -= I_UP;
        if (r < I_G) { p0_transpose_item<false>(A.w_gate, D_MODEL, D_MODEL, (bf16*)(ws + WS_WG), scr, r, lane); continue; } r -= I_G;
        p0_transpose_item<false>(A.w_ple, PLE_DIM, D_MODEL, (bf16*)(ws + WS_WPLE), scr, r, lane);
    }
    for (int m = gw; m < M_TOK; m += NGW) {
        const f32x4* xr = (const f32x4*)(A.x + (size_t)m * D_MODEL) + lane;
        f32x4 v[16]; float s = 0.f;
#pragma unroll
        for (int j = 0; j < 16; ++j) { v[j] = xr[64 * j]; s += (v[j].x * v[j].x + v[j].y * v[j].y) + (v[j].z * v[j].z + v[j].w * v[j].w); }
        const float rstd = 1.0f / sqrtf(wave_sum(s) * (1.0f / D_MODEL) + NORM_EPS);
        v2u* o8 = (v2u*)((bf16*)(ws + WS_XN) + (size_t)m * D_MODEL) + lane;
        const f32x4* gr = (const f32x4*)A.attn_g + lane;
#pragma unroll
        for (int j = 0; j < 16; ++j) { const f32x4 g = gr[64 * j]; v2u o; o.x = pk2(v[j].x * rstd * g.x, v[j].y * rstd * g.y); o.y = pk2(v[j].z * rstd * g.z, v[j].w * rstd * g.w); o8[64 * j] = o; }
    }
    { const int gt = gw * 64 + lane, NGT = NGW * 64;
      for (int i = gt; i < M_TOK * PLE_DIM / 8; i += NGT) { const f32x4 a = ((const f32x4*)A.p)[2 * i], b = ((const f32x4*)A.p)[2 * i + 1];
          v4u o; o.x = pk2(a.x, a.y); o.y = pk2(a.z, a.w); o.z = pk2(b.x, b.y); o.w = pk2(b.z, b.w); ((v4u*)(ws + WS_PB))[i] = o; }
      for (int i = gt; i < SEQ * 64; i += NGT) { const int pos = i >> 6, j = i & 63;
          const float inv = __builtin_amdgcn_exp2f(-(float)(2 * j) * (1.0f / 128.0f) * 13.287712379549449f); const float ang = (float)pos * inv;
          double xr = (double)ang * 0.15915494309189535; xr -= __builtin_rint(xr); const float fx = (float)xr;
          ((f32x2*)(ws + WS_TAB128))[i] = (f32x2){__builtin_amdgcn_cosf(fx), __builtin_amdgcn_sinf(fx)}; }
      for (int i = gt; i < SEQ * 32; i += NGT) { const int pos = i >> 5, j = i & 31;
          const float inv = __builtin_amdgcn_exp2f(-(float)(2 * j) * (1.0f / 64.0f) * 13.287712379549449f); const float ang = (float)pos * inv;
          double xr = (double)ang * 0.15915494309189535; xr -= __builtin_rint(xr); const float fx = (float)xr;
          ((f32x2*)(ws + WS_TAB64))[i] = (f32x2){__builtin_amdgcn_cosf(fx), __builtin_amdgcn_sinf(fx)}; }
      for (int i = gt; i < M_TOK; i += NGT) { ((float*)(ws + WS_ROWSS_MLP))[i] = 0.f; ((float*)(ws + WS_ROWSS_PLE))[i] = 0.f; }
    }
}

__device__ __forceinline__ void p2_qknorm_rope(const Args& A, LAS unsigned char* lds, int gw, int NGW, int tid, int lane) {
    unsigned char* ws = A.ws; bf16* proj = (bf16*)(ws + WS_PROJ);
    const f32x2* tab128 = (const f32x2*)(ws + WS_TAB128); const f32x2* tab64 = (const f32x2*)(ws + WS_TAB64);
    for (int row = gw; row < M_TOK; row += NGW) {
        const int pos = row & (SEQ - 1); bf16* prow = proj + (size_t)row * IN_COLS;
        { const int ch = lane, col = COL_KA + ch * 8, i = ch & 15;
            const v4u w = *(const v4u*)(prow + col);
            float x[8] = {bflo(w.x), bfhi(w.x), bflo(w.y), bfhi(w.y), bflo(w.z), bfhi(w.z), bflo(w.w), bfhi(w.w)};
            float ss = 0.f;
#pragma unroll
            for (int e = 0; e < 8; ++e) ss += x[e] * x[e];
            ss += __shfl_xor(ss, 1); ss += __shfl_xor(ss, 2); ss += __shfl_xor(ss, 4); ss += __shfl_xor(ss, 8);
            const float rstd = 1.0f / sqrtf(ss * (1.0f / 128.0f) + NORM_EPS);
            const float* gp = A.ka_g + i * 8; const f32x4 g0 = *(const f32x4*)gp, g1 = *(const f32x4*)(gp + 4);
            const float g[8] = {g0.x, g0.y, g0.z, g0.w, g1.x, g1.y, g1.z, g1.w};
            const f32x2* tb = tab128 + pos * 64 + (i & 7) * 8; const float sgn = (i < 8) ? -1.f : 1.f;
            float o[8];
#pragma unroll
            for (int e = 0; e < 8; ++e) { const float y = x[e] * rstd * g[e]; const float py = __shfl_xor(y, 8); const f32x2 cs = tb[e]; o[e] = y * cs.x + sgn * py * cs.y; }
            v4u ow; ow.x = pk2(o[0], o[1]); ow.y = pk2(o[2], o[3]); ow.z = pk2(o[4], o[5]); ow.w = pk2(o[6], o[7]);
            { const int b = row / SEQ, jt = pos >> 6, kl = pos & 63, kvh = ch >> 4, t = 2 * (kl >> 5) + ((kl >> 2) & 1), rr = 4 * ((kl >> 3) & 3) + (kl & 3), c = i >> 2, fq = i & 3;
              int ob = rr * 64 + fq * 16; ob ^= ((ob >> 9) & 1) << 5;
              *(v4u*)(ws + WS_KIMG128 + ((size_t)(((b * 4 + kvh) * 32 + jt) * 16 + t * 4 + c)) * 1024 + ob) = ow; } }
#pragma unroll
        for (int it = 0; it < 4; ++it) { const int ch = it * 64 + lane, col = COL_KB + ch * 8, i = ch & 7;
            const v4u w = *(const v4u*)(prow + col);
            float x[8] = {bflo(w.x), bfhi(w.x), bflo(w.y), bfhi(w.y), bflo(w.z), bfhi(w.z), bflo(w.w), bfhi(w.w)};
            float ss = 0.f;
#pragma unroll
            for (int e = 0; e < 8; ++e) ss += x[e] * x[e];
            ss += __shfl_xor(ss, 1); ss += __shfl_xor(ss, 2); ss += __shfl_xor(ss, 4);
            const float rstd = 1.0f / sqrtf(ss * (1.0f / 64.0f) + NORM_EPS);
            const float* gp = A.kb_g + i * 8; const f32x4 g0 = *(const f32x4*)gp, g1 = *(const f32x4*)(gp + 4);
            const float g[8] = {g0.x, g0.y, g0.z, g0.w, g1.x, g1.y, g1.z, g1.w};
            const f32x2* tb = tab64 + pos * 32 + (i & 3) * 8; const float sgn = (i < 4) ? -1.f : 1.f;
            float o[8];
#pragma unroll
            for (int e = 0; e < 8; ++e) { const float y = x[e] * rstd * g[e]; const float py = __shfl_xor(y, 4); const f32x2 cs = tb[e]; o[e] = y * cs.x + sgn * py * cs.y; }
            v4u ow; ow.x = pk2(o[0], o[1]); ow.y = pk2(o[2], o[3]); ow.z = pk2(o[4], o[5]); ow.w = pk2(o[6], o[7]);
            { const int b = row / SEQ, jt = pos >> 6, kl = pos & 63, mh = ch >> 3, t = 2 * (kl >> 5) + ((kl >> 2) & 1), rr = 4 * ((kl >> 3) & 3) + (kl & 3), c = i >> 2, fq = i & 3;
              int ob = rr * 64 + fq * 16; ob ^= ((ob >> 9) & 1) << 5;
              *(v4u*)(ws + WS_KIMG64 + ((size_t)(((b * 32 + mh) * 32 + jt) * 8 + t * 2 + c)) * 1024 + ob) = ow; } }
    }
    LAS bf16* T = (LAS bf16*)lds;
    for (int tile = blockIdx.x; tile < (M_TOK / 64) * 20; tile += gridDim.x) {
        const int tb = tile / 20, hd = tile % 20, b = tb / (SEQ / 64), s0 = (tb % (SEQ / 64)) * 64;
        const int vcol = hd < 4 ? COL_VA + hd * 128 : COL_VB + (hd - 4) * 128;
        unsigned char* dst = hd < 4 ? ws + WS_VTA + ((size_t)(b * 4 + hd) * 32 + (s0 >> 6)) * 16384 : ws + WS_VTB + ((size_t)(b * 16 + (hd - 4)) * 32 + (s0 >> 6)) * 16384;
#pragma unroll
        for (int k = 0; k < 2; ++k) { const int ci = tid + 512 * k, tok = ci >> 4, dc = ci & 15;
            const v4u w = *(const v4u*)(proj + (size_t)(tb * 64 + tok) * IN_COLS + vcol + dc * 8);
            LAS bf16* t = T + (dc * 8) * 72 + tok;
            t[0 * 72] = (bf16)(w.x & 0xffff); t[1 * 72] = (bf16)(w.x >> 16); t[2 * 72] = (bf16)(w.y & 0xffff); t[3 * 72] = (bf16)(w.y >> 16);
            t[4 * 72] = (bf16)(w.z & 0xffff); t[5 * 72] = (bf16)(w.z >> 16); t[6 * 72] = (bf16)(w.w & 0xffff); t[7 * 72] = (bf16)(w.w >> 16); }
        __syncthreads();
#pragma unroll
        for (int k = 0; k < 2; ++k) { const int ci = tid + 512 * k, d = ci >> 3, tc = ci & 7;
            const v4u w = *(const LAS v4u*)(T + d * 72 + tc * 8);
            const int dtp = 2 * (d >> 5) + ((d >> 2) & 1), rrp = 4 * ((d >> 3) & 3) + (d & 3);
            int ob = rrp * 64 + (tc & 3) * 16; ob ^= ((ob >> 9) & 1) << 5;
            *(v4u*)(dst + (dtp * 2 + (tc >> 2)) * 1024 + ob) = w; }
        __syncthreads();
    }
}

namespace att {
constexpr int BUF_BYTES = 32768, K_OFF = 0, V_OFF = 16384;
constexpr float NEG = -1e30f;
__device__ __forceinline__ int swz(int rr, int fq) { const int ob = rr * 64 + fq * 16; return ob ^ (((ob >> 9) & 1) << 5); }

template <int DK>
__device__ __forceinline__ void dma_tile(LAS unsigned char* buf, const unsigned char* ktile, const unsigned char* vtile, int wave, unsigned lane16) {
    constexpr int NK = 4 * (DK / 32), PER = (NK + 16) / 8;
#pragma unroll
    for (int i = 0; i < PER; ++i) { const int st = wave * PER + i;
        const unsigned char* gp; LAS unsigned char* dst;
        if (st < NK) { gp = ktile + st * 1024 + lane16; dst = buf + K_OFF + st * 1024; }
        else { gp = vtile + (st - NK) * 1024 + lane16; dst = buf + V_OFF + (st - NK) * 1024; }
        __builtin_amdgcn_global_load_lds((const unsigned*)gp, (LAS unsigned*)dst, 16, 0, 0); }
}

template <int DK, bool SWA>
__device__ __forceinline__ void pass(LAS unsigned char* lds, const bf16* Q, int ldq, const float* qgain, const f32x2* qtab, const float qscale, const unsigned char* kimg, const unsigned char* vimg, int q0, int jt_lo, int jt_hi,
                                     float (&mrow)[2], float (&lrow)[2], f32x4 (&O)[2][8], const bool online, const float mfix, int tid, int wave, int lane) {
    constexpr int PER = (4 * (DK / 32) + 16) / 8;
    const int fr = lane & 15, fq = lane >> 4, qw = q0 + 32 * wave;
    const int ntile = jt_hi - jt_lo + 1;
    constexpr int KT_BYTES = 4 * (DK / 32) * 1024; const unsigned lane16 = (unsigned)lane * 16u;
#pragma unroll
    for (int p = 0; p < 2; ++p) if (p < ntile) dma_tile<DK>(lds + p * BUF_BYTES, kimg + (size_t)(jt_lo + p) * KT_BYTES, vimg + (size_t)(jt_lo + p) * 16384, wave, lane16);
    bf16x8 qf[2][DK / 32];
#pragma unroll
    for (int rg = 0; rg < 2; ++rg) {
        const int qrow = qw + 16 * rg + fr;
        float x[DK / 32][8]; float ss = 0.f;
#pragma unroll
        for (int c = 0; c < DK / 32; ++c) { const v4u w = *(const v4u*)(Q + (size_t)qrow * ldq + 32 * c + 8 * fq);
            x[c][0] = bflo(w.x); x[c][1] = bfhi(w.x); x[c][2] = bflo(w.y); x[c][3] = bfhi(w.y); x[c][4] = bflo(w.z); x[c][5] = bfhi(w.z); x[c][6] = bflo(w.w); x[c][7] = bfhi(w.w);
#pragma unroll
            for (int e = 0; e < 8; ++e) ss += x[c][e] * x[c][e]; }
        ss += __shfl_xor(ss, 16); ss += __shfl_xor(ss, 32);
        const float rq = qscale / sqrtf(ss * (1.0f / DK) + NORM_EPS);
#pragma unroll
        for (int c = 0; c < DK / 64; ++c) { const int ch = c + DK / 64;
            const f32x4 ga = *(const f32x4*)(qgain + 32 * c + 8 * fq), gb = *(const f32x4*)(qgain + 32 * c + 8 * fq + 4), gc = *(const f32x4*)(qgain + 32 * ch + 8 * fq), gd = *(const f32x4*)(qgain + 32 * ch + 8 * fq + 4);
            const float gl[8] = {ga.x, ga.y, ga.z, ga.w, gb.x, gb.y, gb.z, gb.w}, gh[8] = {gc.x, gc.y, gc.z, gc.w, gd.x, gd.y, gd.z, gd.w};
            const f32x4* tp = (const f32x4*)(qtab + (size_t)qrow * (DK / 2) + 32 * c + 8 * fq);
            const f32x4 t0 = tp[0], t1 = tp[1], t2 = tp[2], t3 = tp[3];
            const float cs[8] = {t0.x, t0.z, t1.x, t1.z, t2.x, t2.z, t3.x, t3.z}, sn[8] = {t0.y, t0.w, t1.y, t1.w, t2.y, t2.w, t3.y, t3.w};
            float ol[8], oh[8];
#pragma unroll
            for (int e = 0; e < 8; ++e) { const float yl = x[c][e] * gl[e], yh = x[ch][e] * gh[e]; ol[e] = (yl * cs[e] - yh * sn[e]) * rq; oh[e] = (yh * cs[e] + yl * sn[e]) * rq; }
            v4u wl, wh; wl.x = pk2(ol[0], ol[1]); wl.y = pk2(ol[2], ol[3]); wl.z = pk2(ol[4], ol[5]); wl.w = pk2(ol[6], ol[7]);
            wh.x = pk2(oh[0], oh[1]); wh.y = pk2(oh[2], oh[3]); wh.z = pk2(oh[4], oh[5]); wh.w = pk2(oh[6], oh[7]);
            qf[rg][c] = __builtin_bit_cast(bf16x8, wl); qf[rg][ch] = __builtin_bit_cast(bf16x8, wh); }
    }
    const int fro = swz(fr, fq);
    const float sinit = online ? 0.f : -mfix;
#define ATT_PV(pvbuf) do { bf16x8 vfa[4][2], vfb[4][2]; \
        _Pragma("unroll") for (int dt = 0; dt < 4; ++dt) _Pragma("unroll") for (int u = 0; u < 2; ++u) vfa[dt][u] = *(const LAS bf16x8*)((pvbuf) + V_OFF + (dt * 2 + u) * 1024 + fro); \
        _Pragma("unroll") for (int dt = 0; dt < 4; ++dt) _Pragma("unroll") for (int u = 0; u < 2; ++u) vfb[dt][u] = *(const LAS bf16x8*)((pvbuf) + V_OFF + ((dt + 4) * 2 + u) * 1024 + fro); \
        __builtin_amdgcn_s_setprio(1); \
        _Pragma("unroll") for (int dt = 0; dt < 8; ++dt) _Pragma("unroll") for (int u = 0; u < 2; ++u) _Pragma("unroll") for (int rg = 0; rg < 2; ++rg) \
            O[rg][dt] = __builtin_amdgcn_mfma_f32_16x16x32_bf16(dt < 4 ? vfa[dt][u] : vfb[dt - 4][u], pf[rg][u], O[rg][dt], 0, 0, 0); \
        __builtin_amdgcn_s_setprio(0); } while (0)
    const bool lagB = wave >= 4;
    bool pend = false;
    bf16x8 pf[2][2];
#pragma unroll
    for (int rg = 0; rg < 2; ++rg)
#pragma unroll
        for (int u = 0; u < 2; ++u) pf[rg][u] = (bf16x8){0, 0, 0, 0, 0, 0, 0, 0};
    for (int i = 0; i < ntile; ++i) {
        const int jt = jt_lo + i, rem = ntile - 1 - i;
        if (rem >= 1) asm volatile("s_waitcnt vmcnt(%0)" :: "n"(PER) : "memory");
        else asm volatile("s_waitcnt vmcnt(0)" ::: "memory");
        __builtin_amdgcn_s_barrier(); asm volatile("" ::: "memory");
        if (i + 2 < ntile) dma_tile<DK>(lds + ((i + 2) & 3) * BUF_BYTES, kimg + (size_t)(jt + 2) * KT_BYTES, vimg + (size_t)(jt + 2) * 16384, wave, lane16);
        if (lagB && pend) { ATT_PV(lds + ((i - 1) & 3) * BUF_BYTES); pend = false; }
        LAS unsigned char* buf = lds + (i & 3) * BUF_BYTES;
        const int kt0 = jt * 64;
        bool need = kt0 <= qw + 31; if (SWA) need = need && (kt0 + 63 >= qw - 127);
        if (need) {
            f32x4 s[2][4];
            {
                bf16x8 kf[4][DK / 32];
#pragma unroll
                for (int t = 0; t < 4; ++t)
#pragma unroll
                    for (int c = 0; c < DK / 32; ++c) kf[t][c] = *(const LAS bf16x8*)(buf + K_OFF + (t * (DK / 32) + c) * 1024 + fro);
                __builtin_amdgcn_s_setprio(1);
#pragma unroll
                for (int t = 0; t < 4; ++t) {
#pragma unroll
                    for (int rg = 0; rg < 2; ++rg) s[rg][t] = (f32x4){sinit, sinit, sinit, sinit};
#pragma unroll
                    for (int c = 0; c < DK / 32; ++c)
#pragma unroll
                        for (int rg = 0; rg < 2; ++rg) s[rg][t] = __builtin_amdgcn_mfma_f32_16x16x32_bf16(kf[t][c], qf[rg][c], s[rg][t], 0, 0, 0); }
                __builtin_amdgcn_s_setprio(0);
            }
            const bool domask = SWA || (kt0 + 63 > qw);
            if (domask) {
#pragma unroll
                for (int rg = 0; rg < 2; ++rg) { const int q = qw + 16 * rg + fr;
#pragma unroll
                    for (int t = 0; t < 4; ++t)
#pragma unroll
                        for (int i2 = 0; i2 < 4; ++i2) { const int key = kt0 + 32 * (t >> 1) + 8 * fq + 4 * (t & 1) + i2;
                            bool ok = key <= q; if (SWA) ok = ok && (q - key < 128);
                            s[rg][t][i2] = ok ? s[rg][t][i2] : NEG; } }
            }
            if (!online) {
#pragma unroll
                for (int rg = 0; rg < 2; ++rg) {
                    float ps = 0.f;
#pragma unroll
                    for (int t = 0; t < 4; ++t)
#pragma unroll
                        for (int i2 = 0; i2 < 4; ++i2) { const float p = __builtin_amdgcn_exp2f(s[rg][t][i2]); s[rg][t][i2] = p; ps += p; }
                    lrow[rg] += ps;
#pragma unroll
                    for (int u = 0; u < 2; ++u) { v4u w; w.x = pk2(s[rg][2 * u][0], s[rg][2 * u][1]); w.y = pk2(s[rg][2 * u][2], s[rg][2 * u][3]);
                        w.z = pk2(s[rg][2 * u + 1][0], s[rg][2 * u + 1][1]); w.w = pk2(s[rg][2 * u + 1][2], s[rg][2 * u + 1][3]); pf[rg][u] = __builtin_bit_cast(bf16x8, w); }
                }
            } else
#pragma unroll
            for (int rg = 0; rg < 2; ++rg) {
                float mx = NEG;
#pragma unroll
                for (int t = 0; t < 4; ++t) mx = fmaxf(mx, fmaxf(fmaxf(s[rg][t][0], s[rg][t][1]), fmaxf(s[rg][t][2], s[rg][t][3])));
                mx = fmaxf(mx, __shfl_xor(mx, 16)); mx = fmaxf(mx, __shfl_xor(mx, 32));
                const float mnew = fmaxf(mrow[rg], mx), alpha = __builtin_amdgcn_exp2f(mrow[rg] - mnew); mrow[rg] = mnew;
                float ps = 0.f;
#pragma unroll
                for (int t = 0; t < 4; ++t)
#pragma unroll
                    for (int i2 = 0; i2 < 4; ++i2) { const float p = __builtin_amdgcn_exp2f(s[rg][t][i2] - mnew); s[rg][t][i2] = p; ps += p; }
                lrow[rg] = lrow[rg] * alpha + ps;
#pragma unroll
                for (int dt = 0; dt < 8; ++dt) O[rg][dt] = O[rg][dt] * alpha;
#pragma unroll
                for (int u = 0; u < 2; ++u) { v4u w; w.x = pk2(s[rg][2 * u][0], s[rg][2 * u][1]); w.y = pk2(s[rg][2 * u][2], s[rg][2 * u][3]);
                    w.z = pk2(s[rg][2 * u + 1][0], s[rg][2 * u + 1][1]); w.w = pk2(s[rg][2 * u + 1][2], s[rg][2 * u + 1][3]); pf[rg][u] = __builtin_bit_cast(bf16x8, w); }
            }
            if (lagB) pend = true; else ATT_PV(buf);
        }
    }
    if (lagB && pend) ATT_PV(lds + ((ntile - 1) & 3) * BUF_BYTES);
#undef ATT_PV
    __builtin_amdgcn_s_barrier(); asm volatile("" ::: "memory");
}

__device__ __forceinline__ void init_state(float (&m)[2], float (&l)[2], f32x4 (&O)[2][8], float m0) {
#pragma unroll
    for (int rg = 0; rg < 2; ++rg) { m[rg] = m0; l[rg] = 0.f;
#pragma unroll
        for (int dt = 0; dt < 8; ++dt) O[rg][dt] = (f32x4){0.f, 0.f, 0.f, 0.f}; }
}

__device__ __forceinline__ void swa_unit(const Args& A, LAS unsigned char* lds, int unit, const bool online, const float mfix) {
    int tid_ = threadIdx.x; asm volatile("" : "+v"(tid_));
    const int tid = tid_, lane = tid & 63, wave = __builtin_amdgcn_readfirstlane(tid >> 6);
    unsigned char* ws = A.ws; const bf16* proj = (const bf16*)(ws + WS_PROJ);
    const int qb = unit & 7, hq = (unit >> 3) & 15, b = unit >> 7, kvh = hq >> 2, q0 = qb * 256;
    const bf16* Q = proj + (size_t)b * SEQ * IN_COLS + COL_QA + hq * 128;
    const unsigned char* kimg = ws + WS_KIMG128 + (size_t)(b * 4 + kvh) * 32 * 16384;
    const unsigned char* vimg = ws + WS_VTA + (size_t)(b * 4 + kvh) * 32 * 16384;
    float m[2], l[2]; f32x4 O[2][8]; init_state(m, l, O, online ? NEG : mfix);
    const int jt_lo = (4 * qb - 2) > 0 ? 4 * qb - 2 : 0, jt_hi = 4 * qb + 3;
    pass<128, true>(lds, Q, IN_COLS, A.qa_g, (const f32x2*)(ws + WS_TAB128), 0.08838834764831845f * LOG2E, kimg, vimg, q0, jt_lo, jt_hi, m, l, O, online, mfix, tid, wave, lane);
    int lane2 = lane; asm volatile("" : "+v"(lane2));
    const int fr = lane2 & 15, fq = lane2 >> 4; const float sink2 = A.sinks[hq] * LOG2E;
    bf16* cat = (bf16*)(ws + WS_CAT);
#pragma unroll
    for (int rg = 0; rg < 2; ++rg) { float lt = l[rg]; lt += __shfl_xor(lt, 16); lt += __shfl_xor(lt, 32);
        lt += __builtin_amdgcn_exp2f(sink2 - m[rg]); const float inv = 1.0f / lt;
        bf16* orow = cat + (size_t)(b * SEQ + q0 + 32 * wave + 16 * rg + fr) * D_MODEL + hq * 128 + 8 * fq;
#pragma unroll
        for (int k = 0; k < 4; ++k) { const f32x4 o0 = O[rg][2 * k] * inv, o1 = O[rg][2 * k + 1] * inv; v4u w; w.x = pk2(o0[0], o0[1]); w.y = pk2(o0[2], o0[3]); w.z = pk2(o1[0], o1[1]); w.w = pk2(o1[2], o1[3]); *(v4u*)(orow + 32 * k) = w; } }
}
__device__ __forceinline__ void diff_unit(const Args& A, LAS unsigned char* lds, int b, int h, int qb, float lam, const bool online, const float mfix) {
    int tid_ = threadIdx.x; asm volatile("" : "+v"(tid_));
    const int tid = tid_, lane = tid & 63, wave = __builtin_amdgcn_readfirstlane(tid >> 6);
    unsigned char* ws = A.ws; const bf16* proj = (const bf16*)(ws + WS_PROJ);
    const int q0 = qb * 256; const size_t boff = (size_t)b * SEQ * IN_COLS;
    const unsigned char* vimg = ws + WS_VTB + (size_t)(b * 16 + h) * 32 * 16384;
    const int jt_hi = 4 * qb + 3;
    float m[2], l[2]; f32x4 O1[2][8], O0[2][8];
    unsigned char* oscr = ws + WS_OSCR + (size_t)blockIdx.x * 131072; const unsigned tid16 = (unsigned)tid * 16u;
#pragma unroll 1
    for (int mp = 0; mp < 2; ++mp) {
        init_state(m, l, O1, online ? NEG : mfix);
        pass<64, false>(lds, proj + boff + COL_QB + mp * 1024 + h * 64, IN_COLS, A.qb_g, (const f32x2*)(ws + WS_TAB64), 0.125f * LOG2E, ws + WS_KIMG64 + (size_t)((b * 2 + mp) * 16 + h) * 32 * 8192, vimg, q0, 0, jt_hi, m, l, O1, online, mfix, tid, wave, lane);
        if (mp == 0) {
#pragma unroll
            for (int rg = 0; rg < 2; ++rg) { float lt = l[rg]; lt += __shfl_xor(lt, 16); lt += __shfl_xor(lt, 32); const float inv = 1.0f / lt;
#pragma unroll
                for (int dt = 0; dt < 8; ++dt) *(f32x4*)(oscr + (rg * 8 + dt) * 8192 + tid16) = O1[rg][dt] * inv; }
        }
    }
#pragma unroll
    for (int rg = 0; rg < 2; ++rg)
#pragma unroll
        for (int dt = 0; dt < 8; ++dt) O0[rg][dt] = *(const f32x4*)(oscr + (rg * 8 + dt) * 8192 + tid16);
    int lane2 = lane; asm volatile("" : "+v"(lane2));
    const int fr = lane2 & 15, fq = lane2 >> 4;
    bf16* cat = (bf16*)(ws + WS_CAT);
#pragma unroll
    for (int rg = 0; rg < 2; ++rg) { float lt = l[rg]; lt += __shfl_xor(lt, 16); lt += __shfl_xor(lt, 32); const float sc = -lam / lt;
        float ss = 0.f;
#pragma unroll
        for (int dt = 0; dt < 8; ++dt) { const f32x4 o = O0[rg][dt] + O1[rg][dt] * sc; O0[rg][dt] = o; ss += (o[0] * o[0] + o[1] * o[1]) + (o[2] * o[2] + o[3] * o[3]); }
        ss += __shfl_xor(ss, 16); ss += __shfl_xor(ss, 32);
        const float rs = 0.8f / sqrtf(ss * (1.0f / 128.0f) + NORM_EPS);
        bf16* orow = cat + (size_t)(b * SEQ + q0 + 32 * wave + 16 * rg + fr) * D_MODEL + 2048 + h * 128 + 8 * fq;
#pragma unroll
        for (int k = 0; k < 4; ++k) { const f32x4 g0 = *(const f32x4*)(A.subln_g + 32 * k + 8 * fq), g1 = *(const f32x4*)(A.subln_g + 32 * k + 8 * fq + 4); const f32x4 o0 = O0[rg][2 * k] * g0 * rs, o1 = O0[rg][2 * k + 1] * g1 * rs;
            v4u w; w.x = pk2(o0[0], o0[1]); w.y = pk2(o0[2], o0[3]); w.z = pk2(o1[0], o1[1]); w.w = pk2(o1[2], o1[3]); *(v4u*)(orow + 32 * k) = w; } }
}
}

#define RLX_AGENT __ATOMIC_RELAXED, __HIP_MEMORY_SCOPE_AGENT
#define XB_TMO      128
#define XB_XCNT(j)  (256  + 64 * (j))
#define XB_XSUB(j)  (1280 + 64 * (j))
#define XB_XGEN(j)  (2304 + 64 * (j))
#define XB_TOP      3328
#define XB_TOPGEN   3392
#define XCD_BAR_WORDS 3456
#define XB_SPIN_CAP (1u << 18)

__device__ __forceinline__ unsigned xb_ld(unsigned* p)              { return __hip_atomic_load(p, __ATOMIC_RELAXED, __HIP_MEMORY_SCOPE_AGENT); }
__device__ __forceinline__ unsigned xb_add(unsigned* p, unsigned v) { return __hip_atomic_fetch_add(p, v, __ATOMIC_RELAXED, __HIP_MEMORY_SCOPE_AGENT); }
__device__ __forceinline__ unsigned xb_xcc_id() { return (unsigned)__builtin_amdgcn_s_getreg((3 << 11) | 20) & 0xFu; }
#define XB_SPIN(cond, bar) do { unsigned _sp = 0; while (cond) { __builtin_amdgcn_s_sleep(1); \
    if ((++_sp & 255u) == 0u) { if (xb_ld(&(bar)[XB_TMO])) break; if (_sp > XB_SPIN_CAP) { atomicAdd(&(bar)[XB_TMO], 1u); break; } } } } while (0)

struct XcdBarrier {
    unsigned* bar; unsigned x;
    volatile LAS unsigned* st;
};

__device__ __forceinline__ XcdBarrier xcd_barrier_post(unsigned* bar, volatile LAS unsigned* st) {
    XcdBarrier b; b.bar = bar; b.x = xb_xcc_id(); b.st = st;
    if (threadIdx.x == 0) (void)xb_add(&bar[XB_XCNT(b.x)], 1u);
    return b;
}
__device__ __forceinline__ void xcd_barrier_complete(unsigned* bar, unsigned x, unsigned& nloc, unsigned& nx) {
    const unsigned G = gridDim.x * gridDim.y * gridDim.z;
    unsigned sum, cnt, mine, sp = 0u;
    for (;;) {
        sum = 0u; cnt = 0u; mine = 0u;
#pragma unroll
        for (unsigned j = 0; j < 16; ++j) { const unsigned c = xb_ld(&bar[XB_XCNT(j)]); sum += c; cnt += (c > 0u) ? 1u : 0u; mine = (j == x) ? c : mine; }
        if (sum == G) break;
        __builtin_amdgcn_s_sleep(1);
        if ((++sp & 255u) == 0u) { if (xb_ld(&bar[XB_TMO])) break; if (sp > XB_SPIN_CAP) { atomicAdd(&bar[XB_TMO], 1u); break; } }
    }
    nloc = mine > 0u ? mine : 1u; nx = cnt > 0u ? cnt : 1u;
}

__device__ __forceinline__ void xcd_barrier(const XcdBarrier& b) {
    asm volatile("s_waitcnt vmcnt(0)" ::: "memory");
    __syncthreads();
    if (threadIdx.x == 0) {
        unsigned* bar = b.bar;
        __builtin_amdgcn_s_waitcnt(0);
        unsigned nloc = b.st[0], nx = b.st[1];
        if (nloc == 0u) { xcd_barrier_complete(bar, b.x, nloc, nx); b.st[0] = nloc; b.st[1] = nx; }
        const unsigned old = xb_add(&bar[XB_XSUB(b.x)], 1u);
        const unsigned gen = old / nloc;
        if (old + 1u == (gen + 1u) * nloc) {
            __builtin_amdgcn_fence(__ATOMIC_RELEASE, "agent");
            asm volatile("s_waitcnt vmcnt(0)" ::: "memory");
            const unsigned og = xb_add(&bar[XB_TOP], 1u);
            const unsigned tg = og / nx;
            if (og + 1u == (tg + 1u) * nx) xb_add(&bar[XB_TOPGEN], 1u);
            else XB_SPIN(xb_ld(&bar[XB_TOPGEN]) == tg, bar);
            __builtin_amdgcn_fence(__ATOMIC_ACQUIRE, "agent");
            xb_add(&bar[XB_XGEN(b.x)], 1u);
            asm volatile("s_waitcnt vmcnt(0)" ::: "memory");
        } else {
            XB_SPIN(xb_ld(&bar[XB_XGEN(b.x)]) == gen, bar);
            __builtin_amdgcn_fence(__ATOMIC_ACQUIRE, "agent");
            asm volatile("s_waitcnt vmcnt(0)" ::: "memory");
        }
    }
    __syncthreads();
}

#define PG8_SP2 true
#define PG8_ALIGN true
__global__ void __launch_bounds__(NTHREADS, 2) hymba_fwd(Args A) {
    extern __shared__ __attribute__((aligned(16))) unsigned char lds_raw[];
    LAS unsigned char* lds = (LAS unsigned char*)lds_raw;
    const int tid = threadIdx.x, lane = tid & 63, wave = __builtin_amdgcn_readfirstlane(tid >> 6);
    const int G = gridDim.x, gw = blockIdx.x * NWAVES + wave, NGW = G * NWAVES;
    unsigned char* ws = A.ws;
    const int lo = A.ph_lo, hi = A.ph_hi;
#ifndef PHMASK
#define PHMASK 0xff
#endif
#define IN(k) (((PHMASK >> (k)) & 1) && lo <= (k) && (k) < hi)
#ifndef DIAG
#define DIAG 0
#endif
#define STAMP(k) do { if (DIAG && blockIdx.x == 0 && tid == 0) ((unsigned long long*)(ws + 32768))[k] = __builtin_amdgcn_s_memrealtime(); } while (0)
#define SEAM(k) do { if (IN(k) && IN((k) + 1)) { xcd_barrier(bar); } STAMP((k) + 1); } while (0)
    volatile LAS unsigned* MISC = (volatile LAS unsigned*)(lds + LDS_BYTES - 64);
    if (tid < 16) MISC[tid] = 0u;
    __syncthreads();
    XcdBarrier bar; bar.bar = (unsigned*)(ws + WS_CTL); bar.x = 0; bar.st = nullptr;
    if (A.coop) bar = xcd_barrier_post((unsigned*)(ws + WS_CTL), MISC);
    if (A.coop == 2) cg::this_grid().sync();

#ifndef REP0
#define REP0 1
#endif
#ifndef REP3
#define REP3 1
#endif
#ifndef REP5
#define REP5 1
#endif
#ifndef WDOWN_IN_P1
#define WDOWN_IN_P1 1
#endif
    const int p1_rem = WDOWN_IN_P1 ? ((M_TOK / 256) * (IN_COLS / 256)) % G : 0;
    STAMP(0);
    if (IN(0)) { for (int rep = 0; rep < REP0; ++rep) p0_prologue(A, lds, gw, NGW, wave, lane); if (p1_rem == 0) convert_wdown<false>(A, lds, gw, NGW, wave, lane); }
    SEAM(0);
    if (IN(1)) {
        { pg8::Gemm g{(const bf16*)(ws + WS_XN), (const bf16*)(ws + WS_WIN), M_TOK, IN_COLS, D_MODEL}; pg8::StaticOrder S; S.init(M_TOK, IN_COLS, G, (int)blockIdx.x);
          pg8::EpiPlain E{(bf16*)(ws + WS_PROJ), IN_COLS};
          pg8::gemm_phase<pg8::EpiPlain, pg8::StaticOrder, PG8_ALIGN, PG8_SP2>(lds, g, S, E); }
        { pg8::Gemm g{(const bf16*)(ws + WS_PB), (const bf16*)(ws + WS_WPLE), M_TOK, D_MODEL, PLE_DIM}; pg8::StaticOrder S; S.init(M_TOK, D_MODEL, G, (int)blockIdx.x);
          pg8::EpiPle E{(bf16*)(ws + WS_PE), D_MODEL, (float*)(ws + WS_ROWSS_PLE)};
          pg8::gemm_phase<pg8::EpiPle, pg8::StaticOrder, PG8_ALIGN, PG8_SP2>(lds, g, S, E); }
        if (p1_rem != 0 && (int)blockIdx.x >= p1_rem) convert_wdown<true>(A, lds, ((int)blockIdx.x - p1_rem) * NWAVES + wave, (G - p1_rem) * NWAVES, wave, lane);
    }
    SEAM(1);
    if (IN(2)) { p2_qknorm_rope(A, lds, gw, NGW, tid, lane); }
    SEAM(2);
    if (IN(3)) {
        const float s1 = wave_sum(A.lq1[lane] * A.lk1[lane]), s2 = wave_sum(A.lq2[lane] * A.lk2[lane]);
        const float lam = __expf(s1) - __expf(s2) + 0.2f;
        const float gqa = wave_max(fmaxf(fabsf(A.qa_g[lane]), fabsf(A.qa_g[lane + 64]))), gka = wave_max(fmaxf(fabsf(A.ka_g[lane]), fabsf(A.ka_g[lane + 64])));
        const float gqb = wave_max(fabsf(A.qb_g[lane])), gkb = wave_max(fabsf(A.kb_g[lane]));
        const float B128 = gqa * gka * 11.313708499f * LOG2E * 1.02f, B64 = gqb * gkb * 8.0f * LOG2E * 1.02f;
        const bool on128 = !(B128 <= 30.f), on64 = !(B64 <= 30.f);
        for (int rep = 0; rep < REP3; ++rep) {
#ifndef NO_DIFF
#pragma unroll 1
        for (int pr2 = 2 * blockIdx.x; pr2 < 512; pr2 += 2 * G)
#pragma unroll 1
            for (int k = 0; k < 2; ++k) { const int pr = pr2 >> 1, b = pr >> 6, h = (pr >> 2) & 15, pi = pr & 3;
                att::diff_unit(A, lds, b, h, k ? pi : 7 - pi, lam, on64, B64); }
#endif
#ifndef NO_SWA
#pragma unroll 1
        for (int un = blockIdx.x; un < 512; un += G) att::swa_unit(A, lds, un, on128, B128);
#endif
        }
    }
    SEAM(3);
    if (IN(4)) {
        pg8::Gemm g{(const bf16*)(ws + WS_CAT), (const bf16*)(ws + WS_WO), M_TOK, D_MODEL, D_MODEL}; pg8::StaticOrder S; S.init(M_TOK, D_MODEL, G, (int)blockIdx.x);
        pg8::EpiResX E{A.x, (bf16*)(ws + WS_XN), D_MODEL, (float*)(ws + WS_ROWSS_MLP)};
        pg8::gemm_phase<pg8::EpiResX, pg8::StaticOrder, PG8_ALIGN, PG8_SP2>(lds, g, S, E);
    }
    SEAM(4);
    if (IN(5)) {
        pg8::Gemm g{(const bf16*)(ws + WS_XN), (const bf16*)(ws + WS_WUP), M_TOK, D_FF, D_MODEL}; pg8::StaticOrder S; S.init(M_TOK, D_FF, G, (int)blockIdx.x);
        pg8::EpiUp E{(bf16*)(ws + WS_U), D_FF, (const float*)(ws + WS_ROWSS_MLP), 1.0f / D_MODEL};
        for (int rep = 0; rep < REP5; ++rep) pg8::gemm_phase<pg8::EpiUp, pg8::StaticOrder, PG8_ALIGN, PG8_SP2>(lds, g, S, E);
    }
    SEAM(5);
    if (IN(6)) {
        pg8::Gemm g{(const bf16*)(ws + WS_U), (const bf16*)(ws + WS_WDN), M_TOK, D_MODEL, D_FF}; pg8::StaticOrder S; S.init(M_TOK, D_MODEL, G, (int)blockIdx.x);
        pg8::EpiResB E{(bf16*)(ws + WS_XN), D_MODEL};
        pg8::gemm_phase<pg8::EpiResB, pg8::StaticOrder, PG8_ALIGN, PG8_SP2>(lds, g, S, E);
    }
    SEAM(6);
    if (IN(7)) {
        pg8::Gemm g{(const bf16*)(ws + WS_XN), (const bf16*)(ws + WS_WG), M_TOK, D_MODEL, D_MODEL}; pg8::StaticOrder S; S.init(M_TOK, D_MODEL, G, (int)blockIdx.x);
        pg8::EpiFinalB E{A.out, (const bf16*)(ws + WS_XN), (const bf16*)(ws + WS_PE), D_MODEL, (const float*)(ws + WS_ROWSS_PLE), A.ple_g, 1.0f / D_MODEL};
        pg8::gemm_phase<pg8::EpiFinalB, pg8::StaticOrder, PG8_ALIGN, PG8_SP2>(lds, g, S, E);
    }
#if DIAG
    STAMP(8); xcd_barrier(bar);
    if (blockIdx.x == 0 && tid == 0) { const unsigned long long* ts = (const unsigned long long*)(ws + 32768); A.out[0] = (float)(ts[DIAG_B] - ts[DIAG_A]) * 0.01f; }
#endif
#undef IN
#undef SEAM
}

#ifndef MK_PER_PHASE
#define MK_PER_PHASE 0
#endif
extern "C" void kernel_launch(void* const* d_in, const int* in_sizes, int n_in, void* d_out, int out_size, void* d_ws, size_t ws_size, hipStream_t stream) {
    static int grid = 0;
    if (grid == 0) {
        if (n_in != 21 || in_sizes[0] != M_TOK * D_MODEL || out_size != M_TOK * D_MODEL || ws_size < WS_END) { fprintf(stderr, "kernel_launch: unexpected shapes (n_in %d, ws %zu); nothing launched\n", n_in, ws_size); grid = -1; return; }
        int dev = 0, cus = 0, per_cu = 0;
        if (hipGetDevice(&dev) != hipSuccess || hipDeviceGetAttribute(&cus, hipDeviceAttributeMultiprocessorCount, dev) != hipSuccess) { grid = -1; return; }
        if (hipFuncSetAttribute((const void*)hymba_fwd, hipFuncAttributeMaxDynamicSharedMemorySize, LDS_BYTES) != hipSuccess) { fprintf(stderr, "kernel_launch: hipFuncSetAttribute failed\n"); grid = -1; return; }
        if (hipOccupancyMaxActiveBlocksPerMultiprocessor(&per_cu, (const void*)hymba_fwd, NTHREADS, LDS_BYTES) != hipSuccess || per_cu < 1) { fprintf(stderr, "kernel_launch: occupancy query says %d\n", per_cu); per_cu = 1; }
        (void)hipGetLastError();
        grid = cus;
    }
    if (grid < 0) return;
    if (hipMemsetAsync((char*)d_ws + WS_CTL, 0, 16384, stream) != hipSuccess) { fprintf(stderr, "kernel_launch: memset failed\n"); return; }
    Args a{};
    const float** f = (const float**)&a;
    for (int i = 0; i < 21; ++i) f[i] = (const float*)d_in[i];
    a.out = (float*)d_out; a.ws = (unsigned char*)d_ws;
#if MK_PER_PHASE
    for (int ph = 0; ph < 8; ++ph) { a.ph_lo = ph; a.ph_hi = ph + 1; a.coop = 0; hipLaunchKernelGGL(hymba_fwd, dim3(grid), dim3(NTHREADS), LDS_BYTES, stream, a); }
#else
    a.ph_lo = 0; a.ph_hi = 8; a.coop = 1;
    void* args[] = {&a};
    hipError_t e = hipLaunchCooperativeKernel((const void*)hymba_fwd, dim3(grid), dim3(NTHREADS), args, LDS_BYTES, stream);
    if (e != hipSuccess) fprintf(stderr, "kernel_launch: cooperative launch failed: %s (grid %d)\n", hipGetErrorString(e), grid);
#endif
}
```

```cpp
#include <hip/hip_runtime.h>
#include <hip/hip_cooperative_groups.h>
#include <cstdio>
#include <cstdint>
namespace cg = cooperative_groups;
namespace pg8 {
#define PG8_LAS __attribute__((address_space(3)))
typedef unsigned short bf16_t;
typedef short bf16x8 __attribute__((ext_vector_type(8)));
typedef float f32x4 __attribute__((ext_vector_type(4)));
typedef unsigned u32x4 __attribute__((ext_vector_type(4)));
constexpr int BM = 256, BK = 64, HALF = 128, HTB = HALF * BK * 2  , STAGE_BYTES = 8 * HTB, NXCD = 8, WGM = 8;

__host__ __device__ __forceinline__ int lds_byte(int r, int c) { const int st = (r >> 4) * 2 + (c >> 5), rr = r & 15, cc = c & 31, ob = rr * 64 + cc * 2; return st * 1024 + (ob ^ (((ob >> 9) & 1) << 5)); }
__host__ __device__ __forceinline__ void stage_rc(int b, int& R, int& C) { const int st = b / 1024, sb = b % 1024, swz = sb ^ (((sb >> 9) & 1) << 5); R = (st >> 1) * 16 + swz / 64; C = (st & 1) * 32 + (swz % 64) / 2; }
__host__ __device__ __forceinline__ int perm32(int rho) { const int n = rho >> 4, i = rho & 15; return 8 * (i >> 2) + 4 * n + (i & 3); }

struct Unit { int pm, pn; };
struct Gemm { const bf16_t* A; const bf16_t* Bt; int M, N, K; };

struct StaticOrder {
    int nM, nN, nwg, G, c;
    __host__ __device__ void init(int M, int N, int G_, int c_) { nM = M / BM; nN = N / BM; nwg = nM * nN; G = G_; c = c_; }
    __host__ __device__ bool next(int i, Unit& u) const {
        const long L = (long)i * G + c; if (L >= nwg) return false;
        int wgid = (int)L; { const int q = nwg / NXCD, r = nwg % NXCD, xcd = wgid % NXCD, off = wgid / NXCD; wgid = (xcd < r ? xcd * (q + 1) : r * (q + 1) + (xcd - r) * q) + off; }
        const int nig = WGM * nN, gid = wgid / nig, fm = gid * WGM, gsz = (nM - fm) < WGM ? (nM - fm) : WGM;
        u.pm = fm + ((wgid % nig) % gsz); u.pn = (wgid % nig) / gsz; return true;
    }
    __device__ __forceinline__ void a_ready(const Unit&) const {}
    __device__ __forceinline__ void done(const Unit&) const {}
};

__device__ __forceinline__ unsigned cvt_pk_bf16(float lo, float hi) { unsigned r; asm volatile("v_cvt_pk_bf16_f32 %0, %1, %2" : "=v"(r) : "v"(lo), "v"(hi)); return r; }
typedef float f32x2 __attribute__((ext_vector_type(2)));
constexpr float RMS_EPS = 1e-6f;
__device__ __forceinline__ u32x4 pack8(const f32x4 v0, const f32x4 v1) { u32x4 w; w.x = cvt_pk_bf16(v0[0], v0[1]); w.y = cvt_pk_bf16(v0[2], v0[3]); w.z = cvt_pk_bf16(v1[0], v1[1]); w.w = cvt_pk_bf16(v1[2], v1[3]); return w; }
__device__ __forceinline__ float bf_lo(unsigned w) { return __uint_as_float(w << 16); }
__device__ __forceinline__ float bf_hi(unsigned w) { return __uint_as_float(w & 0xffff0000u); }

struct EpiPlain {
    static constexpr bool PERM = true, AFTER_DRAIN = false;
    bf16_t* O; int ldc;
    __device__ __forceinline__ void operator()(const f32x4 (&acc)[2][2][4][2], const Unit& u, int wr, int wc, int fr, int fq) const {
        const int row0 = u.pm * BM + wr * 64 + fr, col0 = u.pn * BM + wc * 32 + 8 * fq;
#pragma unroll
        for (int ai = 0; ai < 2; ++ai)
#pragma unroll
            for (int m = 0; m < 4; ++m) { bf16_t* rowp = O + (size_t)(row0 + ai * HALF + m * 16) * ldc + col0;
#pragma unroll
                for (int bj = 0; bj < 2; ++bj) *(u32x4*)(rowp + bj * HALF) = pack8(acc[ai][bj][m][0], acc[ai][bj][m][1]); }
    }
};
struct EpiPle {
    static constexpr bool PERM = true, AFTER_DRAIN = false;
    bf16_t* O; int ldc; float* rowss;
    __device__ __forceinline__ void operator()(const f32x4 (&acc)[2][2][4][2], const Unit& u, int wr, int wc, int fr, int fq) const {
        const int row0 = u.pm * BM + wr * 64 + fr, col0 = u.pn * BM + wc * 32 + 8 * fq;
#pragma unroll
        for (int ai = 0; ai < 2; ++ai)
#pragma unroll
            for (int m = 0; m < 4; ++m) { const int row = row0 + ai * HALF + m * 16; bf16_t* rowp = O + (size_t)row * ldc + col0; float ss = 0.f;
#pragma unroll
                for (int bj = 0; bj < 2; ++bj) { const f32x4 v0 = acc[ai][bj][m][0], v1 = acc[ai][bj][m][1];
                    ss += (v0[0] * v0[0] + v0[1] * v0[1]) + (v0[2] * v0[2] + v0[3] * v0[3]) + (v1[0] * v1[0] + v1[1] * v1[1]) + (v1[2] * v1[2] + v1[3] * v1[3]);
                    *(u32x4*)(rowp + bj * HALF) = pack8(v0, v1); }
                ss += __shfl_xor(ss, 16); ss += __shfl_xor(ss, 32);
                if (fq == 0) atomicAdd(rowss + row, ss); }
    }
};
struct EpiUp {
    static constexpr bool PERM = true, AFTER_DRAIN = false;
    bf16_t* O; int ldc; const float* rowss; float inv_nfeat;
    __device__ __forceinline__ void operator()(const f32x4 (&acc)[2][2][4][2], const Unit& u, int wr, int wc, int fr, int fq) const {
        const int row0 = u.pm * BM + wr * 64 + fr, col0 = u.pn * BM + wc * 32 + 8 * fq;
#pragma unroll
        for (int ai = 0; ai < 2; ++ai)
#pragma unroll
            for (int m = 0; m < 4; ++m) { const int row = row0 + ai * HALF + m * 16; bf16_t* rowp = O + (size_t)row * ldc + col0;
                const float r2 = 1.0f / (rowss[row] * inv_nfeat + RMS_EPS);
#pragma unroll
                for (int bj = 0; bj < 2; ++bj) { f32x4 v0 = acc[ai][bj][m][0], v1 = acc[ai][bj][m][1];
#pragma unroll
                    for (int e = 0; e < 4; ++e) { const float a = fmaxf(v0[e], 0.f), b = fmaxf(v1[e], 0.f); v0[e] = a * a * r2; v1[e] = b * b * r2; }
                    *(u32x4*)(rowp + bj * HALF) = pack8(v0, v1); } }
    }
};
struct EpiRes {
    static constexpr bool PERM = true, AFTER_DRAIN = false;
    const float* base; float* out; bf16_t* hb; int ldc; const float* gain; float* rowss;
    __device__ __forceinline__ void operator()(const f32x4 (&acc)[2][2][4][2], const Unit& u, int wr, int wc, int fr, int fq) const {
        const int row0 = u.pm * BM + wr * 64 + fr, col0 = u.pn * BM + wc * 32 + 8 * fq;
        f32x4 g[2][2];
#pragma unroll
        for (int bj = 0; bj < 2; ++bj)
#pragma unroll
            for (int n = 0; n < 2; ++n) g[bj][n] = gain ? *(const f32x4*)(gain + col0 + bj * HALF + 4 * n) : (f32x4){1.f, 1.f, 1.f, 1.f};
#pragma unroll
        for (int ai = 0; ai < 2; ++ai)
#pragma unroll
            for (int m = 0; m < 4; ++m) { const int row = row0 + ai * HALF + m * 16; const size_t off = (size_t)row * ldc + col0; float ss = 0.f;
#pragma unroll
                for (int bj = 0; bj < 2; ++bj) { const f32x4 b0 = *(const f32x4*)(base + off + bj * HALF), b1 = *(const f32x4*)(base + off + bj * HALF + 4);
                    const f32x4 v0 = acc[ai][bj][m][0] + b0, v1 = acc[ai][bj][m][1] + b1;
                    *(f32x4*)(out + off + bj * HALF) = v0; *(f32x4*)(out + off + bj * HALF + 4) = v1;
                    ss += (v0[0] * v0[0] + v0[1] * v0[1]) + (v0[2] * v0[2] + v0[3] * v0[3]) + (v1[0] * v1[0] + v1[1] * v1[1]) + (v1[2] * v1[2] + v1[3] * v1[3]);
                    *(u32x4*)(hb + off + bj * HALF) = pack8(v0 * g[bj][0], v1 * g[bj][1]); }
                if (rowss) { ss += __shfl_xor(ss, 16); ss += __shfl_xor(ss, 32); if (fq == 0) atomicAdd(rowss + row, ss); } }
    }
};
struct EpiFinal {
    static constexpr bool PERM = true, AFTER_DRAIN = false;
    float* out; const bf16_t* pe; int ldc; const float* rowss; const float* gple; float inv_nfeat;
    __device__ __forceinline__ void operator()(const f32x4 (&acc)[2][2][4][2], const Unit& u, int wr, int wc, int fr, int fq) const {
        const int row0 = u.pm * BM + wr * 64 + fr, col0 = u.pn * BM + wc * 32 + 8 * fq;
        f32x4 g[2][2];
#pragma unroll
        for (int bj = 0; bj < 2; ++bj)
#pragma unroll
            for (int n = 0; n < 2; ++n) g[bj][n] = *(const f32x4*)(gple + col0 + bj * HALF + 4 * n);
#pragma unroll
        for (int ai = 0; ai < 2; ++ai)
#pragma unroll
            for (int m = 0; m < 4; ++m) { const int row = row0 + ai * HALF + m * 16; const size_t off = (size_t)row * ldc + col0;
                const float rs = 1.0f / sqrtf(rowss[row] * inv_nfeat + RMS_EPS);
#pragma unroll
                for (int bj = 0; bj < 2; ++bj) { const f32x4 b0 = *(const f32x4*)(out + off + bj * HALF), b1 = *(const f32x4*)(out + off + bj * HALF + 4);
                    const u32x4 pw = *(const u32x4*)(pe + off + bj * HALF);
                    const f32x4 p0 = (f32x4){bf_lo(pw.x), bf_hi(pw.x), bf_lo(pw.y), bf_hi(pw.y)}, p1 = (f32x4){bf_lo(pw.z), bf_hi(pw.z), bf_lo(pw.w), bf_hi(pw.w)};
                    f32x4 v0 = acc[ai][bj][m][0], v1 = acc[ai][bj][m][1];
#pragma unroll
                    for (int e = 0; e < 4; ++e) { v0[e] = 1.0f / (1.0f + __expf(-v0[e])); v1[e] = 1.0f / (1.0f + __expf(-v1[e])); }
                    v0 = b0 + v0 * (p0 * g[bj][0]) * rs; v1 = b1 + v1 * (p1 * g[bj][1]) * rs;
                    *(f32x4*)(out + off + bj * HALF) = v0; *(f32x4*)(out + off + bj * HALF + 4) = v1; } }
    }
};

struct EpiResX {
    static constexpr bool PERM = true, AFTER_DRAIN = false;
    const float* base; bf16_t* hb; int ldc; float* rowss;
    __device__ __forceinline__ void operator()(const f32x4 (&acc)[2][2][4][2], const Unit& u, int wr, int wc, int fr, int fq) const {
        const int row0 = u.pm * BM + wr * 64 + fr, col0 = u.pn * BM + wc * 32 + 8 * fq;
#pragma unroll
        for (int ai = 0; ai < 2; ++ai)
#pragma unroll
            for (int m = 0; m < 4; ++m) { const int row = row0 + ai * HALF + m * 16; const size_t off = (size_t)row * ldc + col0; float ss = 0.f;
#pragma unroll
                for (int bj = 0; bj < 2; ++bj) { const f32x4 b0 = *(const f32x4*)(base + off + bj * HALF), b1 = *(const f32x4*)(base + off + bj * HALF + 4);
                    const f32x4 v0 = acc[ai][bj][m][0] + b0, v1 = acc[ai][bj][m][1] + b1;
                    ss += (v0[0] * v0[0] + v0[1] * v0[1]) + (v0[2] * v0[2] + v0[3] * v0[3]) + (v1[0] * v1[0] + v1[1] * v1[1]) + (v1[2] * v1[2] + v1[3] * v1[3]);
                    *(u32x4*)(hb + off + bj * HALF) = pack8(v0, v1); }
                ss += __shfl_xor(ss, 16); ss += __shfl_xor(ss, 32); if (fq == 0) atomicAdd(rowss + row, ss); }
    }
};
struct EpiResB {
    static constexpr bool PERM = true, AFTER_DRAIN = false;
    bf16_t* hb; int ldc;
    __device__ __forceinline__ void operator()(const f32x4 (&acc)[2][2][4][2], const Unit& u, int wr, int wc, int fr, int fq) const {
        const int row0 = u.pm * BM + wr * 64 + fr, col0 = u.pn * BM + wc * 32 + 8 * fq;
#pragma unroll
        for (int ai = 0; ai < 2; ++ai)
#pragma unroll
            for (int m = 0; m < 4; ++m) { const size_t off = (size_t)(row0 + ai * HALF + m * 16) * ldc + col0;
#pragma unroll
                for (int bj = 0; bj < 2; ++bj) { const u32x4 bw = *(const u32x4*)(hb + off + bj * HALF);
                    const f32x4 b0 = (f32x4){bf_lo(bw.x), bf_hi(bw.x), bf_lo(bw.y), bf_hi(bw.y)}, b1 = (f32x4){bf_lo(bw.z), bf_hi(bw.z), bf_lo(bw.w), bf_hi(bw.w)};
                    *(u32x4*)(hb + off + bj * HALF) = pack8(acc[ai][bj][m][0] + b0, acc[ai][bj][m][1] + b1); } }
    }
};
struct EpiFinalB {
    static constexpr bool PERM = true, AFTER_DRAIN = false;
    float* out; const bf16_t* h2; const bf16_t* pe; int ldc; const float* rowss; const float* gple; float inv_nfeat;
    __device__ __forceinline__ void operator()(const f32x4 (&acc)[2][2][4][2], const Unit& u, int wr, int wc, int fr, int fq) const {
        const int row0 = u.pm * BM + wr * 64 + fr, col0 = u.pn * BM + wc * 32 + 8 * fq;
        f32x4 g[2][2];
#pragma unroll
        for (int bj = 0; bj < 2; ++bj)
#pragma unroll
            for (int n = 0; n < 2; ++n) g[bj][n] = *(const f32x4*)(gple + col0 + bj * HALF + 4 * n);
#pragma unroll
        for (int ai = 0; ai < 2; ++ai)
#pragma unroll
            for (int m = 0; m < 4; ++m) { const int row = row0 + ai * HALF + m * 16; const size_t off = (size_t)row * ldc + col0;
                const float rs = 1.0f / sqrtf(rowss[row] * inv_nfeat + RMS_EPS);
#pragma unroll
                for (int bj = 0; bj < 2; ++bj) { const u32x4 bw = *(const u32x4*)(h2 + off + bj * HALF); const u32x4 pw = *(const u32x4*)(pe + off + bj * HALF);
                    const f32x4 b0 = (f32x4){bf_lo(bw.x), bf_hi(bw.x), bf_lo(bw.y), bf_hi(bw.y)}, b1 = (f32x4){bf_lo(bw.z), bf_hi(bw.z), bf_lo(bw.w), bf_hi(bw.w)};
                    const f32x4 p0 = (f32x4){bf_lo(pw.x), bf_hi(pw.x), bf_lo(pw.y), bf_hi(pw.y)}, p1 = (f32x4){bf_lo(pw.z), bf_hi(pw.z), bf_lo(pw.w), bf_hi(pw.w)};
                    f32x4 v0 = acc[ai][bj][m][0], v1 = acc[ai][bj][m][1];
#pragma unroll
                    for (int e = 0; e < 4; ++e) { v0[e] = 1.0f / (1.0f + __expf(-v0[e])); v1[e] = 1.0f / (1.0f + __expf(-v1[e])); }
                    v0 = b0 + v0 * (p0 * g[bj][0]) * rs; v1 = b1 + v1 * (p1 * g[bj][1]) * rs;
                    *(f32x4*)(out + off + bj * HALF) = v0; *(f32x4*)(out + off + bj * HALF + 4) = v1; } }
    }
};
template <class Epi, class Sched, bool ALIGN_EPI = false, bool SP2 = false>
__device__ __forceinline__ void gemm_phase(PG8_LAS unsigned char* lds, const Gemm g, const Sched& S, const Epi& E) {
    const int tid = threadIdx.x, wid = __builtin_amdgcn_readfirstlane(tid >> 6), lane = tid & 63, wr = wid >> 2, wc = wid & 3, fr = lane & 15, fq = lane >> 4;
    const int K = g.K, nt = K / BK;
    unsigned voffA[2], voffB[2];
#pragma unroll
    for (int i = 0; i < 2; ++i) { int R, C; stage_rc(tid * 16 + i * 8192, R, C); const int Rb = Epi::PERM ? ((R & ~31) + perm32(R & 31)) : R;
        voffA[i] = (unsigned)(R * K + C) * 2u; voffB[i] = (unsigned)(Rb * K + C) * 2u; }
    const size_t kstep = (size_t)(BK * 2);
    const size_t hstep = (size_t)HALF * K * 2;
    const size_t tstep = 2 * hstep;
    const unsigned ldsw = (unsigned)wid * 1024u;
    const int aoff = lds_byte(wr * 64 + fr, fq * 8), boff = lds_byte(wc * 32 + fr, fq * 8);
#define PG8_SA(b, h) (((b) * 2 + (h)) * HTB)
#define PG8_SB(b, h) ((4 + (b) * 2 + (h)) * HTB)
#define PG8_STAGE(bufoff, gbase, voff) do { _Pragma("unroll") for (int _i = 0; _i < 2; ++_i) \
        __builtin_amdgcn_global_load_lds((const unsigned*)((const char*)(gbase) + (voff)[_i]), (PG8_LAS unsigned*)(lds + (bufoff) + ldsw + _i * 8192), 16, 0, 0); } while (0)
#define PG8_LDA(dst, b, h) do { _Pragma("unroll") for (int m = 0; m < 4; ++m) _Pragma("unroll") for (int k = 0; k < 2; ++k) dst[m][k] = *(const PG8_LAS bf16x8*)(lds + PG8_SA(b, h) + aoff + m * 2048 + k * 1024); } while (0)
#define PG8_LDB(dst, b, h) do { _Pragma("unroll") for (int n = 0; n < 2; ++n) _Pragma("unroll") for (int k = 0; k < 2; ++k) dst[n][k] = *(const PG8_LAS bf16x8*)(lds + PG8_SB(b, h) + boff + n * 2048 + k * 1024); } while (0)
#define PG8_MMA(ai, bj, At, Bt) do { __builtin_amdgcn_s_setprio(1); _Pragma("unroll") for (int m = 0; m < 4; ++m) _Pragma("unroll") for (int n = 0; n < 2; ++n) _Pragma("unroll") for (int k = 0; k < 2; ++k) \
        acc[ai][bj][m][n] = __builtin_amdgcn_mfma_f32_16x16x32_bf16(Bt[n][k], At[m][k], acc[ai][bj][m][n], 0, 0, 0); __builtin_amdgcn_s_setprio(0); } while (0)
#define PG8_WAIT_V(n) asm volatile("s_waitcnt vmcnt(" #n ")" ::: "memory")
#define PG8_WAIT_L(n) asm volatile("s_waitcnt lgkmcnt(" #n ")" ::: "memory")
#define PG8_BAR __builtin_amdgcn_s_barrier()
#define PG8_SCHED __builtin_amdgcn_sched_barrier(0)
    Unit cur, nxt; int ui = 0;
    if (!S.next(0, cur)) return;
    f32x4 acc[2][2][4][2];
#pragma unroll
    for (int a = 0; a < 2; ++a)
#pragma unroll
        for (int b = 0; b < 2; ++b)
#pragma unroll
            for (int m = 0; m < 4; ++m)
#pragma unroll
                for (int n = 0; n < 2; ++n) acc[a][b][m][n] = (f32x4){0.f, 0.f, 0.f, 0.f};
    bf16x8 At[4][2], B0[2][2], B1[2][2];
    const char* cA = (const char*)g.A + (size_t)cur.pm * tstep; const char* cB = (const char*)g.Bt + (size_t)cur.pn * tstep;
    S.a_ready(cur);
    if constexpr (SP2) {
        PG8_STAGE(PG8_SB(0, 0), cB, voffB); PG8_STAGE(PG8_SB(0, 1), cB + hstep, voffB); PG8_STAGE(PG8_SA(0, 0), cA, voffA); PG8_STAGE(PG8_SA(0, 1), cA + hstep, voffA);
        if (wr == 1) PG8_BAR;
        PG8_WAIT_V(2); PG8_BAR;
        PG8_STAGE(PG8_SB(1, 0), cB + kstep, voffB); PG8_STAGE(PG8_SA(1, 0), cA + kstep, voffA); PG8_STAGE(PG8_SB(1, 1), cB + hstep + kstep, voffB);
        PG8_WAIT_V(6); PG8_BAR;
    } else {
        PG8_STAGE(PG8_SB(0, 0), cB, voffB); PG8_STAGE(PG8_SA(0, 0), cA, voffA); PG8_STAGE(PG8_SB(0, 1), cB + hstep, voffB); PG8_STAGE(PG8_SA(0, 1), cA + hstep, voffA);
        if (wr == 1) PG8_BAR;
        PG8_WAIT_V(4); PG8_BAR;
        PG8_STAGE(PG8_SB(1, 0), cB + kstep, voffB); PG8_STAGE(PG8_SA(1, 0), cA + kstep, voffA); PG8_STAGE(PG8_SB(1, 1), cB + hstep + kstep, voffB);
        PG8_WAIT_V(6); PG8_BAR;
    }
    for (;;) {
        const bool has_next = S.next(ui + 1, nxt);
        const char* nA = has_next ? (const char*)g.A + (size_t)nxt.pm * tstep : cA; const char* nB = has_next ? (const char*)g.Bt + (size_t)nxt.pn * tstep : cB;
        for (int t = 0; t < nt; t += 2) {
            const bool last = (t == nt - 2);
            const char* a1 = cA + (size_t)(t + 1) * kstep;
            const char* a2 = last ? nA : cA + (size_t)(t + 2) * kstep; const char* b2 = last ? nB : cB + (size_t)(t + 2) * kstep;
            const char* a3 = a2 + kstep; const char* b3 = b2 + kstep;
            if (last && has_next) S.a_ready(nxt);
            if constexpr (SP2) {
            PG8_LDB(B0, 0, 0); PG8_LDB(B1, 0, 1); PG8_SCHED; PG8_LDA(At, 0, 0); PG8_STAGE(PG8_SA(1, 1), a1 + hstep, voffA);
            PG8_WAIT_V(8); PG8_WAIT_L(0); PG8_BAR; PG8_MMA(0, 0, At, B0); PG8_MMA(0, 1, At, B1); PG8_BAR; PG8_SCHED;
            PG8_LDA(At, 0, 1); PG8_STAGE(PG8_SB(0, 0), b2, voffB); PG8_STAGE(PG8_SB(0, 1), b2 + hstep, voffB); PG8_STAGE(PG8_SA(0, 0), a2, voffA);
            PG8_WAIT_V(8); PG8_WAIT_L(0); PG8_BAR; PG8_MMA(1, 0, At, B0); PG8_MMA(1, 1, At, B1); PG8_BAR; PG8_SCHED;
            PG8_LDB(B0, 1, 0); PG8_LDB(B1, 1, 1); PG8_SCHED; PG8_LDA(At, 1, 0); PG8_STAGE(PG8_SA(0, 1), a2 + hstep, voffA);
            PG8_WAIT_V(8); PG8_WAIT_L(0); PG8_BAR; PG8_MMA(0, 0, At, B0); PG8_MMA(0, 1, At, B1); PG8_BAR; PG8_SCHED;
            PG8_LDA(At, 1, 1); PG8_STAGE(PG8_SB(1, 0), b3, voffB); PG8_STAGE(PG8_SB(1, 1), b3 + hstep, voffB); PG8_STAGE(PG8_SA(1, 0), a3, voffA);
            PG8_WAIT_V(8); PG8_WAIT_L(0); PG8_BAR; PG8_MMA(1, 0, At, B0); PG8_MMA(1, 1, At, B1); PG8_BAR; PG8_SCHED;
            } else {
            PG8_LDB(B0, 0, 0); PG8_SCHED; PG8_LDA(At, 0, 0); PG8_STAGE(PG8_SA(1, 1), a1 + hstep, voffA);
            PG8_WAIT_L(8); PG8_BAR; PG8_WAIT_L(0); PG8_MMA(0, 0, At, B0); PG8_BAR; PG8_SCHED;
            PG8_LDB(B1, 0, 1); PG8_STAGE(PG8_SB(0, 0), b2, voffB);
            PG8_BAR; PG8_WAIT_L(0); PG8_MMA(0, 1, At, B1); PG8_BAR;
            PG8_LDA(At, 0, 1); PG8_STAGE(PG8_SA(0, 0), a2, voffA);
            PG8_BAR; PG8_WAIT_L(0); PG8_MMA(1, 0, At, B0); PG8_BAR; PG8_SCHED;
            PG8_STAGE(PG8_SB(0, 1), b2 + hstep, voffB);
            PG8_WAIT_V(6); PG8_BAR; PG8_MMA(1, 1, At, B1); PG8_BAR;
            PG8_LDB(B0, 1, 0); PG8_SCHED; PG8_LDA(At, 1, 0); PG8_STAGE(PG8_SA(0, 1), a2 + hstep, voffA);
            PG8_WAIT_L(8); PG8_BAR; PG8_WAIT_L(0); PG8_MMA(0, 0, At, B0); PG8_BAR; PG8_SCHED;
            PG8_LDB(B1, 1, 1); PG8_STAGE(PG8_SB(1, 0), b3, voffB);
            PG8_BAR; PG8_WAIT_L(0); PG8_MMA(0, 1, At, B1); PG8_BAR;
            PG8_LDA(At, 1, 1); PG8_STAGE(PG8_SA(1, 0), a3, voffA);
            PG8_BAR; PG8_WAIT_L(0); PG8_MMA(1, 0, At, B0); PG8_BAR; PG8_SCHED;
            PG8_STAGE(PG8_SB(1, 1), b3 + hstep, voffB);
            PG8_WAIT_V(6); PG8_BAR; PG8_MMA(1, 1, At, B1); PG8_BAR;
            }
        }
        if constexpr (ALIGN_EPI) { if (wr == 0) PG8_BAR; }
        if constexpr (!Epi::AFTER_DRAIN) { E(acc, cur, wr, wc, fr, fq); S.done(cur); }
        if (!has_next) break;
#pragma unroll
        for (int a = 0; a < 2; ++a)
#pragma unroll
            for (int b = 0; b < 2; ++b)
#pragma unroll
                for (int m = 0; m < 4; ++m)
#pragma unroll
                    for (int n = 0; n < 2; ++n) acc[a][b][m][n] = (f32x4){0.f, 0.f, 0.f, 0.f};
        cur = nxt; cA = nA; cB = nB; ++ui;
        if constexpr (ALIGN_EPI) { if (wr == 1) PG8_BAR; }
    }
    PG8_WAIT_V(0);
    if constexpr (!ALIGN_EPI) { if (wr == 0) PG8_BAR; }
    PG8_BAR;
    if constexpr (Epi::AFTER_DRAIN) { E.fused(acc, cur, wr, wc, fr, fq, lds, wid, lane); S.done(cur); }
#undef PG8_SA
#undef PG8_SB
#undef PG8_STAGE
#undef PG8_LDA
#undef PG8_LDB
#undef PG8_MMA
#undef PG8_WAIT_V
#undef PG8_WAIT_L
#undef PG8_BAR
#undef PG8_SCHED
}
}

constexpr int NWAVES = 8, NTHREADS = 512;
constexpr int D_MODEL = 4096, BATCH = 4, SEQ = 2048, M_TOK = BATCH * SEQ, IN_COLS = 9216, D_FF = 16384, PLE_DIM = 256;
constexpr int COL_QA = 0, COL_KA = 2048, COL_VA = 2560, COL_QB = 3072, COL_KB = 5120, COL_VB = 7168;
constexpr float NORM_EPS = 1e-6f;
constexpr float LOG2E = 1.4426950408889634f;
constexpr size_t MiB = 1u << 20;
constexpr size_t WS_CTL = 0;
constexpr size_t WS_ROWSS_MLP = 64 * 1024, WS_ROWSS_PLE = 128 * 1024;
constexpr size_t WS_TAB128 = 1 * MiB;
constexpr size_t WS_TAB64 = 2 * MiB;
constexpr size_t WS_WIN = 4 * MiB, WS_WO = 76 * MiB, WS_WUP = 108 * MiB, WS_WDN = 236 * MiB, WS_WG = 364 * MiB, WS_WPLE = 396 * MiB;
constexpr size_t WS_PB = 398 * MiB;
constexpr size_t WS_XN = 402 * MiB;
constexpr size_t WS_PE = 466 * MiB;
constexpr size_t WS_PROJ = 530 * MiB;
constexpr size_t WS_VTA = 674 * MiB, WS_VTB = 682 * MiB;
constexpr size_t WS_CAT = 714 * MiB;
constexpr size_t WS_U = 530 * MiB;
constexpr size_t WS_OSCR = 786 * MiB;
constexpr size_t WS_KIMG128 = 818 * MiB;
constexpr size_t WS_KIMG64 = 826 * MiB;
constexpr size_t WS_END = 858 * MiB;
constexpr int LDS_BYTES = 147456;

#define GAS __attribute__((address_space(1)))
#define LAS __attribute__((address_space(3)))
typedef unsigned short bf16;
typedef unsigned v4u __attribute__((ext_vector_type(4)));
typedef unsigned v2u __attribute__((ext_vector_type(2)));
typedef float f32x4 __attribute__((ext_vector_type(4)));
typedef float f32x2 __attribute__((ext_vector_type(2)));
typedef short bf16x8 __attribute__((ext_vector_type(8)));
#define LDS_WAIT() asm volatile("s_waitcnt lgkmcnt(0)" ::: "memory")

__device__ __forceinline__ unsigned pk2(float lo, float hi) { unsigned r; asm("v_cvt_pk_bf16_f32 %0, %1, %2" : "=v"(r) : "v"(lo), "v"(hi)); return r; }
__device__ __forceinline__ float bflo(unsigned w) { return __uint_as_float(w << 16); }
__device__ __forceinline__ float bfhi(unsigned w) { return __uint_as_float(w & 0xffff0000u); }
__device__ __forceinline__ float wave_max(float v) {
#pragma unroll
    for (int o = 1; o < 64; o <<= 1) v = fmaxf(v, __shfl_xor(v, o));
    return v;
}
__device__ __forceinline__ float wave_sum(float v) {
#pragma unroll
    for (int o = 1; o < 64; o <<= 1) v += __shfl_xor(v, o);
    return v;
}

struct Args {
    const float *x, *p, *attn_g, *w_in, *qa_g, *ka_g, *sinks, *qb_g, *kb_g, *lq1, *lk1, *lq2, *lk2, *subln_g, *w_o, *mlp_g, *w_up, *w_down, *w_ple, *ple_g, *w_gate;
    float* out; unsigned char* ws; int ph_lo, ph_hi, coop, pad;
};

template <bool NT>
__device__ __forceinline__ void p0_transpose_item(const float* W, int K, int N, bf16* WT, LAS unsigned* scr, int item, int lane, const float* kgain = nullptr) {
    const int nblk = N / 64, kb = item / nblk, nb = item % nblk, k0 = 128 * kb, n0 = 64 * nb;
    const float* src = W + (size_t)k0 * N + n0 + lane;
#pragma unroll 1
    for (int kp0 = 0; kp0 < 64; kp0 += 16) { float a[16], b[16];
#pragma unroll
        for (int i = 0; i < 16; ++i) { const float* pa = src + (size_t)(2 * (kp0 + i)) * N; const float* pb = pa + N; a[i] = NT ? __builtin_nontemporal_load(pa) : *pa; b[i] = NT ? __builtin_nontemporal_load(pb) : *pb; }
#pragma unroll
        for (int i = 0; i < 16; ++i) { float ga = 1.f, gb = 1.f; if (kgain) { ga = kgain[k0 + 2 * (kp0 + i)]; gb = kgain[k0 + 2 * (kp0 + i) + 1]; } scr[(kp0 + i) * 65 + lane] = pk2(a[i] * ga, b[i] * gb); } }
    LDS_WAIT(); asm volatile("" ::: "memory");
    const int c = lane & 15;
#pragma unroll
    for (int j = 0; j < 16; ++j) { const int n = (lane >> 4) + 4 * j; const LAS unsigned* s = scr + (4 * c) * 65 + n;
        v4u o; o.x = s[0 * 65]; o.y = s[1 * 65]; o.z = s[2 * 65]; o.w = s[3 * 65];
        *(v4u*)(WT + (size_t)(n0 + n) * K + k0 + 8 * c) = o; }
    LDS_WAIT(); asm volatile("" ::: "memory");
}
template <bool NT>
__device__ __forceinline__ void convert_wdown(const Args& A, LAS unsigned char* lds, int gw, int NGW, int wave, int lane) {
    LAS unsigned* scr = (LAS unsigned*)(lds + wave * 16640);
    constexpr int I_DN = (D_FF / 128) * (D_MODEL / 64);
    for (int it = gw; it < I_DN; it += NGW) p0_transpose_item<NT>(A.w_down, D_FF, D_MODEL, (bf16*)(A.ws + WS_WDN), scr, it, lane);
}
__device__ __forceinline__ void p0_prologue(const Args& A, LAS unsigned char* lds, int gw, int NGW, int wave, int lane) {
    unsigned char* ws = A.ws;
    LAS unsigned* scr = (LAS unsigned*)(lds + wave * 16640);
    constexpr int I_IN = (D_MODEL / 128) * (IN_COLS / 64), I_O = (D_MODEL / 128) * (D_MODEL / 64), I_UP = (D_MODEL / 128) * (D_FF / 64), I_G = I_O, I_PLE = (PLE_DIM / 128) * (D_MODEL / 64);
    constexpr int NITEMS = I_IN + I_O + I_UP + I_G + I_PLE;
    for (int it = gw; it < NITEMS; it += NGW) {
        int r = it;
        if (r < I_IN) { p0_transpose_item<false>(A.w_in, D_MODEL, IN_COLS, (bf16*)(ws + WS_WIN), scr, r, lane); continue; } r -= I_IN;
        if (r < I_O) { p0_transpose_item<false>(A.w_o, D_MODEL, D_MODEL, (bf16*)(ws + WS_WO), scr, r, lane); continue; } r -= I_O;
        if (r < I_UP) { p0_transpose_item<false>(A.w_up, D_MODEL, D_FF, (bf16*)(ws + WS_WUP), scr, r, lane, A.mlp_g); continue; } r -= I_UP;
        if (r < I_G) { p0_transpose_item<false>(A.w_gate, D_MODEL, D_MODEL, (bf16*)(ws + WS_WG), scr, r, lane); continue; } r -= I_G;
        p0_transpose_item<false>(A.w_ple, PLE_DIM, D_MODEL, (bf16*)(ws + WS_WPLE), scr, r, lane);
    }
    for (int m = gw; m < M_TOK; m += NGW) {
        const f32x4* xr = (const f32x4*)(A.x + (size_t)m * D_MODEL) + lane;
        f32x4 v[16]; float s = 0.f;
#pragma unroll
        for (int j = 0; j < 16; ++j) { v[j] = xr[64 * j]; s += (v[j].x * v[j].x + v[j].y * v[j].y) + (v[j].z * v[j].z + v[j].w * v[j].w); }
        const float rstd = 1.0f / sqrtf(wave_sum(s) * (1.0f / D_MODEL) + NORM_EPS);
        v2u* o8 = (v2u*)((bf16*)(ws + WS_XN) + (size_t)m * D_MODEL) + lane;
        const f32x4* gr = (const f32x4*)A.attn_g + lane;
#pragma unroll
        for (int j = 0; j < 16; ++j) { const f32x4 g = gr[64 * j]; v2u o; o.x = pk2(v[j].x * rstd * g.x, v[j].y * rstd * g.y); o.y = pk2(v[j].z * rstd * g.z, v[j].w * rstd * g.w); o8[64 * j] = o; }
    }
    { const int gt = gw * 64 + lane, NGT = NGW * 64;
      for (int i = gt; i < M_TOK * PLE_DIM / 8; i += NGT) { const f32x4 a = ((const f32x4*)A.p)[2 * i], b = ((const f32x4*)A.p)[2 * i + 1];
          v4u o; o.x = pk2(a.x, a.y); o.y = pk2(a.z, a.w); o.z = pk2(b.x, b.y); o.w = pk2(b.z, b.w); ((v4u*)(ws + WS_PB))[i] = o; }
      for (int i = gt; i < SEQ * 64; i += NGT) { const int pos = i >> 6, j = i & 63;
          const float inv = __builtin_amdgcn_exp2f(-(float)(2 * j) * (1.0f / 128.0f) * 13.287712379549449f); const float ang = (float)pos * inv;
          double xr = (double)ang * 0.15915494309189535; xr -= __builtin_rint(xr); const float fx = (float)xr;
          ((f32x2*)(ws + WS_TAB128))[i] = (f32x2){__builtin_amdgcn_cosf(fx), __builtin_amdgcn_sinf(fx)}; }
      for (int i = gt; i < SEQ * 32; i += NGT) { const int pos = i >> 5, j = i & 31;
          const float inv = __builtin_amdgcn_exp2f(-(float)(2 * j) * (1.0f / 64.0f) * 13.287712379549449f); const float ang = (float)pos * inv;
          double xr = (double)ang * 0.15915494309189535; xr -= __builtin_rint(xr); const float fx = (float)xr;
          ((f32x2*)(ws + WS_TAB64))[i] = (f32x2){__builtin_amdgcn_cosf(fx), __builtin_amdgcn_sinf(fx)}; }
      for (int i = gt; i < M_TOK; i += NGT) { ((float*)(ws + WS_ROWSS_MLP))[i] = 0.f; ((float*)(ws + WS_ROWSS_PLE))[i] = 0.f; }
    }
}

__device__ __forceinline__ void p2_qknorm_rope(const Args& A, LAS unsigned char* lds, int gw, int NGW, int tid, int lane) {
    unsigned char* ws = A.ws; bf16* proj = (bf16*)(ws + WS_PROJ);
    const f32x2* tab128 = (const f32x2*)(ws + WS_TAB128); const f32x2* tab64 = (const f32x2*)(ws + WS_TAB64);
    for (int row = gw; row < M_TOK; row += NGW) {
        const int pos = row & (SEQ - 1); bf16* prow = proj + (size_t)row * IN_COLS;
        { const int ch = lane, col = COL_KA + ch * 8, i = ch & 15;
            const v4u w = *(const v4u*)(prow + col);
            float x[8] = {bflo(w.x), bfhi(w.x), bflo(w.y), bfhi(w.y), bflo(w.z), bfhi(w.z), bflo(w.w), bfhi(w.w)};
            float ss = 0.f;
#pragma unroll
            for (int e = 0; e < 8; ++e) ss += x[e] * x[e];
            ss += __shfl_xor(ss, 1); ss += __shfl_xor(ss, 2); ss += __shfl_xor(ss, 4); ss += __shfl_xor(ss, 8);
            const float rstd = 1.0f / sqrtf(ss * (1.0f / 128.0f) + NORM_EPS);
            const float* gp = A.ka_g + i * 8; const f32x4 g0 = *(const f32x4*)gp, g1 = *(const f32x4*)(gp + 4);
            const float g[8] = {g0.x, g0.y, g0.z, g0.w, g1.x, g1.y, g1.z, g1.w};
            const f32x2* tb = tab128 + pos * 64 + (i & 7) * 8; const float sgn = (i < 8) ? -1.f : 1.f;
            float o[8];
#pragma unroll
            for (int e = 0; e < 8; ++e) { const float y = x[e] * rstd * g[e]; const float py = __shfl_xor(y, 8); const f32x2 cs = tb[e]; o[e] = y * cs.x + sgn * py * cs.y; }
            v4u ow; ow.x = pk2(o[0], o[1]); ow.y = pk2(o[2], o[3]); ow.z = pk2(o[4], o[5]); ow.w = pk2(o[6], o[7]);
            { const int b = row / SEQ, jt = pos >> 6, kl = pos & 63, kvh = ch >> 4, t = 2 * (kl >> 5) + ((kl >> 2) & 1), rr = 4 * ((kl >> 3) & 3) + (kl & 3), c = i >> 2, fq = i & 3;
              int ob = rr * 64 + fq * 16; ob ^= ((ob >> 9) & 1) << 5;
              *(v4u*)(ws + WS_KIMG128 + ((size_t)(((b * 4 + kvh) * 32 + jt) * 16 + t * 4 + c)) * 1024 + ob) = ow; } }
#pragma unroll
        for (int it = 0; it < 4; ++it) { const int ch = it * 64 + lane, col = COL_KB + ch * 8, i = ch & 7;
            const v4u w = *(const v4u*)(prow + col);
            float x[8] = {bflo(w.x), bfhi(w.x), bflo(w.y), bfhi(w.y), bflo(w.z), bfhi(w.z), bflo(w.w), bfhi(w.w)};
            float ss = 0.f;
#pragma unroll
            for (int e = 0; e < 8; ++e) ss += x[e] * x[e];
            ss += __shfl_xor(ss, 1); ss += __shfl_xor(ss, 2); ss += __shfl_xor(ss, 4);
            const float rstd = 1.0f / sqrtf(ss * (1.0f / 64.0f) + NORM_EPS);
            const float* gp = A.kb_g + i * 8; const f32x4 g0 = *(const f32x4*)gp, g1 = *(const f32x4*)(gp + 4);
            const float g[8] = {g0.x, g0.y, g0.z, g0.w, g1.x, g1.y, g1.z, g1.w};
            const f32x2* tb = tab64 + pos * 32 + (i & 3) * 8; const float sgn = (i < 4) ? -1.f : 1.f;
            float o[8];
#pragma unroll
            for (int e = 0; e < 8; ++e) { const float y = x[e] * rstd * g[e]; const float py = __shfl_xor(y, 4); const f32x2 cs = tb[e]; o[e] = y * cs.x + sgn * py * cs.y; }
            v4u ow; ow.x = pk2(o[0], o[1]); ow.y = pk2(o[2], o[3]); ow.z = pk2(o[4], o[5]); ow.w = pk2(o[6], o[7]);
            { const int b = row / SEQ, jt = pos >> 6, kl = pos & 63, mh = ch >> 3, t = 2 * (kl >> 5) + ((kl >> 2) & 1), rr = 4 * ((kl >> 3) & 3) + (kl & 3), c = i >> 2, fq = i & 3;
              int ob = rr * 64 + fq * 16; ob ^= ((ob >> 9) & 1) << 5;
              *(v4u*)(ws + WS_KIMG64 + ((size_t)(((b * 32 + mh) * 32 + jt) * 8 + t * 2 + c)) * 1024 + ob) = ow; } }
    }
    LAS bf16* T = (LAS bf16*)lds;
    for (int tile = blockIdx.x; tile < (M_TOK / 64) * 20; tile += gridDim.x) {
        const int tb = tile / 20, hd = tile % 20, b = tb / (SEQ / 64), s0 = (tb % (SEQ / 64)) * 64;
        const int vcol = hd < 4 ? COL_VA + hd * 128 : COL_VB + (hd - 4) * 128;
        unsigned char* dst = hd < 4 ? ws + WS_VTA + ((size_t)(b * 4 + hd) * 32 + (s0 >> 6)) * 16384 : ws + WS_VTB + ((size_t)(b * 16 + (hd - 4)) * 32 + (s0 >> 6)) * 16384;
#pragma unroll
        for (int k = 0; k < 2; ++k) { const int ci = tid + 512 * k, tok = ci >> 4, dc = ci & 15;
            const v4u w = *(const v4u*)(proj + (size_t)(tb * 64 + tok) * IN_COLS + vcol + dc * 8);
            LAS bf16* t = T + (dc * 8) * 72 + tok;
            t[0 * 72] = (bf16)(w.x & 0xffff); t[1 * 72] = (bf16)(w.x >> 16); t[2 * 72] = (bf16)(w.y & 0xffff); t[3 * 72] = (bf16)(w.y >> 16);
            t[4 * 72] = (bf16)(w.z & 0xffff); t[5 * 72] = (bf16)(w.z >> 16); t[6 * 72] = (bf16)(w.w & 0xffff); t[7 * 72] = (bf16)(w.w >> 16); }
        __syncthreads();
#pragma unroll
        for (int k = 0; k < 2; ++k) { const int ci = tid + 512 * k, d = ci >> 3, tc = ci & 7;
            const v4u w = *(const LAS v4u*)(T + d * 72 + tc * 8);
            const int dtp = 2 * (d >> 5) + ((d >> 2) & 1), rrp = 4 * ((d >> 3) & 3) + (d & 3);
            int ob = rrp * 64 + (tc & 3) * 16; ob ^= ((ob >> 9) & 1) << 5;
            *(v4u*)(dst + (dtp * 2 + (tc >> 2)) * 1024 + ob) = w; }
        __syncthreads();
    }
}

namespace att {
constexpr int BUF_BYTES = 32768, K_OFF = 0, V_OFF = 16384;
constexpr float NEG = -1e30f;
__device__ __forceinline__ int swz(int rr, int fq) { const int ob = rr * 64 + fq * 16; return ob ^ (((ob >> 9) & 1) << 5); }

template <int DK>
__device__ __forceinline__ void dma_tile(LAS unsigned char* buf, const unsigned char* ktile, const unsigned char* vtile, int wave, unsigned lane16) {
    constexpr int NK = 4 * (DK / 32), PER = (NK + 16) / 8;
#pragma unroll
    for (int i = 0; i < PER; ++i) { const int st = wave * PER + i;
        const unsigned char* gp; LAS unsigned char* dst;
        if (st < NK) { gp = ktile + st * 1024 + lane16; dst = buf + K_OFF + st * 1024; }
        else { gp = vtile + (st - NK) * 1024 + lane16; dst = buf + V_OFF + (st - NK) * 1024; }
        __builtin_amdgcn_global_load_lds((const unsigned*)gp, (LAS unsigned*)dst, 16, 0, 0); }
}

template <int DK, bool SWA>
__device__ __forceinline__ void pass(LAS unsigned char* lds, const bf16* Q, int ldq, const float* qgain, const f32x2* qtab, const float qscale, const unsigned char* kimg, const unsigned char* vimg, int q0, int jt_lo, int jt_hi,
                                     float (&mrow)[2], float (&lrow)[2], f32x4 (&O)[2][8], const bool online, const float mfix, int tid, int wave, int lane) {
    constexpr int PER = (4 * (DK / 32) + 16) / 8;
    const int fr = lane & 15, fq = lane >> 4, qw = q0 + 32 * wave;
    const int ntile = jt_hi - jt_lo + 1;
    constexpr int KT_BYTES = 4 * (DK / 32) * 1024; const unsigned lane16 = (unsigned)lane * 16u;
#pragma unroll
    for (int p = 0; p < 2; ++p) if (p < ntile) dma_tile<DK>(lds + p * BUF_BYTES, kimg + (size_t)(jt_lo + p) * KT_BYTES, vimg + (size_t)(jt_lo + p) * 16384, wave, lane16);
    bf16x8 qf[2][DK / 32];
#pragma unroll
    for (int rg = 0; rg < 2; ++rg) {
        const int qrow = qw + 16 * rg + fr;
        float x[DK / 32][8]; float ss = 0.f;
#pragma unroll
        for (int c = 0; c < DK / 32; ++c) { const v4u w = *(const v4u*)(Q + (size_t)qrow * ldq + 32 * c + 8 * fq);
            x[c][0] = bflo(w.x); x[c][1] = bfhi(w.x); x[c][2] = bflo(w.y); x[c][3] = bfhi(w.y); x[c][4] = bflo(w.z); x[c][5] = bfhi(w.z); x[c][6] = bflo(w.w); x[c][7] = bfhi(w.w);
#pragma unroll
            for (int e = 0; e < 8; ++e) ss += x[c][e] * x[c][e]; }
        ss += __shfl_xor(ss, 16); ss += __shfl_xor(ss, 32);
        const float rq = qscale / sqrtf(ss * (1.0f / DK) + NORM_EPS);
#pragma unroll
        for (int c = 0; c < DK / 64; ++c) { const int ch = c + DK / 64;
            const f32x4 ga = *(const f32x4*)(qgain + 32 * c + 8 * fq), gb = *(const f32x4*)(qgain + 32 * c + 8 * fq + 4), gc = *(const f32x4*)(qgain + 32 * ch + 8 * fq), gd = *(const f32x4*)(qgain + 32 * ch + 8 * fq + 4);
            const float gl[8] = {ga.x, ga.y, ga.z, ga.w, gb.x, gb.y, gb.z, gb.w}, gh[8] = {gc.x, gc.y, gc.z, gc.w, gd.x, gd.y, gd.z, gd.w};
            const f32x4* tp = (const f32x4*)(qtab + (size_t)qrow * (DK / 2) + 32 * c + 8 * fq);
            const f32x4 t0 = tp[0], t1 = tp[1], t2 = tp[2], t3 = tp[3];
            const float cs[8] = {t0.x, t0.z, t1.x, t1.z, t2.x, t2.z, t3.x, t3.z}, sn[8] = {t0.y, t0.w, t1.y, t1.w, t2.y, t2.w, t3.y, t3.w};
            float ol[8], oh[8];
#pragma unroll
            for (int e = 0; e < 8; ++e) { const float yl = x[c][e] * gl[e], yh = x[ch][e] * gh[e]; ol[e] = (yl * cs[e] - yh * sn[e]) * rq; oh[e] = (yh * cs[e] + yl * sn[e]) * rq; }
            v4u wl, wh; wl.x = pk2(ol[0], ol[1]); wl.y = pk2(ol[2], ol[3]); wl.z = pk2(ol[4], ol[5]); wl.w = pk2(ol[6], ol[7]);
            wh.x = pk2(oh[0], oh[1]); wh.y = pk2(oh[2], oh[3]); wh.z = pk2(oh[4], oh[5]); wh.w = pk2(oh[6], oh[7]);
            qf[rg][c] = __builtin_bit_cast(bf16x8, wl); qf[rg][ch] = __builtin_bit_cast(bf16x8, wh); }
    }
    const int fro = swz(fr, fq);
    const float sinit = online ? 0.f : -mfix;
#define ATT_PV(pvbuf) do { bf16x8 vfa[4][2], vfb[4][2]; \
        _Pragma("unroll") for (int dt = 0; dt < 4; ++dt) _Pragma("unroll") for (int u = 0; u < 2; ++u) vfa[dt][u] = *(const LAS bf16x8*)((pvbuf) + V_OFF + (dt * 2 + u) * 1024 + fro); \
        _Pragma("unroll") for (int dt = 0; dt < 4; ++dt) _Pragma("unroll") for (int u = 0; u < 2; ++u) vfb[dt][u] = *(const LAS bf16x8*)((pvbuf) + V_OFF + ((dt + 4) * 2 + u) * 1024 + fro); \
        __builtin_amdgcn_s_setprio(1); \
        _Pragma("unroll") for (int dt = 0; dt < 8; ++dt) _Pragma("unroll") for (int u = 0; u < 2; ++u) _Pragma("unroll") for (int rg = 0; rg < 2; ++rg) \
            O[rg][dt] = __builtin_amdgcn_mfma_f32_16x16x32_bf16(dt < 4 ? vfa[dt][u] : vfb[dt - 4][u], pf[rg][u], O[rg][dt], 0, 0, 0); \
        __builtin_amdgcn_s_setprio(0); } while (0)
    const bool lagB = wave >= 4;
    bool pend = false;
    bf16x8 pf[2][2];
#pragma unroll
    for (int rg = 0; rg < 2; ++rg)
#pragma unroll
        for (int u = 0; u < 2; ++u) pf[rg][u] = (bf16x8){0, 0, 0, 0, 0, 0, 0, 0};
    for (int i = 0; i < ntile; ++i) {
        const int jt = jt_lo + i, rem = ntile - 1 - i;
        if (rem >= 1) asm volatile("s_waitcnt vmcnt(%0)" :: "n"(PER) : "memory");
        else asm volatile("s_waitcnt vmcnt(0)" ::: "memory");
        __builtin_amdgcn_s_barrier(); asm volatile("" ::: "memory");
        if (i + 2 < ntile) dma_tile<DK>(lds + ((i + 2) & 3) * BUF_BYTES, kimg + (size_t)(jt + 2) * KT_BYTES, vimg + (size_t)(jt + 2) * 16384, wave, lane16);
        if (lagB && pend) { ATT_PV(lds + ((i - 1) & 3) * BUF_BYTES); pend = false; }
        LAS unsigned char* buf = lds + (i & 3) * BUF_BYTES;
        const int kt0 = jt * 64;
        bool need = kt0 <= qw + 31; if (SWA) need = need && (kt0 + 63 >= qw - 127);
        if (need) {
            f32x4 s[2][4];
            {
                bf16x8 kf[4][DK / 32];
#pragma unroll
                for (int t = 0; t < 4; ++t)
#pragma unroll
                    for (int c = 0; c < DK / 32; ++c) kf[t][c] = *(const LAS bf16x8*)(buf + K_OFF + (t * (DK / 32) + c) * 1024 + fro);
                __builtin_amdgcn_s_setprio(1);
#pragma unroll
                for (int t = 0; t < 4; ++t) {
#pragma unroll
                    for (int rg = 0; rg < 2; ++rg) s[rg][t] = (f32x4){sinit, sinit, sinit, sinit};
#pragma unroll
                    for (int c = 0; c < DK / 32; ++c)
#pragma unroll
                        for (int rg = 0; rg < 2; ++rg) s[rg][t] = __builtin_amdgcn_mfma_f32_16x16x32_bf16(kf[t][c], qf[rg][c], s[rg][t], 0, 0, 0); }
                __builtin_amdgcn_s_setprio(0);
            }
            const bool domask = SWA || (kt0 + 63 > qw);
            if (domask) {
#pragma unroll
                for (int rg = 0; rg < 2; ++rg) { const int q = qw + 16 * rg + fr;
#pragma unroll
                    for (int t = 0; t < 4; ++t)
#pragma unroll
                        for (int i2 = 0; i2 < 4; ++i2) { const int key = kt0 + 32 * (t >> 1) + 8 * fq + 4 * (t & 1) + i2;
                            bool ok = key <= q; if (SWA) ok = ok && (q - key < 128);
                            s[rg][t][i2] = ok ? s[rg][t][i2] : NEG; } }
            }
            if (!online) {
#pragma unroll
                for (int rg = 0; rg < 2; ++rg) {
                    float ps = 0.f;
#pragma unroll
                    for (int t = 0; t < 4; ++t)
#pragma unroll
                        for (int i2 = 0; i2 < 4; ++i2) { const float p = __builtin_amdgcn_exp2f(s[rg][t][i2]); s[rg][t][i2] = p; ps += p; }
                    lrow[rg] += ps;
#pragma unroll
                    for (int u = 0; u < 2; ++u) { v4u w; w.x = pk2(s[rg][2 * u][0], s[rg][2 * u][1]); w.y = pk2(s[rg][2 * u][2], s[rg][2 * u][3]);
                        w.z = pk2(s[rg][2 * u + 1][0], s[rg][2 * u + 1][1]); w.w = pk2(s[rg][2 * u + 1][2], s[rg][2 * u + 1][3]); pf[rg][u] = __builtin_bit_cast(bf16x8, w); }
                }
            } else
#pragma unroll
            for (int rg = 0; rg < 2; ++rg) {
                float mx = NEG;
#pragma unroll
                for (int t = 0; t < 4; ++t) mx = fmaxf(mx, fmaxf(fmaxf(s[rg][t][0], s[rg][t][1]), fmaxf(s[rg][t][2], s[rg][t][3])));
                mx = fmaxf(mx, __shfl_xor(mx, 16)); mx = fmaxf(mx, __shfl_xor(mx, 32));
                const float mnew = fmaxf(mrow[rg], mx), alpha = __builtin_amdgcn_exp2f(mrow[rg] - mnew); mrow[rg] = mnew;
                float ps = 0.f;
#pragma unroll
                for (int t = 0; t < 4; ++t)
#pragma unroll
                    for (int i2 = 0; i2 < 4; ++i2) { const float p = __builtin_amdgcn_exp2f(s[rg][t][i2] - mnew); s[rg][t][i2] = p; ps += p; }
                lrow[rg] = lrow[rg] * alpha + ps;
#pragma unroll
                for (int dt = 0; dt < 8; ++dt) O[rg][dt] = O[rg][dt] * alpha;
#pragma unroll
                for (int u = 0; u < 2; ++u) { v4u w; w.x = pk2(s[rg][2 * u][0], s[rg][2 * u][1]); w.y = pk2(s[rg][2 * u][2], s[rg][2 * u][3]);
                    w.z = pk2(s[rg][2 * u + 1][0], s[rg][2 * u + 1][1]); w.w = pk2(s[rg][2 * u + 1][2], s[rg][2 * u + 1][3]); pf[rg][u] = __builtin_bit_cast(bf16x8, w); }
            }
            if (lagB) pend = true; else ATT_PV(buf);
        }
    }
    if (lagB && pend) ATT_PV(lds + ((ntile - 1) & 3) * BUF_BYTES);
#undef ATT_PV
    __builtin_amdgcn_s_barrier(); asm volatile("" ::: "memory");
}

__device__ __forceinline__ void init_state(float (&m)[2], float (&l)[2], f32x4 (&O)[2][8], float m0) {
#pragma unroll
    for (int rg = 0; rg < 2; ++rg) { m[rg] = m0; l[rg] = 0.f;
#pragma unroll
        for (int dt = 0; dt < 8; ++dt) O[rg][dt] = (f32x4){0.f, 0.f, 0.f, 0.f}; }
}

__device__ __forceinline__ void swa_unit(const Args& A, LAS unsigned char* lds, int unit, const bool online, const float mfix) {
    int tid_ = threadIdx.x; asm volatile("" : "+v"(tid_));
    const int tid = tid_, lane = tid & 63, wave = __builtin_amdgcn_readfirstlane(tid >> 6);
    unsigned char* ws = A.ws; const bf16* proj = (const bf16*)(ws + WS_PROJ);
    const int qb = unit & 7, hq = (unit >> 3) & 15, b = unit >> 7, kvh = hq >> 2, q0 = qb * 256;
    const bf16* Q = proj + (size_t)b * SEQ * IN_COLS + COL_QA + hq * 128;
    const unsigned char* kimg = ws + WS_KIMG128 + (size_t)(b * 4 + kvh) * 32 * 16384;
    const unsigned char* vimg = ws + WS_VTA + (size_t)(b * 4 + kvh) * 32 * 16384;
    float m[2], l[2]; f32x4 O[2][8]; init_state(m, l, O, online ? NEG : mfix);
    const int jt_lo = (4 * qb - 2) > 0 ? 4 * qb - 2 : 0, jt_hi = 4 * qb + 3;
    pass<128, true>(lds, Q, IN_COLS, A.qa_g, (const f32x2*)(ws + WS_TAB128), 0.08838834764831845f * LOG2E, kimg, vimg, q0, jt_lo, jt_hi, m, l, O, online, mfix, tid, wave, lane);
    int lane2 = lane; asm volatile("" : "+v"(lane2));
    const int fr = lane2 & 15, fq = lane2 >> 4; const float sink2 = A.sinks[hq] * LOG2E;
    bf16* cat = (bf16*)(ws + WS_CAT);
#pragma unroll
    for (int rg = 0; rg < 2; ++rg) { float lt = l[rg]; lt += __shfl_xor(lt, 16); lt += __shfl_xor(lt, 32);
        lt += __builtin_amdgcn_exp2f(sink2 - m[rg]); const float inv = 1.0f / lt;
        bf16* orow = cat + (size_t)(b * SEQ + q0 + 32 * wave + 16 * rg + fr) * D_MODEL + hq * 128 + 8 * fq;
#pragma unroll
        for (int k = 0; k < 4; ++k) { const f32x4 o0 = O[rg][2 * k] * inv, o1 = O[rg][2 * k + 1] * inv; v4u w; w.x = pk2(o0[0], o0[1]); w.y = pk2(o0[2], o0[3]); w.z = pk2(o1[0], o1[1]); w.w = pk2(o1[2], o1[3]); *(v4u*)(orow + 32 * k) = w; } }
}
__device__ __forceinline__ void diff_unit(const Args& A, LAS unsigned char* lds, int b, int h, int qb, float lam, const bool online, const float mfix) {
    int tid_ = threadIdx.x; asm volatile("" : "+v"(tid_));
    const int tid = tid_, lane = tid & 63, wave = __builtin_amdgcn_readfirstlane(tid >> 6);
    unsigned char* ws = A.ws; const bf16* proj = (const bf16*)(ws + WS_PROJ);
    const int q0 = qb * 256; const size_t boff = (size_t)b * SEQ * IN_COLS;
    const unsigned char* vimg = ws + WS_VTB + (size_t)(b * 16 + h) * 32 * 16384;
    const int jt_hi = 4 * qb + 3;
    float m[2], l[2]; f32x4 O1[2][8], O0[2][8];
    unsigned char* oscr = ws + WS_OSCR + (size_t)blockIdx.x * 131072; const unsigned tid16 = (unsigned)tid * 16u;
#pragma unroll 1
    for (int mp = 0; mp < 2; ++mp) {
        init_state(m, l, O1, online ? NEG : mfix);
        pass<64, false>(lds, proj + boff + COL_QB + mp * 1024 + h * 64, IN_COLS, A.qb_g, (const f32x2*)(ws + WS_TAB64), 0.125f * LOG2E, ws + WS_KIMG64 + (size_t)((b * 2 + mp) * 16 + h) * 32 * 8192, vimg, q0, 0, jt_hi, m, l, O1, online, mfix, tid, wave, lane);
        if (mp == 0) {
#pragma unroll
            for (int rg = 0; rg < 2; ++rg) { float lt = l[rg]; lt += __shfl_xor(lt, 16); lt += __shfl_xor(lt, 32); const float inv = 1.0f / lt;
#pragma unroll
                for (int dt = 0; dt < 8; ++dt) *(f32x4*)(oscr + (rg * 8 + dt) * 8192 + tid16) = O1[rg][dt] * inv; }
        }
    }
#pragma unroll
    for (int rg = 0; rg < 2; ++rg)
#pragma unroll
        for (int dt = 0; dt < 8; ++dt) O0[rg][dt] = *(const f32x4*)(oscr + (rg * 8 + dt) * 8192 + tid16);
    int lane2 = lane; asm volatile("" : "+v"(lane2));
    const int fr = lane2 & 15, fq = lane2 >> 4;
    bf16* cat = (bf16*)(ws + WS_CAT);
#pragma unroll
    for (int rg = 0; rg < 2; ++rg) { float lt = l[rg]; lt += __shfl_xor(lt, 16); lt += __shfl_xor(lt, 32); const float sc = -lam / lt;
        float ss = 0.f;
#pragma unroll
        for (int dt = 0; dt < 8; ++dt) { const f32x4 o = O0[rg][dt] + O1[rg][dt] * sc; O0[rg][dt] = o; ss += (o[0] * o[0] + o[1] * o[1]) + (o[2] * o[2] + o[3] * o[3]); }
        ss += __shfl_xor(ss, 16); ss += __shfl_xor(ss, 32);
        const float rs = 0.8f / sqrtf(ss * (1.0f / 128.0f) + NORM_EPS);
        bf16* orow = cat + (size_t)(b * SEQ + q0 + 32 * wave + 16 * rg + fr) * D_MODEL + 2048 + h * 128 + 8 * fq;
#pragma unroll
        for (int k = 0; k < 4; ++k) { const f32x4 g0 = *(const f32x4*)(A.subln_g + 32 * k + 8 * fq), g1 = *(const f32x4*)(A.subln_g + 32 * k + 8 * fq + 4); const f32x4 o0 = O0[rg][2 * k] * g0 * rs, o1 = O0[rg][2 * k + 1] * g1 * rs;
            v4u w; w.x = pk2(o0[0], o0[1]); w.y = pk2(o0[2], o0[3]); w.z = pk2(o1[0], o1[1]); w.w = pk2(o1[2], o1[3]); *(v4u*)(orow + 32 * k) = w; } }
}
}

#define RLX_AGENT __ATOMIC_RELAXED, __HIP_MEMORY_SCOPE_AGENT
#define XB_TMO      128
#define XB_XCNT(j)  (256  + 64 * (j))
#define XB_XSUB(j)  (1280 + 64 * (j))
#define XB_XGEN(j)  (2304 + 64 * (j))
#define XB_TOP      3328
#define XB_TOPGEN   3392
#define XCD_BAR_WORDS 3456
#define XB_SPIN_CAP (1u << 18)

__device__ __forceinline__ unsigned xb_ld(unsigned* p)              { return __hip_atomic_load(p, __ATOMIC_RELAXED, __HIP_MEMORY_SCOPE_AGENT); }
__device__ __forceinline__ unsigned xb_add(unsigned* p, unsigned v) { return __hip_atomic_fetch_add(p, v, __ATOMIC_RELAXED, __HIP_MEMORY_SCOPE_AGENT); }
__device__ __forceinline__ unsigned xb_xcc_id() { return (unsigned)__builtin_amdgcn_s_getreg((3 << 11) | 20) & 0xFu; }
#define XB_SPIN(cond, bar) do { unsigned _sp = 0; while (cond) { __builtin_amdgcn_s_sleep(1); \
    if ((++_sp & 255u) == 0u) { if (xb_ld(&(bar)[XB_TMO])) break; if (_sp > XB_SPIN_CAP) { atomicAdd(&(bar)[XB_TMO], 1u); break; } } } } while (0)

struct XcdBarrier {
    unsigned* bar; unsigned x;
    volatile LAS unsigned* st;
};

__device__ __forceinline__ XcdBarrier xcd_barrier_post(unsigned* bar, volatile LAS unsigned* st) {
    XcdBarrier b; b.bar = bar; b.x = xb_xcc_id(); b.st = st;
    if (threadIdx.x == 0) (void)xb_add(&bar[XB_XCNT(b.x)], 1u);
    return b;
}
__device__ __forceinline__ void xcd_barrier_complete(unsigned* bar, unsigned x, unsigned& nloc, unsigned& nx) {
    const unsigned G = gridDim.x * gridDim.y * gridDim.z;
    unsigned sum, cnt, mine, sp = 0u;
    for (;;) {
        sum = 0u; cnt = 0u; mine = 0u;
#pragma unroll
        for (unsigned j = 0; j < 16; ++j) { const unsigned c = xb_ld(&bar[XB_XCNT(j)]); sum += c; cnt += (c > 0u) ? 1u : 0u; mine = (j == x) ? c : mine; }
        if (sum == G) break;
        __builtin_amdgcn_s_sleep(1);
        if ((++sp & 255u) == 0u) { if (xb_ld(&bar[XB_TMO])) break; if (sp > XB_SPIN_CAP) { atomicAdd(&bar[XB_TMO], 1u); break; } }
    }
    nloc = mine > 0u ? mine : 1u; nx = cnt > 0u ? cnt : 1u;
}

__device__ __forceinline__ void xcd_barrier(const XcdBarrier& b) {
    asm volatile("s_waitcnt vmcnt(0)" ::: "memory");
    __syncthreads();
    if (threadIdx.x == 0) {
        unsigned* bar = b.bar;
        __builtin_amdgcn_s_waitcnt(0);
        unsigned nloc = b.st[0], nx = b.st[1];
        if (nloc == 0u) { xcd_barrier_complete(bar, b.x, nloc, nx); b.st[0] = nloc; b.st[1] = nx; }
        const unsigned old = xb_add(&bar[XB_XSUB(b.x)], 1u);
        const unsigned gen = old / nloc;
        if (old + 1u == (gen + 1u) * nloc) {
            __builtin_amdgcn_fence(__ATOMIC_RELEASE, "agent");
            asm volatile("s_waitcnt vmcnt(0)" ::: "memory");
            const unsigned og = xb_add(&bar[XB_TOP], 1u);
            const unsigned tg = og / nx;
            if (og + 1u == (tg + 1u) * nx) xb_add(&bar[XB_TOPGEN], 1u);
            else XB_SPIN(xb_ld(&bar[XB_TOPGEN]) == tg, bar);
            __builtin_amdgcn_fence(__ATOMIC_ACQUIRE, "agent");
            xb_add(&bar[XB_XGEN(b.x)], 1u);
            asm volatile("s_waitcnt vmcnt(0)" ::: "memory");
        } else {
            XB_SPIN(xb_ld(&bar[XB_XGEN(b.x)]) == gen, bar);
            __builtin_amdgcn_fence(__ATOMIC_ACQUIRE, "agent");
            asm volatile("s_waitcnt vmcnt(0)" ::: "memory");
        }
    }
    __syncthreads();
}

#define PG8_SP2 true
#define PG8_ALIGN true
__global__ void __launch_bounds__(NTHREADS, 2) hymba_fwd(Args A) {
    extern __shared__ __attribute__((aligned(16))) unsigned char lds_raw[];
    LAS unsigned char* lds = (LAS unsigned char*)lds_raw;
    const int tid = threadIdx.x, lane = tid & 63, wave = __builtin_amdgcn_readfirstlane(tid >> 6);
    const int G = gridDim.x, gw = blockIdx.x * NWAVES + wave, NGW = G * NWAVES;
    unsigned char* ws = A.ws;
    const int lo = A.ph_lo, hi = A.ph_hi;
#ifndef PHMASK
#define PHMASK 0xff
#endif
#define IN(k) (((PHMASK >> (k)) & 1) && lo <= (k) && (k) < hi)
#ifndef DIAG
#define DIAG 0
#endif
#define STAMP(k) do { if (DIAG && blockIdx.x == 0 && tid == 0) ((unsigned long long*)(ws + 32768))[k] = __builtin_amdgcn_s_memrealtime(); } while (0)
#define SEAM(k) do { if (IN(k) && IN((k) + 1)) { xcd_barrier(bar); } STAMP((k) + 1); } while (0)
    volatile LAS unsigned* MISC = (volatile LAS unsigned*)(lds + LDS_BYTES - 64);
    if (tid < 16) MISC[tid] = 0u;
    __syncthreads();
    XcdBarrier bar; bar.bar = (unsigned*)(ws + WS_CTL); bar.x = 0; bar.st = nullptr;
    if (A.coop) bar = xcd_barrier_post((unsigned*)(ws + WS_CTL), MISC);
    if (A.coop == 2) cg::this_grid().sync();

#ifndef REP0
#define REP0 1
#endif
#ifndef REP3
#define REP3 1
#endif
#ifndef REP5
#define REP5 1
#endif
#ifndef WDOWN_IN_P1
#define WDOWN_IN_P1 1
#endif
    const int p1_rem = WDOWN_IN_P1 ? ((M_TOK / 256) * (IN_COLS / 256)) % G : 0;
    STAMP(0);
    if (IN(0)) { for (int rep = 0; rep < REP0; ++rep) p0_prologue(A, lds, gw, NGW, wave, lane); if (p1_rem == 0) convert_wdown<false>(A, lds, gw, NGW, wave, lane); }
    SEAM(0);
    if (IN(1)) {
        { pg8::Gemm g{(const bf16*)(ws + WS_XN), (const bf16*)(ws + WS_WIN), M_TOK, IN_COLS, D_MODEL}; pg8::StaticOrder S; S.init(M_TOK, IN_COLS, G, (int)blockIdx.x);
          pg8::EpiPlain E{(bf16*)(ws + WS_PROJ), IN_COLS};
          pg8::gemm_phase<pg8::EpiPlain, pg8::StaticOrder, PG8_ALIGN, PG8_SP2>(lds, g, S, E); }
        { pg8::Gemm g{(const bf16*)(ws + WS_PB), (const bf16*)(ws + WS_WPLE), M_TOK, D_MODEL, PLE_DIM}; pg8::StaticOrder S; S.init(M_TOK, D_MODEL, G, (int)blockIdx.x);
          pg8::EpiPle E{(bf16*)(ws + WS_PE), D_MODEL, (float*)(ws + WS_ROWSS_PLE)};
          pg8::gemm_phase<pg8::EpiPle, pg8::StaticOrder, PG8_ALIGN, PG8_SP2>(lds, g, S, E); }
        if (p1_rem != 0 && (int)blockIdx.x >= p1_rem) convert_wdown<true>(A, lds, ((int)blockIdx.x - p1_rem) * NWAVES + wave, (G - p1_rem) * NWAVES, wave, lane);
    }
    SEAM(1);
    if (IN(2)) { p2_qknorm_rope(A, lds, gw, NGW, tid, lane); }
    SEAM(2);
    if (IN(3)) {
        const float s1 = wave_sum(A.lq1[lane] * A.lk1[lane]), s2 = wave_sum(A.lq2[lane] * A.lk2[lane]);
        const float lam = __expf(s1) - __expf(s2) + 0.2f;
        const float gqa = wave_max(fmaxf(fabsf(A.qa_g[lane]), fabsf(A.qa_g[lane + 64]))), gka = wave_max(fmaxf(fabsf(A.ka_g[lane]), fabsf(A.ka_g[lane + 64])));
        const float gqb = wave_max(fabsf(A.qb_g[lane])), gkb = wave_max(fabsf(A.kb_g[lane]));
        const float B128 = gqa * gka * 11.313708499f * LOG2E * 1.02f, B64 = gqb * gkb * 8.0f * LOG2E * 1.02f;
        const bool on128 = !(B128 <= 30.f), on64 = !(B64 <= 30.f);
        for (int rep = 0; rep < REP3; ++rep) {
#ifndef NO_DIFF
#pragma unroll 1
        for (int pr2 = 2 * blockIdx.x; pr2 < 512; pr2 += 2 * G)
#pragma unroll 1
            for (int k = 0; k < 2; ++k) { const int pr = pr2 >> 1, b = pr >> 6, h = (pr >> 2) & 15, pi = pr & 3;
                att::diff_unit(A, lds, b, h, k ? pi : 7 - pi, lam, on64, B64); }
#endif
#ifndef NO_SWA
#pragma unroll 1
        for (int un = blockIdx.x; un < 512; un += G) att::swa_unit(A, lds, un, on128, B128);
#endif
        }
    }
    SEAM(3);
    if (IN(4)) {
        pg8::Gemm g{(const bf16*)(ws + WS_CAT), (const bf16*)(ws + WS_WO), M_TOK, D_MODEL, D_MODEL}; pg8::StaticOrder S; S.init(M_TOK, D_MODEL, G, (int)blockIdx.x);
        pg8::EpiResX E{A.x, (bf16*)(ws + WS_XN), D_MODEL, (float*)(ws + WS_ROWSS_MLP)};
        pg8::gemm_phase<pg8::EpiResX, pg8::StaticOrder, PG8_ALIGN, PG8_SP2>(lds, g, S, E);
    }
    SEAM(4);
    if (IN(5)) {
        pg8::Gemm g{(const bf16*)(ws + WS_XN), (const bf16*)(ws + WS_WUP), M_TOK, D_FF, D_MODEL}; pg8::StaticOrder S; S.init(M_TOK, D_FF, G, (int)blockIdx.x);
        pg8::EpiUp E{(bf16*)(ws + WS_U), D_FF, (const float*)(ws + WS_ROWSS_MLP), 1.0f / D_MODEL};
        for (int rep = 0; rep < REP5; ++rep) pg8::gemm_phase<pg8::EpiUp, pg8::StaticOrder, PG8_ALIGN, PG8_SP2>(lds, g, S, E);
    }
    SEAM(5);
    if (IN(6)) {
        pg8::Gemm g{(const bf16*)(ws + WS_U), (const bf16*)(ws + WS_WDN), M_TOK, D_MODEL, D_FF}; pg8::StaticOrder S; S.init(M_TOK, D_MODEL, G, (int)blockIdx.x);
        pg8::EpiResB E{(bf16*)(ws + WS_XN), D_MODEL};
        pg8::gemm_phase<pg8::EpiResB, pg8::StaticOrder, PG8_ALIGN, PG8_SP2>(lds, g, S, E);
    }
    SEAM(6);
    if (IN(7)) {
        pg8::Gemm g{(const bf16*)(ws + WS_XN), (const bf16*)(ws + WS_WG), M_TOK, D_MODEL, D_MODEL}; pg8::StaticOrder S; S.init(M_TOK, D_MODEL, G, (int)blockIdx.x);
        pg8::EpiFinalB E{A.out, (const bf16*)(ws + WS_XN), (const bf16*)(ws + WS_PE), D_MODEL, (const float*)(ws + WS_ROWSS_PLE), A.ple_g, 1.0f / D_MODEL};
        pg8::gemm_phase<pg8::EpiFinalB, pg8::StaticOrder, PG8_ALIGN, PG8_SP2>(lds, g, S, E);
    }
#if DIAG
    STAMP(8); xcd_barrier(bar);
    if (blockIdx.x == 0 && tid == 0) { const unsigned long long* ts = (const unsigned long long*)(ws + 32768); A.out[0] = (float)(ts[DIAG_B] - ts[DIAG_A]) * 0.01f; }
#endif
#undef IN
#undef SEAM
}

#ifndef MK_PER_PHASE
#define MK_PER_PHASE 0
#endif
extern "C" void kernel_launch(void* const* d_in, const int* in_sizes, int n_in, void* d_out, int out_size, void* d_ws, size_t ws_size, hipStream_t stream) {
    static int grid = 0;
    if (grid == 0) {
        if (n_in != 21 || in_sizes[0] != M_TOK * D_MODEL || out_size != M_TOK * D_MODEL || ws_size < WS_END) { fprintf(stderr, "kernel_launch: unexpected shapes (n_in %d, ws %zu); nothing launched\n", n_in, ws_size); grid = -1; return; }
        int dev = 0, cus = 0, per_cu = 0;
        if (hipGetDevice(&dev) != hipSuccess || hipDeviceGetAttribute(&cus, hipDeviceAttributeMultiprocessorCount, dev) != hipSuccess) { grid = -1; return; }
        if (hipFuncSetAttribute((const void*)hymba_fwd, hipFuncAttributeMaxDynamicSharedMemorySize, LDS_BYTES) != hipSuccess) { fprintf(stderr, "kernel_launch: hipFuncSetAttribute failed\n"); grid = -1; return; }
        if (hipOccupancyMaxActiveBlocksPerMultiprocessor(&per_cu, (const void*)hymba_fwd, NTHREADS, LDS_BYTES) != hipSuccess || per_cu < 1) { fprintf(stderr, "kernel_launch: occupancy query says %d\n", per_cu); per_cu = 1; }
        (void)hipGetLastError();
        grid = cus;
    }
    if (grid < 0) return;
    if (hipMemsetAsync((char*)d_ws + WS_CTL, 0, 16384, stream) != hipSuccess) { fprintf(stderr, "kernel_launch: memset failed\n"); return; }
    Args a{};
    const float** f = (const float**)&a;
    for (int i = 0; i < 21; ++i) f[i] = (const float*)d_in[i];
    a.out = (float*)d_out; a.ws = (unsigned char*)d_ws;
#if MK_PER_PHASE
    for (int ph = 0; ph < 8; ++ph) { a.ph_lo = ph; a.ph_hi = ph + 1; a.coop = 0; hipLaunchKernelGGL(hymba_fwd, dim3(grid), dim3(NTHREADS), LDS_BYTES, stream, a); }
#else
    a.ph_lo = 0; a.ph_hi = 8; a.coop = 1;
    void* args[] = {&a};
    hipError_t e = hipLaunchCooperativeKernel((const void*)hymba_fwd, dim3(grid), dim3(NTHREADS), args, LDS_BYTES, stream);
    if (e != hipSuccess) fprintf(stderr, "kernel_launch: cooperative launch failed: %s (grid %d)\n", hipGetErrorString(e), grid);
#endif
}
```

```cpp
#include <hip/hip_runtime.h>
#include <hip/hip_cooperative_groups.h>
#include <cstdio>
#include <cstdint>
namespace cg = cooperative_groups;
namespace pg8 {
#define PG8_LAS __attribute__((address_space(3)))
typedef unsigned short bf16_t;
typedef short bf16x8 __attribute__((ext_vector_type(8)));
typedef float f32x4 __attribute__((ext_vector_type(4)));
typedef unsigned u32x4 __attribute__((ext_vector_type(4)));
constexpr int BM = 256, BK = 64, HALF = 128, HTB = HALF * BK * 2  , STAGE_BYTES = 8 * HTB, NXCD = 8, WGM = 8;

__host__ __device__ __forceinline__ int lds_byte(int r, int c) { const int st = (r >> 4) * 2 + (c >> 5), rr = r & 15, cc = c & 31, ob = rr * 64 + cc * 2; return st * 1024 + (ob ^ (((ob >> 9) & 1) << 5)); }
__host__ __device__ __forceinline__ void stage_rc(int b, int& R, int& C) { const int st = b / 1024, sb = b % 1024, swz = sb ^ (((sb >> 9) & 1) << 5); R = (st >> 1) * 16 + swz / 64; C = (st & 1) * 32 + (swz % 64) / 2; }
__host__ __device__ __forceinline__ int perm32(int rho) { const int n = rho >> 4, i = rho & 15; return 8 * (i >> 2) + 4 * n + (i & 3); }

struct Unit { int pm, pn; };
struct Gemm { const bf16_t* A; const bf16_t* Bt; int M, N, K; };

struct StaticOrder {
    int nM, nN, nwg, G, c;
    __host__ __device__ void init(int M, int N, int G_, int c_) { nM = M / BM; nN = N / BM; nwg = nM * nN; G = G_; c = c_; }
    __host__ __device__ bool next(int i, Unit& u) const {
        const long L = (long)i * G + c; if (L >= nwg) return false;
        int wgid = (int)L; { const int q = nwg / NXCD, r = nwg % NXCD, xcd = wgid % NXCD, off = wgid / NXCD; wgid = (xcd < r ? xcd * (q + 1) : r * (q + 1) + (xcd - r) * q) + off; }
        const int nig = WGM * nN, gid = wgid / nig, fm = gid * WGM, gsz = (nM - fm) < WGM ? (nM - fm) : WGM;
        u.pm = fm + ((wgid % nig) % gsz); u.pn = (wgid % nig) / gsz; return true;
    }
    __device__ __forceinline__ void a_ready(const Unit&) const {}
    __device__ __forceinline__ void done(const Unit&) const {}
};

__device__ __forceinline__ unsigned cvt_pk_bf16(float lo, float hi) { unsigned r; asm volatile("v_cvt_pk_bf16_f32 %0, %1, %2" : "=v"(r) : "v"(lo), "v"(hi)); return r; }
typedef float f32x2 __attribute__((ext_vector_type(2)));
constexpr float RMS_EPS = 1e-6f;
__device__ __forceinline__ u32x4 pack8(const f32x4 v0, const f32x4 v1) { u32x4 w; w.x = cvt_pk_bf16(v0[0], v0[1]); w.y = cvt_pk_bf16(v0[2], v0[3]); w.z = cvt_pk_bf16(v1[0], v1[1]); w.w = cvt_pk_bf16(v1[2], v1[3]); return w; }
__device__ __forceinline__ float bf_lo(unsigned w) { return __uint_as_float(w << 16); }
__device__ __forceinline__ float bf_hi(unsigned w) { return __uint_as_float(w & 0xffff0000u); }

struct EpiPlain {
    static constexpr bool PERM = true, AFTER_DRAIN = false;
    bf16_t* O; int ldc;
    __device__ __forceinline__ void operator()(const f32x4 (&acc)[2][2][4][2], const Unit& u, int wr, int wc, int fr, int fq) const {
        const int row0 = u.pm * BM + wr * 64 + fr, col0 = u.pn * BM + wc * 32 + 8 * fq;
#pragma unroll
        for (int ai = 0; ai < 2; ++ai)
#pragma unroll
            for (int m = 0; m < 4; ++m) { bf16_t* rowp = O + (size_t)(row0 + ai * HALF + m * 16) * ldc + col0;
#pragma unroll
                for (int bj = 0; bj < 2; ++bj) *(u32x4*)(rowp + bj * HALF) = pack8(acc[ai][bj][m][0], acc[ai][bj][m][1]); }
    }
};
struct EpiPle {
    static constexpr bool PERM = true, AFTER_DRAIN = false;
    bf16_t* O; int ldc; float* rowss;
    __device__ __forceinline__ void operator()(const f32x4 (&acc)[2][2][4][2], const Unit& u, int wr, int wc, int fr, int fq) const {
        const int row0 = u.pm * BM + wr * 64 + fr, col0 = u.pn * BM + wc * 32 + 8 * fq;
#pragma unroll
        for (int ai = 0; ai < 2; ++ai)
#pragma unroll
            for (int m = 0; m < 4; ++m) { const int row = row0 + ai * HALF + m * 16; bf16_t* rowp = O + (size_t)row * ldc + col0; float ss = 0.f;
#pragma unroll
                for (int bj = 0; bj < 2; ++bj) { const f32x4 v0 = acc[ai][bj][m][0], v1 = acc[ai][bj][m][1];
                    ss += (v0[0] * v0[0] + v0[1] * v0[1]) + (v0[2] * v0[2] + v0[3] * v0[3]) + (v1[0] * v1[0] + v1[1] * v1[1]) + (v1[2] * v1[2] + v1[3] * v1[3]);
                    *(u32x4*)(rowp + bj * HALF) = pack8(v0, v1); }
                ss += __shfl_xor(ss, 16); ss += __shfl_xor(ss, 32);
                if (fq == 0) atomicAdd(rowss + row, ss); }
    }
};
struct EpiUp {
    static constexpr bool PERM = true, AFTER_DRAIN = false;
    bf16_t* O; int ldc; const float* rowss; float inv_nfeat;
    __device__ __forceinline__ void operator()(const f32x4 (&acc)[2][2][4][2], const Unit& u, int wr, int wc, int fr, int fq) const {
        const int row0 = u.pm * BM + wr * 64 + fr, col0 = u.pn * BM + wc * 32 + 8 * fq;
#pragma unroll
        for (int ai = 0; ai < 2; ++ai)
#pragma unroll
            for (int m = 0; m < 4; ++m) { const int row = row0 + ai * HALF + m * 16; bf16_t* rowp = O + (size_t)row * ldc + col0;
                const float r2 = 1.0f / (rowss[row] * inv_nfeat + RMS_EPS);
#pragma unroll
                for (int bj = 0; bj < 2; ++bj) { f32x4 v0 = acc[ai][bj][m][0], v1 = acc[ai][bj][m][1];
#pragma unroll
                    for (int e = 0; e < 4; ++e) { const float a = fmaxf(v0[e], 0.f), b = fmaxf(v1[e], 0.f); v0[e] = a * a * r2; v1[e] = b * b * r2; }
                    *(u32x4*)(rowp + bj * HALF) = pack8(v0, v1); } }
    }
};
struct EpiRes {
    static constexpr bool PERM = true, AFTER_DRAIN = false;
    const float* base; float* out; bf16_t* hb; int ldc; const float* gain; float* rowss;
    __device__ __forceinline__ void operator()(const f32x4 (&acc)[2][2][4][2], const Unit& u, int wr, int wc, int fr, int fq) const {
        const int row0 = u.pm * BM + wr * 64 + fr, col0 = u.pn * BM + wc * 32 + 8 * fq;
        f32x4 g[2][2];
#pragma unroll
        for (int bj = 0; bj < 2; ++bj)
#pragma unroll
            for (int n = 0; n < 2; ++n) g[bj][n] = gain ? *(const f32x4*)(gain + col0 + bj * HALF + 4 * n) : (f32x4){1.f, 1.f, 1.f, 1.f};
#pragma unroll
        for (int ai = 0; ai < 2; ++ai)
#pragma unroll
            for (int m = 0; m < 4; ++m) { const int row = row0 + ai * HALF + m * 16; const size_t off = (size_t)row * ldc + col0; float ss = 0.f;
#pragma unroll
                for (int bj = 0; bj < 2; ++bj) { const f32x4 b0 = *(const f32x4*)(base + off + bj * HALF), b1 = *(const f32x4*)(base + off + bj * HALF + 4);
                    const f32x4 v0 = acc[ai][bj][m][0] + b0, v1 = acc[ai][bj][m][1] + b1;
                    *(f32x4*)(out + off + bj * HALF) = v0; *(f32x4*)(out + off + bj * HALF + 4) = v1;
                    ss += (v0[0] * v0[0] + v0[1] * v0[1]) + (v0[2] * v0[2] + v0[3] * v0[3]) + (v1[0] * v1[0] + v1[1] * v1[1]) + (v1[2] * v1[2] + v1[3] * v1[3]);
                    *(u32x4*)(hb + off + bj * HALF) = pack8(v0 * g[bj][0], v1 * g[bj][1]); }
                if (rowss) { ss += __shfl_xor(ss, 16); ss += __shfl_xor(ss, 32); if (fq == 0) atomicAdd(rowss + row, ss); } }
    }
};
struct EpiFinal {
    static constexpr bool PERM = true, AFTER_DRAIN = false;
    float* out; const bf16_t* pe; int ldc; const float* rowss; const float* gple; float inv_nfeat;
    __device__ __forceinline__ void operator()(const f32x4 (&acc)[2][2][4][2], const Unit& u, int wr, int wc, int fr, int fq) const {
        const int row0 = u.pm * BM + wr * 64 + fr, col0 = u.pn * BM + wc * 32 + 8 * fq;
        f32x4 g[2][2];
#pragma unroll
        for (int bj = 0; bj < 2; ++bj)
#pragma unroll
            for (int n = 0; n < 2; ++n) g[bj][n] = *(const f32x4*)(gple + col0 + bj * HALF + 4 * n);
#pragma unroll
        for (int ai = 0; ai < 2; ++ai)
#pragma unroll
            for (int m = 0; m < 4; ++m) { const int row = row0 + ai * HALF + m * 16; const size_t off = (size_t)row * ldc + col0;
                const float rs = 1.0f / sqrtf(rowss[row] * inv_nfeat + RMS_EPS);
#pragma unroll
                for (int bj = 0; bj < 2; ++bj) { const f32x4 b0 = *(const f32x4*)(out + off + bj * HALF), b1 = *(const f32x4*)(out + off + bj * HALF + 4);
                    const u32x4 pw = *(const u32x4*)(pe + off + bj * HALF);
                    const f32x4 p0 = (f32x4){bf_lo(pw.x), bf_hi(pw.x), bf_lo(pw.y), bf_hi(pw.y)}, p1 = (f32x4){bf_lo(pw.z), bf_hi(pw.z), bf_lo(pw.w), bf_hi(pw.w)};
                    f32x4 v0 = acc[ai][bj][m][0], v1 = acc[ai][bj][m][1];
#pragma unroll
                    for (int e = 0; e < 4; ++e) { v0[e] = 1.0f / (1.0f + __expf(-v0[e])); v1[e] = 1.0f / (1.0f + __expf(-v1[e])); }
                    v0 = b0 + v0 * (p0 * g[bj][0]) * rs; v1 = b1 + v1 * (p1 * g[bj][1]) * rs;
                    *(f32x4*)(out + off + bj * HALF) = v0; *(f32x4*)(out + off + bj * HALF + 4) = v1; } }
    }
};

struct EpiResX {
    static constexpr bool PERM = true, AFTER_DRAIN = false;
    const float* base; bf16_t* hb; int ldc; float* rowss;
    __device__ __forceinline__ void operator()(const f32x4 (&acc)[2][2][4][2], const Unit& u, int wr, int wc, int fr, int fq) const {
        const int row0 = u.pm * BM + wr * 64 + fr, col0 = u.pn * BM + wc * 32 + 8 * fq;
#pragma unroll
        for (int ai = 0; ai < 2; ++ai)
#pragma unroll
            for (int m = 0; m < 4; ++m) { const int row = row0 + ai * HALF + m * 16; const size_t off = (size_t)row * ldc + col0; float ss = 0.f;
#pragma unroll
                for (int bj = 0; bj < 2; ++bj) { const f32x4 b0 = *(const f32x4*)(base + off + bj * HALF), b1 = *(const f32x4*)(base + off + bj * HALF + 4);
                    const f32x4 v0 = acc[ai][bj][m][0] + b0, v1 = acc[ai][bj][m][1] + b1;
                    ss += (v0[0] * v0[0] + v0[1] * v0[1]) + (v0[2] * v0[2] + v0[3] * v0[3]) + (v1[0] * v1[0] + v1[1] * v1[1]) + (v1[2] * v1[2] + v1[3] * v1[3]);
                    *(u32x4*)(hb + off + bj * HALF) = pack8(v0, v1); }
                ss += __shfl_xor(ss, 16); ss += __shfl_xor(ss, 32); if (fq == 0) atomicAdd(rowss + row, ss); }
    }
};
struct EpiResB {
    static constexpr bool PERM = true, AFTER_DRAIN = false;
    bf16_t* hb; int ldc;
    __device__ __forceinline__ void operator()(const f32x4 (&acc)[2][2][4][2], const Unit& u, int wr, int wc, int fr, int fq) const {
        const int row0 = u.pm * BM + wr * 64 + fr, col0 = u.pn * BM + wc * 32 + 8 * fq;
#pragma unroll
        for (int ai = 0; ai < 2; ++ai)
#pragma unroll
            for (int m = 0; m < 4; ++m) { const size_t off = (size_t)(row0 + ai * HALF + m * 16) * ldc + col0;
#pragma unroll
                for (int bj = 0; bj < 2; ++bj) { const u32x4 bw = *(const u32x4*)(hb + off + bj * HALF);
                    const f32x4 b0 = (f32x4){bf_lo(bw.x), bf_hi(bw.x), bf_lo(bw.y), bf_hi(bw.y)}, b1 = (f32x4){bf_lo(bw.z), bf_hi(bw.z), bf_lo(bw.w), bf_hi(bw.w)};
                    *(u32x4*)(hb + off + bj * HALF) = pack8(acc[ai][bj][m][0] + b0, acc[ai][bj][m][1] + b1); } }
    }
};
struct EpiFinalB {
    static constexpr bool PERM = true, AFTER_DRAIN = false;
    float* out; const bf16_t* h2; const bf16_t* pe; int ldc; const float* rowss; const float* gple; float inv_nfeat;
    __device__ __forceinline__ void operator()(const f32x4 (&acc)[2][2][4][2], const Unit& u, int wr, int wc, int fr, int fq) const {
        const int row0 = u.pm * BM + wr * 64 + fr, col0 = u.pn * BM + wc * 32 + 8 * fq;
        f32x4 g[2][2];
#pragma unroll
        for (int bj = 0; bj < 2; ++bj)
#pragma unroll
            for (int n = 0; n < 2; ++n) g[bj][n] = *(const f32x4*)(gple + col0 + bj * HALF + 4 * n);
#pragma unroll
        for (int ai = 0; ai < 2; ++ai)
#pragma unroll
            for (int m = 0; m < 4; ++m) { const int row = row0 + ai * HALF + m * 16; const size_t off = (size_t)row * ldc + col0;
                const float rs = 1.0f / sqrtf(rowss[row] * inv_nfeat + RMS_EPS);
#pragma unroll
                for (int bj = 0; bj < 2; ++bj) { const u32x4 bw = *(const u32x4*)(h2 + off + bj * HALF); const u32x4 pw = *(const u32x4*)(pe + off + bj * HALF);
                    const f32x4 b0 = (f32x4){bf_lo(bw.x), bf_hi(bw.x), bf_lo(bw.y), bf_hi(bw.y)}, b1 = (f32x4){bf_lo(bw.z), bf_hi(bw.z), bf_lo(bw.w), bf_hi(bw.w)};
                    const f32x4 p0 = (f32x4){bf_lo(pw.x), bf_hi(pw.x), bf_lo(pw.y), bf_hi(pw.y)}, p1 = (f32x4){bf_lo(pw.z), bf_hi(pw.z), bf_lo(pw.w), bf_hi(pw.w)};
                    f32x4 v0 = acc[ai][bj][m][0], v1 = acc[ai][bj][m][1];
#pragma unroll
                    for (int e = 0; e < 4; ++e) { v0[e] = 1.0f / (1.0f + __expf(-v0[e])); v1[e] = 1.0f / (1.0f + __expf(-v1[e])); }
                    v0 = b0 + v0 * (p0 * g[bj][0]) * rs; v1 = b1 + v1 * (p1 * g[bj][1]) * rs;
                    *(f32x4*)(out + off + bj * HALF) = v0; *(f32x4*)(out + off + bj * HALF + 4) = v1; } }
    }
};
template <class Epi, class Sched, bool ALIGN_EPI = false, bool SP2 = false>
__device__ __forceinline__ void gemm_phase(PG8_LAS unsigned char* lds, const Gemm g, const Sched& S, const Epi& E) {
    const int tid = threadIdx.x, wid = __builtin_amdgcn_readfirstlane(tid >> 6), lane = tid & 63, wr = wid >> 2, wc = wid & 3, fr = lane & 15, fq = lane >> 4;
    const int K = g.K, nt = K / BK;
    unsigned voffA[2], voffB[2];
#pragma unroll
    for (int i = 0; i < 2; ++i) { int R, C; stage_rc(tid * 16 + i * 8192, R, C); const int Rb = Epi::PERM ? ((R & ~31) + perm32(R & 31)) : R;
        voffA[i] = (unsigned)(R * K + C) * 2u; voffB[i] = (unsigned)(Rb * K + C) * 2u; }
    const size_t kstep = (size_t)(BK * 2);
    const size_t hstep = (size_t)HALF * K * 2;
    const size_t tstep = 2 * hstep;
    const unsigned ldsw = (unsigned)wid * 1024u;
    const int aoff = lds_byte(wr * 64 + fr, fq * 8), boff = lds_byte(wc * 32 + fr, fq * 8);
#define PG8_SA(b, h) (((b) * 2 + (h)) * HTB)
#define PG8_SB(b, h) ((4 + (b) * 2 + (h)) * HTB)
#define PG8_STAGE(bufoff, gbase, voff) do { _Pragma("unroll") for (int _i = 0; _i < 2; ++_i) \
        __builtin_amdgcn_global_load_lds((const unsigned*)((const char*)(gbase) + (voff)[_i]), (PG8_LAS unsigned*)(lds + (bufoff) + ldsw + _i * 8192), 16, 0, 0); } while (0)
#define PG8_LDA(dst, b, h) do { _Pragma("unroll") for (int m = 0; m < 4; ++m) _Pragma("unroll") for (int k = 0; k < 2; ++k) dst[m][k] = *(const PG8_LAS bf16x8*)(lds + PG8_SA(b, h) + aoff + m * 2048 + k * 1024); } while (0)
#define PG8_LDB(dst, b, h) do { _Pragma("unroll") for (int n = 0; n < 2; ++n) _Pragma("unroll") for (int k = 0; k < 2; ++k) dst[n][k] = *(const PG8_LAS bf16x8*)(lds + PG8_SB(b, h) + boff + n * 2048 + k * 1024); } while (0)
#define PG8_MMA(ai, bj, At, Bt) do { __builtin_amdgcn_s_setprio(1); _Pragma("unroll") for (int m = 0; m < 4; ++m) _Pragma("unroll") for (int n = 0; n < 2; ++n) _Pragma("unroll") for (int k = 0; k < 2; ++k) \
        acc[ai][bj][m][n] = __builtin_amdgcn_mfma_f32_16x16x32_bf16(Bt[n][k], At[m][k], acc[ai][bj][m][n], 0, 0, 0); __builtin_amdgcn_s_setprio(0); } while (0)
#define PG8_WAIT_V(n) asm volatile("s_waitcnt vmcnt(" #n ")" ::: "memory")
#define PG8_WAIT_L(n) asm volatile("s_waitcnt lgkmcnt(" #n ")" ::: "memory")
#define PG8_BAR __builtin_amdgcn_s_barrier()
#define PG8_SCHED __builtin_amdgcn_sched_barrier(0)
    Unit cur, nxt; int ui = 0;
    if (!S.next(0, cur)) return;
    f32x4 acc[2][2][4][2];
#pragma unroll
    for (int a = 0; a < 2; ++a)
#pragma unroll
        for (int b = 0; b < 2; ++b)
#pragma unroll
            for (int m = 0; m < 4; ++m)
#pragma unroll
                for (int n = 0; n < 2; ++n) acc[a][b][m][n] = (f32x4){0.f, 0.f, 0.f, 0.f};
    bf16x8 At[4][2], B0[2][2], B1[2][2];
    const char* cA = (const char*)g.A + (size_t)cur.pm * tstep; const char* cB = (const char*)g.Bt + (size_t)cur.pn * tstep;
    S.a_ready(cur);
    if constexpr (SP2) {
        PG8_STAGE(PG8_SB(0, 0), cB, voffB); PG8_STAGE(PG8_SB(0, 1), cB + hstep, voffB); PG8_STAGE(PG8_SA(0, 0), cA, voffA); PG8_STAGE(PG8_SA(0, 1), cA + hstep, voffA);
        if (wr == 1) PG8_BAR;
        PG8_WAIT_V(2); PG8_BAR;
        PG8_STAGE(PG8_SB(1, 0), cB + kstep, voffB); PG8_STAGE(PG8_SA(1, 0), cA + kstep, voffA); PG8_STAGE(PG8_SB(1, 1), cB + hstep + kstep, voffB);
        PG8_WAIT_V(6); PG8_BAR;
    } else {
        PG8_STAGE(PG8_SB(0, 0), cB, voffB); PG8_STAGE(PG8_SA(0, 0), cA, voffA); PG8_STAGE(PG8_SB(0, 1), cB + hstep, voffB); PG8_STAGE(PG8_SA(0, 1), cA + hstep, voffA);
        if (wr == 1) PG8_BAR;
        PG8_WAIT_V(4); PG8_BAR;
        PG8_STAGE(PG8_SB(1, 0), cB + kstep, voffB); PG8_STAGE(PG8_SA(1, 0), cA + kstep, voffA); PG8_STAGE(PG8_SB(1, 1), cB + hstep + kstep, voffB);
        PG8_WAIT_V(6); PG8_BAR;
    }
    for (;;) {
        const bool has_next = S.next(ui + 1, nxt);
        const char* nA = has_next ? (const char*)g.A + (size_t)nxt.pm * tstep : cA; const char* nB = has_next ? (const char*)g.Bt + (size_t)nxt.pn * tstep : cB;
        for (int t = 0; t < nt; t += 2) {
            const bool last = (t == nt - 2);
            const char* a1 = cA + (size_t)(t + 1) * kstep;
            const char* a2 = last ? nA : cA + (size_t)(t + 2) * kstep; const char* b2 = last ? nB : cB + (size_t)(t + 2) * kstep;
            const char* a3 = a2 + kstep; const char* b3 = b2 + kstep;
            if (last && has_next) S.a_ready(nxt);
            if constexpr (SP2) {
            PG8_LDB(B0, 0, 0); PG8_LDB(B1, 0, 1); PG8_SCHED; PG8_LDA(At, 0, 0); PG8_STAGE(PG8_SA(1, 1), a1 + hstep, voffA);
            PG8_WAIT_V(8); PG8_WAIT_L(0); PG8_BAR; PG8_MMA(0, 0, At, B0); PG8_MMA(0, 1, At, B1); PG8_BAR; PG8_SCHED;
            PG8_LDA(At, 0, 1); PG8_STAGE(PG8_SB(0, 0), b2, voffB); PG8_STAGE(PG8_SB(0, 1), b2 + hstep, voffB); PG8_STAGE(PG8_SA(0, 0), a2, voffA);
            PG8_WAIT_V(8); PG8_WAIT_L(0); PG8_BAR; PG8_MMA(1, 0, At, B0); PG8_MMA(1, 1, At, B1); PG8_BAR; PG8_SCHED;
            PG8_LDB(B0, 1, 0); PG8_LDB(B1, 1, 1); PG8_SCHED; PG8_LDA(At, 1, 0); PG8_STAGE(PG8_SA(0, 1), a2 + hstep, voffA);
            PG8_WAIT_V(8); PG8_WAIT_L(0); PG8_BAR; PG8_MMA(0, 0, At, B0); PG8_MMA(0, 1, At, B1); PG8_BAR; PG8_SCHED;
            PG8_LDA(At, 1, 1); PG8_STAGE(PG8_SB(1, 0), b3, voffB); PG8_STAGE(PG8_SB(1, 1), b3 + hstep, voffB); PG8_STAGE(PG8_SA(1, 0), a3, voffA);
            PG8_WAIT_V(8); PG8_WAIT_L(0); PG8_BAR; PG8_MMA(1, 0, At, B0); PG8_MMA(1, 1, At, B1); PG8_BAR; PG8_SCHED;
            } else {
            PG8_LDB(B0, 0, 0); PG8_SCHED; PG8_LDA(At, 0, 0); PG8_STAGE(PG8_SA(1, 1), a1 + hstep, voffA);
            PG8_WAIT_L(8); PG8_BAR; PG8_WAIT_L(0); PG8_MMA(0, 0, At, B0); PG8_BAR; PG8_SCHED;
            PG8_LDB(B1, 0, 1); PG8_STAGE(PG8_SB(0, 0), b2, voffB);
            PG8_BAR; PG8_WAIT_L(0); PG8_MMA(0, 1, At, B1); PG8_BAR;
            PG8_LDA(At, 0, 1); PG8_STAGE(PG8_SA(0, 0), a2, voffA);
            PG8_BAR; PG8_WAIT_L(0); PG8_MMA(1, 0, At, B0); PG8_BAR; PG8_SCHED;
            PG8_STAGE(PG8_SB(0, 1), b2 + hstep, voffB);
            PG8_WAIT_V(6); PG8_BAR; PG8_MMA(1, 1, At, B1); PG8_BAR;
            PG8_LDB(B0, 1, 0); PG8_SCHED; PG8_LDA(At, 1, 0); PG8_STAGE(PG8_SA(0, 1), a2 + hstep, voffA);
            PG8_WAIT_L(8); PG8_BAR; PG8_WAIT_L(0); PG8_MMA(0, 0, At, B0); PG8_BAR; PG8_SCHED;
            PG8_LDB(B1, 1, 1); PG8_STAGE(PG8_SB(1, 0), b3, voffB);
            PG8_BAR; PG8_WAIT_L(0); PG8_MMA(0, 1, At, B1); PG8_BAR;
            PG8_LDA(At, 1, 1); PG8_STAGE(PG8_SA(1, 0), a3, voffA);
            PG8_BAR; PG8_WAIT_L(0); PG8_MMA(1, 0, At, B0); PG8_BAR; PG8_SCHED;
            PG8_STAGE(PG8_SB(1, 1), b3 + hstep, voffB);
            PG8_WAIT_V(6); PG8_BAR; PG8_MMA(1, 1, At, B1); PG8_BAR;
            }
        }
        if constexpr (ALIGN_EPI) { if (wr == 0) PG8_BAR; }
        if constexpr (!Epi::AFTER_DRAIN) { E(acc, cur, wr, wc, fr, fq); S.done(cur); }
        if (!has_next) break;
#pragma unroll
        for (int a = 0; a < 2; ++a)
#pragma unroll
            for (int b = 0; b < 2; ++b)
#pragma unroll
                for (int m = 0; m < 4; ++m)
#pragma unroll
                    for (int n = 0; n < 2; ++n) acc[a][b][m][n] = (f32x4){0.f, 0.f, 0.f, 0.f};
        cur = nxt; cA = nA; cB = nB; ++ui;
        if constexpr (ALIGN_EPI) { if (wr == 1) PG8_BAR; }
    }
    PG8_WAIT_V(0);
    if constexpr (!ALIGN_EPI) { if (wr == 0) PG8_BAR; }
    PG8_BAR;
    if constexpr (Epi::AFTER_DRAIN) { E.fused(acc, cur, wr, wc, fr, fq, lds, wid, lane); S.done(cur); }
#undef PG8_SA
#undef PG8_SB
#undef PG8_STAGE
#undef PG8_LDA
#undef PG8_LDB
#undef PG8_MMA
#undef PG8_WAIT_V
#undef PG8_WAIT_L
#undef PG8_BAR
#undef PG8_SCHED
}
}

constexpr int NWAVES = 8, NTHREADS = 512;
constexpr int D_MODEL = 4096, BATCH = 4, SEQ = 2048, M_TOK = BATCH * SEQ, IN_COLS = 9216, D_FF = 16384, PLE_DIM = 256;
constexpr int COL_QA = 0, COL_KA = 2048, COL_VA = 2560, COL_QB = 3072, COL_KB = 5120, COL_VB = 7168;
constexpr float NORM_EPS = 1e-6f;
constexpr float LOG2E = 1.4426950408889634f;
constexpr size_t MiB = 1u << 20;
constexpr size_t WS_CTL = 0;
constexpr size_t WS_ROWSS_MLP = 64 * 1024, WS_ROWSS_PLE = 128 * 1024;
constexpr size_t WS_TAB128 = 1 * MiB;
constexpr size_t WS_TAB64 = 2 * MiB;
constexpr size_t WS_WIN = 4 * MiB, WS_WO = 76 * MiB, WS_WUP = 108 * MiB, WS_WDN = 236 * MiB, WS_WG = 364 * MiB, WS_WPLE = 396 * MiB;
constexpr size_t WS_PB = 398 * MiB;
constexpr size_t WS_XN = 402 * MiB;
constexpr size_t WS_PE = 466 * MiB;
constexpr size_t WS_PROJ = 530 * MiB;
constexpr size_t WS_VTA = 674 * MiB, WS_VTB = 682 * MiB;
constexpr size_t WS_CAT = 714 * MiB;
constexpr size_t WS_U = 530 * MiB;
constexpr size_t WS_OSCR = 786 * MiB;
constexpr size_t WS_KIMG128 = 818 * MiB;
constexpr size_t WS_KIMG64 = 826 * MiB;
constexpr size_t WS_END = 858 * MiB;
constexpr int LDS_BYTES = 147456;

#define GAS __attribute__((address_space(1)))
#define LAS __attribute__((address_space(3)))
typedef unsigned short bf16;
typedef unsigned v4u __attribute__((ext_vector_type(4)));
typedef unsigned v2u __attribute__((ext_vector_type(2)));
typedef float f32x4 __attribute__((ext_vector_type(4)));
typedef float f32x2 __attribute__((ext_vector_type(2)));
typedef short bf16x8 __attribute__((ext_vector_type(8)));
#define LDS_WAIT() asm volatile("s_waitcnt lgkmcnt(0)" ::: "memory")

__device__ __forceinline__ unsigned pk2(float lo, float hi) { unsigned r; asm("v_cvt_pk_bf16_f32 %0, %1, %2" : "=v"(r) : "v"(lo), "v"(hi)); return r; }
__device__ __forceinline__ float bflo(unsigned w) { return __uint_as_float(w << 16); }
__device__ __forceinline__ float bfhi(unsigned w) { return __uint_as_float(w & 0xffff0000u); }
__device__ __forceinline__ float wave_max(float v) {
#pragma unroll
    for (int o = 1; o < 64; o <<= 1) v = fmaxf(v, __shfl_xor(v, o));
    return v;
}
__device__ __forceinline__ float wave_sum(float v) {
#pragma unroll
    for (int o = 1; o < 64; o <<= 1) v += __shfl_xor(v, o);
    return v;
}

struct Args {
    const float *x, *p, *attn_g, *w_in, *qa_g, *ka_g, *sinks, *qb_g, *kb_g, *lq1, *lk1, *lq2, *lk2, *subln_g, *w_o, *mlp_g, *w_up, *w_down, *w_ple, *ple_g, *w_gate;
    float* out; unsigned char* ws; int ph_lo, ph_hi, coop, pad;
};

template <bool NT>
__device__ __forceinline__ void p0_transpose_item(const float* W, int K, int N, bf16* WT, LAS unsigned* scr, int item, int lane, const float* kgain = nullptr) {
    const int nblk = N / 64, kb = item / nblk, nb = item % nblk, k0 = 128 * kb, n0 = 64 * nb;
    const float* src = W + (size_t)k0 * N + n0 + lane;
#pragma unroll 1
    for (int kp0 = 0; kp0 < 64; kp0 += 16) { float a[16], b[16];
#pragma unroll
        for (int i = 0; i < 16; ++i) { const float* pa = src + (size_t)(2 * (kp0 + i)) * N; const float* pb = pa + N; a[i] = NT ? __builtin_nontemporal_load(pa) : *pa; b[i] = NT ? __builtin_nontemporal_load(pb) : *pb; }
#pragma unroll
        for (int i = 0; i < 16; ++i) { float ga = 1.f, gb = 1.f; if (kgain) { ga = kgain[k0 + 2 * (kp0 + i)]; gb = kgain[k0 + 2 * (kp0 + i) + 1]; } scr[(kp0 + i) * 65 + lane] = pk2(a[i] * ga, b[i] * gb); } }
    LDS_WAIT(); asm volatile("" ::: "memory");
    const int c = lane & 15;
#pragma unroll
    for (int j = 0; j < 16; ++j) { const int n = (lane >> 4) + 4 * j; const LAS unsigned* s = scr + (4 * c) * 65 + n;
        v4u o; o.x = s[0 * 65]; o.y = s[1 * 65]; o.z = s[2 * 65]; o.w = s[3 * 65];
        *(v4u*)(WT + (size_t)(n0 + n) * K + k0 + 8 * c) = o; }
    LDS_WAIT(); asm volatile("" ::: "memory");
}
template <bool NT>
__device__ __forceinline__ void convert_wdown(const Args& A, LAS unsigned char* lds, int gw, int NGW, int wave, int lane) {
    LAS unsigned* scr = (LAS unsigned*)(lds + wave * 16640);
    constexpr int I_DN = (D_FF / 128) * (D_MODEL / 64);
    for (int it = gw; it < I_DN; it += NGW) p0_transpose_item<NT>(A.w_down, D_FF, D_MODEL, (bf16*)(A.ws + WS_WDN), scr, it, lane);
}
__device__ __forceinline__ void p0_prologue(const Args& A, LAS unsigned char* lds, int gw, int NGW, int wave, int lane) {
    unsigned char* ws = A.ws;
    LAS unsigned* scr = (LAS unsigned*)(lds + wave * 16640);
    constexpr int I_IN = (D_MODEL / 128) * (IN_COLS / 64), I_O = (D_MODEL / 128) * (D_MODEL / 64), I_UP = (D_MODEL / 128) * (D_FF / 64), I_G = I_O, I_PLE = (PLE_DIM / 128) * (D_MODEL / 64);
    constexpr int NITEMS = I_IN + I_O + I_UP + I_G + I_PLE;
    for (int it = gw; it < NITEMS; it += NGW) {
        int r = it;
        if (r < I_IN) { p0_transpose_item<false>(A.w_in, D_MODEL, IN_COLS, (bf16*)(ws + WS_WIN), scr, r, lane); continue; } r -= I_IN;
        if (r < I_O) { p0_transpose_item<false>(A.w_o, D_MODEL, D_MODEL, (bf16*)(ws + WS_WO), scr, r, lane); continue; } r -= I_O;
        if (r < I_UP) { p0_transpose_item<false>(A.w_up, D_MODEL, D_FF, (bf16*)(ws + WS_WUP), scr, r, lane, A.mlp_g); continue; } r -= I_UP;
        if (r < I_G) { p0_transpose_item<false>(A.w_gate, D_MODEL, D_MODEL, (bf16*)(ws + WS_WG), scr, r, lane); continue; } r -= I_G;
        p0_transpose_item<false>(A.w_ple, PLE_DIM, D_MODEL, (bf16*)(ws + WS_WPLE), scr, r, lane);
    }
    for (int m = gw; m < M_TOK; m += NGW) {
        const f32x4* xr = (const f32x4*)(A.x + (size_t)m * D_MODEL) + lane;
        f32x4 v[16]; float s = 0.f;
#pragma unroll
        for (int j = 0; j < 16; ++j) { v[j] = xr[64 * j]; s += (v[j].x * v[j].x + v[j].y * v[j].y) + (v[j].z * v[j].z + v[j].w * v[j].w); }
        const float rstd = 1.0f / sqrtf(wave_sum(s) * (1.0f / D_MODEL) + NORM_EPS);
        v2u* o8 = (v2u*)((bf16*)(ws + WS_XN) + (size_t)m * D_MODEL) + lane;
        const f32x4* gr = (const f32x4*)A.attn_g + lane;
#pragma unroll
        for (int j = 0; j < 16; ++j) { const f32x4 g = gr[64 * j]; v2u o; o.x = pk2(v[j].x * rstd * g.x, v[j].y * rstd * g.y); o.y = pk2(v[j].z * rstd * g.z, v[j].w * rstd * g.w); o8[64 * j] = o; }
    }
    { const int gt = gw * 64 + lane, NGT = NGW * 64;
      for (int i = gt; i < M_TOK * PLE_DIM / 8; i += NGT) { const f32x4 a = ((const f32x4*)A.p)[2 * i], b = ((const f32x4*)A.p)[2 * i + 1];
          v4u o; o.x = pk2(a.x, a.y); o.y = pk2(a.z, a.w); o.z = pk2(b.x, b.y); o.w = pk2(b.z, b.w); ((v4u*)(ws + WS_PB))[i] = o; }
      for (int i = gt; i < SEQ * 64; i += NGT) { const int pos = i >> 6, j = i & 63;
          const float inv = __builtin_amdgcn_exp2f(-(float)(2 * j) * (1.0f / 128.0f) * 13.287712379549449f); const float ang = (float)pos * inv;
          double xr = (double)ang * 0.15915494309189535; xr -= __builtin_rint(xr); const float fx = (float)xr;
          ((f32x2*)(ws + WS_TAB128))[i] = (f32x2){__builtin_amdgcn_cosf(fx), __builtin_amdgcn_sinf(fx)}; }
      for (int i = gt; i < SEQ * 32; i += NGT) { const int pos = i >> 5, j = i & 31;
          const float inv = __builtin_amdgcn_exp2f(-(float)(2 * j) * (1.0f / 64.0f) * 13.287712379549449f); const float ang = (float)pos * inv;
          double xr = (double)ang * 0.15915494309189535; xr -= __builtin_rint(xr); const float fx = (float)xr;
          ((f32x2*)(ws + WS_TAB64))[i] = (f32x2){__builtin_amdgcn_cosf(fx), __builtin_amdgcn_sinf(fx)}; }
      for (int i = gt; i < M_TOK; i += NGT) { ((float*)(ws + WS_ROWSS_MLP))[i] = 0.f; ((float*)(ws + WS_ROWSS_PLE))[i] = 0.f; }
    }
}

__device__ __forceinline__ void p2_qknorm_rope(const Args& A, LAS unsigned char* lds, int gw, int NGW, int tid, int lane) {
    unsigned char* ws = A.ws; bf16* proj = (bf16*)(ws + WS_PROJ);
    const f32x2* tab128 = (const f32x2*)(ws + WS_TAB128); const f32x2* tab64 = (const f32x2*)(ws + WS_TAB64);
    v4u wk_n = (v4u){0u, 0u, 0u, 0u}, w4_n[4];
#pragma unroll
    for (int it = 0; it < 4; ++it) w4_n[it] = (v4u){0u, 0u, 0u, 0u};
    if (gw < M_TOK) { const bf16* p0 = proj + (size_t)gw * IN_COLS; wk_n = *(const v4u*)(p0 + COL_KA + lane * 8);
#pragma unroll
        for (int it = 0; it < 4; ++it) w4_n[it] = *(const v4u*)(p0 + COL_KB + (it * 64 + lane) * 8); }
    for (int row = gw; row < M_TOK; row += NGW) {
        const int pos = row & (SEQ - 1); bf16* prow = proj + (size_t)row * IN_COLS; (void)prow;
        const v4u wk_c = wk_n; v4u w4_c[4];
#pragma unroll
        for (int it = 0; it < 4; ++it) w4_c[it] = w4_n[it];
        if (row + NGW < M_TOK) { const bf16* pn = proj + (size_t)(row + NGW) * IN_COLS; wk_n = *(const v4u*)(pn + COL_KA + lane * 8);
#pragma unroll
            for (int it = 0; it < 4; ++it) w4_n[it] = *(const v4u*)(pn + COL_KB + (it * 64 + lane) * 8); }
        { const int ch = lane, i = ch & 15;
            const v4u w = wk_c;
            float x[8] = {bflo(w.x), bfhi(w.x), bflo(w.y), bfhi(w.y), bflo(w.z), bfhi(w.z), bflo(w.w), bfhi(w.w)};
            float ss = 0.f;
#pragma unroll
            for (int e = 0; e < 8; ++e) ss += x[e] * x[e];
            ss += __shfl_xor(ss, 1); ss += __shfl_xor(ss, 2); ss += __shfl_xor(ss, 4); ss += __shfl_xor(ss, 8);
            const float rstd = 1.0f / sqrtf(ss * (1.0f / 128.0f) + NORM_EPS);
            const float* gp = A.ka_g + i * 8; const f32x4 g0 = *(const f32x4*)gp, g1 = *(const f32x4*)(gp + 4);
            const float g[8] = {g0.x, g0.y, g0.z, g0.w, g1.x, g1.y, g1.z, g1.w};
            const f32x2* tb = tab128 + pos * 64 + (i & 7) * 8; const float sgn = (i < 8) ? -1.f : 1.f;
            float o[8];
#pragma unroll
            for (int e = 0; e < 8; ++e) { const float y = x[e] * rstd * g[e]; const float py = __shfl_xor(y, 8); const f32x2 cs = tb[e]; o[e] = y * cs.x + sgn * py * cs.y; }
            v4u ow; ow.x = pk2(o[0], o[1]); ow.y = pk2(o[2], o[3]); ow.z = pk2(o[4], o[5]); ow.w = pk2(o[6], o[7]);
            { const int b = row / SEQ, jt = pos >> 6, kl = pos & 63, kvh = ch >> 4, t = 2 * (kl >> 5) + ((kl >> 2) & 1), rr = 4 * ((kl >> 3) & 3) + (kl & 3), c = i >> 2, fq = i & 3;
              int ob = rr * 64 + fq * 16; ob ^= ((ob >> 9) & 1) << 5;
              *(v4u*)(ws + WS_KIMG128 + ((size_t)(((b * 4 + kvh) * 32 + jt) * 16 + t * 4 + c)) * 1024 + ob) = ow; } }
#pragma unroll
        for (int it = 0; it < 4; ++it) { const int ch = it * 64 + lane, i = ch & 7;
            const v4u w = w4_c[it];
            float x[8] = {bflo(w.x), bfhi(w.x), bflo(w.y), bfhi(w.y), bflo(w.z), bfhi(w.z), bflo(w.w), bfhi(w.w)};
            float ss = 0.f;
#pragma unroll
            for (int e = 0; e < 8; ++e) ss += x[e] * x[e];
            ss += __shfl_xor(ss, 1); ss += __shfl_xor(ss, 2); ss += __shfl_xor(ss, 4);
            const float rstd = 1.0f / sqrtf(ss * (1.0f / 64.0f) + NORM_EPS);
            const float* gp = A.kb_g + i * 8; const f32x4 g0 = *(const f32x4*)gp, g1 = *(const f32x4*)(gp + 4);
            const float g[8] = {g0.x, g0.y, g0.z, g0.w, g1.x, g1.y, g1.z, g1.w};
            const f32x2* tb = tab64 + pos * 32 + (i & 3) * 8; const float sgn = (i < 4) ? -1.f : 1.f;
            float o[8];
#pragma unroll
            for (int e = 0; e < 8; ++e) { const float y = x[e] * rstd * g[e]; const float py = __shfl_xor(y, 4); const f32x2 cs = tb[e]; o[e] = y * cs.x + sgn * py * cs.y; }
            v4u ow; ow.x = pk2(o[0], o[1]); ow.y = pk2(o[2], o[3]); ow.z = pk2(o[4], o[5]); ow.w = pk2(o[6], o[7]);
            { const int b = row / SEQ, jt = pos >> 6, kl = pos & 63, mh = ch >> 3, t = 2 * (kl >> 5) + ((kl >> 2) & 1), rr = 4 * ((kl >> 3) & 3) + (kl & 3), c = i >> 2, fq = i & 3;
              int ob = rr * 64 + fq * 16; ob ^= ((ob >> 9) & 1) << 5;
              *(v4u*)(ws + WS_KIMG64 + ((size_t)(((b * 32 + mh) * 32 + jt) * 8 + t * 2 + c)) * 1024 + ob) = ow; } }
    }
    constexpr int NVT = (M_TOK / 64) * 20;
    v4u wv[2] = {(v4u){0u, 0u, 0u, 0u}, (v4u){0u, 0u, 0u, 0u}};
#define P2_VSRC(tile_, k_) (proj + (size_t)(((tile_) / 20) * 64 + ((tid + 512 * (k_)) >> 4)) * IN_COLS + (((tile_) % 20) < 4 ? COL_VA + ((tile_) % 20) * 128 : COL_VB + (((tile_) % 20) - 4) * 128) + ((tid + 512 * (k_)) & 15) * 8)
    if ((int)blockIdx.x < NVT) { wv[0] = *(const v4u*)P2_VSRC((int)blockIdx.x, 0); wv[1] = *(const v4u*)P2_VSRC((int)blockIdx.x, 1); }
    int vit = 0;
    for (int tile = blockIdx.x; tile < NVT; tile += gridDim.x, ++vit) {
        LAS bf16* T = (LAS bf16*)(lds + (vit & 1) * 18432);
        const int tb = tile / 20, hd = tile % 20, b = tb / (SEQ / 64), s0 = (tb % (SEQ / 64)) * 64;
        unsigned char* dst = hd < 4 ? ws + WS_VTA + ((size_t)(b * 4 + hd) * 32 + (s0 >> 6)) * 16384 : ws + WS_VTB + ((size_t)(b * 16 + (hd - 4)) * 32 + (s0 >> 6)) * 16384;
        const v4u wc0 = wv[0], wc1 = wv[1];
        const int nxt = tile + (int)gridDim.x;
        if (nxt < NVT) { wv[0] = *(const v4u*)P2_VSRC(nxt, 0); wv[1] = *(const v4u*)P2_VSRC(nxt, 1); }
#pragma unroll
        for (int k = 0; k < 2; ++k) { const int ci = tid + 512 * k, tok = ci >> 4, dc = ci & 15;
            const v4u w = k ? wc1 : wc0;
            LAS bf16* t = T + (dc * 8) * 72 + tok;
            t[0 * 72] = (bf16)(w.x & 0xffff); t[1 * 72] = (bf16)(w.x >> 16); t[2 * 72] = (bf16)(w.y & 0xffff); t[3 * 72] = (bf16)(w.y >> 16);
            t[4 * 72] = (bf16)(w.z & 0xffff); t[5 * 72] = (bf16)(w.z >> 16); t[6 * 72] = (bf16)(w.w & 0xffff); t[7 * 72] = (bf16)(w.w >> 16); }
        __syncthreads();
#pragma unroll
        for (int k = 0; k < 2; ++k) { const int ci = tid + 512 * k, d = ci >> 3, tc = ci & 7;
            const v4u w = *(const LAS v4u*)(T + d * 72 + tc * 8);
            const int dtp = 2 * (d >> 5) + ((d >> 2) & 1), rrp = 4 * ((d >> 3) & 3) + (d & 3);
            int ob = rrp * 64 + (tc & 3) * 16; ob ^= ((ob >> 9) & 1) << 5;
            *(v4u*)(dst + (dtp * 2 + (tc >> 2)) * 1024 + ob) = w; }
    }
    __syncthreads();
#undef P2_VSRC
}

namespace att {
constexpr int BUF_BYTES = 32768, K_OFF = 0, V_OFF = 16384;
constexpr float NEG = -1e30f;
__device__ __forceinline__ int swz(int rr, int fq) { const int ob = rr * 64 + fq * 16; return ob ^ (((ob >> 9) & 1) << 5); }

template <int DK>
__device__ __forceinline__ void dma_tile(LAS unsigned char* buf, const unsigned char* ktile, const unsigned char* vtile, int wave, unsigned lane16) {
    constexpr int NK = 4 * (DK / 32), PER = (NK + 16) / 8;
#pragma unroll
    for (int i = 0; i < PER; ++i) { const int st = wave * PER + i;
        const unsigned char* gp; LAS unsigned char* dst;
        if (st < NK) { gp = ktile + st * 1024 + lane16; dst = buf + K_OFF + st * 1024; }
        else { gp = vtile + (st - NK) * 1024 + lane16; dst = buf + V_OFF + (st - NK) * 1024; }
        __builtin_amdgcn_global_load_lds((const unsigned*)gp, (LAS unsigned*)dst, 16, 0, 0); }
}

template <int DK, bool SWA>
__device__ __forceinline__ void pass(LAS unsigned char* lds, const bf16* Q, int ldq, const float* qgain, const f32x2* qtab, const float qscale, const unsigned char* kimg, const unsigned char* vimg, int q0, int jt_lo, int jt_hi,
                                     float (&mrow)[2], float (&lrow)[2], f32x4 (&O)[2][8], const bool online, const float mfix, int tid, int wave, int lane) {
    constexpr int PER = (4 * (DK / 32) + 16) / 8;
    const int fr = lane & 15, fq = lane >> 4, qw = q0 + 32 * wave;
    const int ntile = jt_hi - jt_lo + 1;
    constexpr int KT_BYTES = 4 * (DK / 32) * 1024; const unsigned lane16 = (unsigned)lane * 16u;
#pragma unroll
    for (int p = 0; p < 2; ++p) if (p < ntile) dma_tile<DK>(lds + p * BUF_BYTES, kimg + (size_t)(jt_lo + p) * KT_BYTES, vimg + (size_t)(jt_lo + p) * 16384, wave, lane16);
    bf16x8 qf[2][DK / 32];
#pragma unroll
    for (int rg = 0; rg < 2; ++rg) {
        const int qrow = qw + 16 * rg + fr;
        float x[DK / 32][8]; float ss = 0.f;
#pragma unroll
        for (int c = 0; c < DK / 32; ++c) { const v4u w = *(const v4u*)(Q + (size_t)qrow * ldq + 32 * c + 8 * fq);
            x[c][0] = bflo(w.x); x[c][1] = bfhi(w.x); x[c][2] = bflo(w.y); x[c][3] = bfhi(w.y); x[c][4] = bflo(w.z); x[c][5] = bfhi(w.z); x[c][6] = bflo(w.w); x[c][7] = bfhi(w.w);
#pragma unroll
            for (int e = 0; e < 8; ++e) ss += x[c][e] * x[c][e]; }
        ss += __shfl_xor(ss, 16); ss += __shfl_xor(ss, 32);
        const float rq = qscale / sqrtf(ss * (1.0f / DK) + NORM_EPS);
#pragma unroll
        for (int c = 0; c < DK / 64; ++c) { const int ch = c + DK / 64;
            const f32x4 ga = *(const f32x4*)(qgain + 32 * c + 8 * fq), gb = *(const f32x4*)(qgain + 32 * c + 8 * fq + 4), gc = *(const f32x4*)(qgain + 32 * ch + 8 * fq), gd = *(const f32x4*)(qgain + 32 * ch + 8 * fq + 4);
            const float gl[8] = {ga.x, ga.y, ga.z, ga.w, gb.x, gb.y, gb.z, gb.w}, gh[8] = {gc.x, gc.y, gc.z, gc.w, gd.x, gd.y, gd.z, gd.w};
            const f32x4* tp = (const f32x4*)(qtab + (size_t)qrow * (DK / 2) + 32 * c + 8 * fq);
            const f32x4 t0 = tp[0], t1 = tp[1], t2 = tp[2], t3 = tp[3];
            const float cs[8] = {t0.x, t0.z, t1.x, t1.z, t2.x, t2.z, t3.x, t3.z}, sn[8] = {t0.y, t0.w, t1.y, t1.w, t2.y, t2.w, t3.y, t3.w};
            float ol[8], oh[8];
#pragma unroll
            for (int e = 0; e < 8; ++e) { const float yl = x[c][e] * gl[e], yh = x[ch][e] * gh[e]; ol[e] = (yl * cs[e] - yh * sn[e]) * rq; oh[e] = (yh * cs[e] + yl * sn[e]) * rq; }
            v4u wl, wh; wl.x = pk2(ol[0], ol[1]); wl.y = pk2(ol[2], ol[3]); wl.z = pk2(ol[4], ol[5]); wl.w = pk2(ol[6], ol[7]);
            wh.x = pk2(oh[0], oh[1]); wh.y = pk2(oh[2], oh[3]); wh.z = pk2(oh[4], oh[5]); wh.w = pk2(oh[6], oh[7]);
            qf[rg][c] = __builtin_bit_cast(bf16x8, wl); qf[rg][ch] = __builtin_bit_cast(bf16x8, wh); }
    }
    const int fro = swz(fr, fq);
    const float sinit = online ? 0.f : -mfix;
#define ATT_PV(pvbuf) do { bf16x8 vfa[4][2], vfb[4][2]; \
        _Pragma("unroll") for (int dt = 0; dt < 4; ++dt) _Pragma("unroll") for (int u = 0; u < 2; ++u) vfa[dt][u] = *(const LAS bf16x8*)((pvbuf) + V_OFF + (dt * 2 + u) * 1024 + fro); \
        _Pragma("unroll") for (int dt = 0; dt < 4; ++dt) _Pragma("unroll") for (int u = 0; u < 2; ++u) vfb[dt][u] = *(const LAS bf16x8*)((pvbuf) + V_OFF + ((dt + 4) * 2 + u) * 1024 + fro); \
        __builtin_amdgcn_s_setprio(1); \
        _Pragma("unroll") for (int dt = 0; dt < 8; ++dt) _Pragma("unroll") for (int u = 0; u < 2; ++u) _Pragma("unroll") for (int rg = 0; rg < 2; ++rg) \
            O[rg][dt] = __builtin_amdgcn_mfma_f32_16x16x32_bf16(dt < 4 ? vfa[dt][u] : vfb[dt - 4][u], pf[rg][u], O[rg][dt], 0, 0, 0); \
        __builtin_amdgcn_s_setprio(0); } while (0)
    const bool lagB = wave >= 4;
    bool pend = false;
    bf16x8 pf[2][2];
#pragma unroll
    for (int rg = 0; rg < 2; ++rg)
#pragma unroll
        for (int u = 0; u < 2; ++u) pf[rg][u] = (bf16x8){0, 0, 0, 0, 0, 0, 0, 0};
    for (int i = 0; i < ntile; ++i) {
        const int jt = jt_lo + i, rem = ntile - 1 - i;
        if (rem >= 1) asm volatile("s_waitcnt vmcnt(%0)" :: "n"(PER) : "memory");
        else asm volatile("s_waitcnt vmcnt(0)" ::: "memory");
        __builtin_amdgcn_s_barrier(); asm volatile("" ::: "memory");
        if (i + 2 < ntile) dma_tile<DK>(lds + ((i + 2) & 3) * BUF_BYTES, kimg + (size_t)(jt + 2) * KT_BYTES, vimg + (size_t)(jt + 2) * 16384, wave, lane16);
        if (lagB && pend) { ATT_PV(lds + ((i - 1) & 3) * BUF_BYTES); pend = false; }
        LAS unsigned char* buf = lds + (i & 3) * BUF_BYTES;
        const int kt0 = jt * 64;
        bool need = kt0 <= qw + 31; if (SWA) need = need && (kt0 + 63 >= qw - 127);
        if (need) {
            f32x4 s[2][4];
            {
                bf16x8 kf[4][DK / 32];
#pragma unroll
                for (int t = 0; t < 4; ++t)
#pragma unroll
                    for (int c = 0; c < DK / 32; ++c) kf[t][c] = *(const LAS bf16x8*)(buf + K_OFF + (t * (DK / 32) + c) * 1024 + fro);
                __builtin_amdgcn_s_setprio(1);
#pragma unroll
                for (int t = 0; t < 4; ++t) {
#pragma unroll
                    for (int rg = 0; rg < 2; ++rg) s[rg][t] = (f32x4){sinit, sinit, sinit, sinit};
#pragma unroll
                    for (int c = 0; c < DK / 32; ++c)
#pragma unroll
                        for (int rg = 0; rg < 2; ++rg) s[rg][t] = __builtin_amdgcn_mfma_f32_16x16x32_bf16(kf[t][c], qf[rg][c], s[rg][t], 0, 0, 0); }
                __builtin_amdgcn_s_setprio(0);
            }
            const bool domask = SWA || (kt0 + 63 > qw);
            if (domask) {
#pragma unroll
                for (int rg = 0; rg < 2; ++rg) { const int q = qw + 16 * rg + fr;
#pragma unroll
                    for (int t = 0; t < 4; ++t)
#pragma unroll
                        for (int i2 = 0; i2 < 4; ++i2) { const int key = kt0 + 32 * (t >> 1) + 8 * fq + 4 * (t & 1) + i2;
                            bool ok = key <= q; if (SWA) ok = ok && (q - key < 128);
                            s[rg][t][i2] = ok ? s[rg][t][i2] : NEG; } }
            }
            if (!online) {
#pragma unroll
                for (int rg = 0; rg < 2; ++rg) {
                    float ps = 0.f;
#pragma unroll
                    for (int t = 0; t < 4; ++t)
#pragma unroll
                        for (int i2 = 0; i2 < 4; ++i2) { const float p = __builtin_amdgcn_exp2f(s[rg][t][i2]); s[rg][t][i2] = p; ps += p; }
                    lrow[rg] += ps;
#pragma unroll
                    for (int u = 0; u < 2; ++u) { v4u w; w.x = pk2(s[rg][2 * u][0], s[rg][2 * u][1]); w.y = pk2(s[rg][2 * u][2], s[rg][2 * u][3]);
                        w.z = pk2(s[rg][2 * u + 1][0], s[rg][2 * u + 1][1]); w.w = pk2(s[rg][2 * u + 1][2], s[rg][2 * u + 1][3]); pf[rg][u] = __builtin_bit_cast(bf16x8, w); }
                }
            } else
#pragma unroll
            for (int rg = 0; rg < 2; ++rg) {
                float mx = NEG;
#pragma unroll
                for (int t = 0; t < 4; ++t) mx = fmaxf(mx, fmaxf(fmaxf(s[rg][t][0], s[rg][t][1]), fmaxf(s[rg][t][2], s[rg][t][3])));
                mx = fmaxf(mx, __shfl_xor(mx, 16)); mx = fmaxf(mx, __shfl_xor(mx, 32));
                const float mnew = fmaxf(mrow[rg], mx), alpha = __builtin_amdgcn_exp2f(mrow[rg] - mnew); mrow[rg] = mnew;
                float ps = 0.f;
#pragma unroll
                for (int t = 0; t < 4; ++t)
#pragma unroll
                    for (int i2 = 0; i2 < 4; ++i2) { const float p = __builtin_amdgcn_exp2f(s[rg][t][i2] - mnew); s[rg][t][i2] = p; ps += p; }
                lrow[rg] = lrow[rg] * alpha + ps;
#pragma unroll
                for (int dt = 0; dt < 8; ++dt) O[rg][dt] = O[rg][dt] * alpha;
#pragma unroll
                for (int u = 0; u < 2; ++u) { v4u w; w.x = pk2(s[rg][2 * u][0], s[rg][2 * u][1]); w.y = pk2(s[rg][2 * u][2], s[rg][2 * u][3]);
                    w.z = pk2(s[rg][2 * u + 1][0], s[rg][2 * u + 1][1]); w.w = pk2(s[rg][2 * u + 1][2], s[rg][2 * u + 1][3]); pf[rg][u] = __builtin_bit_cast(bf16x8, w); }
            }
            if (lagB) pend = true; else ATT_PV(buf);
        }
    }
    if (lagB && pend) ATT_PV(lds + ((ntile - 1) & 3) * BUF_BYTES);
#undef ATT_PV
    __builtin_amdgcn_s_barrier(); asm volatile("" ::: "memory");
}

__device__ __forceinline__ void init_state(float (&m)[2], float (&l)[2], f32x4 (&O)[2][8], float m0) {
#pragma unroll
    for (int rg = 0; rg < 2; ++rg) { m[rg] = m0; l[rg] = 0.f;
#pragma unroll
        for (int dt = 0; dt < 8; ++dt) O[rg][dt] = (f32x4){0.f, 0.f, 0.f, 0.f}; }
}

__device__ __forceinline__ void swa_unit(const Args& A, LAS unsigned char* lds, int unit, const bool online, const float mfix) {
    int tid_ = threadIdx.x; asm volatile("" : "+v"(tid_));
    const int tid = tid_, lane = tid & 63, wave = __builtin_amdgcn_readfirstlane(tid >> 6);
    unsigned char* ws = A.ws; const bf16* proj = (const bf16*)(ws + WS_PROJ);
    const int qb = unit & 7, hq = (unit >> 3) & 15, b = unit >> 7, kvh = hq >> 2, q0 = qb * 256;
    const bf16* Q = proj + (size_t)b * SEQ * IN_COLS + COL_QA + hq * 128;
    const unsigned char* kimg = ws + WS_KIMG128 + (size_t)(b * 4 + kvh) * 32 * 16384;
    const unsigned char* vimg = ws + WS_VTA + (size_t)(b * 4 + kvh) * 32 * 16384;
    float m[2], l[2]; f32x4 O[2][8]; init_state(m, l, O, online ? NEG : mfix);
    const int jt_lo = (4 * qb - 2) > 0 ? 4 * qb - 2 : 0, jt_hi = 4 * qb + 3;
    pass<128, true>(lds, Q, IN_COLS, A.qa_g, (const f32x2*)(ws + WS_TAB128), 0.08838834764831845f * LOG2E, kimg, vimg, q0, jt_lo, jt_hi, m, l, O, online, mfix, tid, wave, lane);
    int lane2 = lane; asm volatile("" : "+v"(lane2));
    const int fr = lane2 & 15, fq = lane2 >> 4; const float sink2 = A.sinks[hq] * LOG2E;
    bf16* cat = (bf16*)(ws + WS_CAT);
#pragma unroll
    for (int rg = 0; rg < 2; ++rg) { float lt = l[rg]; lt += __shfl_xor(lt, 16); lt += __shfl_xor(lt, 32);
        lt += __builtin_amdgcn_exp2f(sink2 - m[rg]); const float inv = 1.0f / lt;
        bf16* orow = cat + (size_t)(b * SEQ + q0 + 32 * wave + 16 * rg + fr) * D_MODEL + hq * 128 + 8 * fq;
#pragma unroll
        for (int k = 0; k < 4; ++k) { const f32x4 o0 = O[rg][2 * k] * inv, o1 = O[rg][2 * k + 1] * inv; v4u w; w.x = pk2(o0[0], o0[1]); w.y = pk2(o0[2], o0[3]); w.z = pk2(o1[0], o1[1]); w.w = pk2(o1[2], o1[3]); *(v4u*)(orow + 32 * k) = w; } }
}
__device__ __forceinline__ void diff_unit(const Args& A, LAS unsigned char* lds, int b, int h, int qb, float lam, const bool online, const float mfix) {
    int tid_ = threadIdx.x; asm volatile("" : "+v"(tid_));
    const int tid = tid_, lane = tid & 63, wave = __builtin_amdgcn_readfirstlane(tid >> 6);
    unsigned char* ws = A.ws; const bf16* proj = (const bf16*)(ws + WS_PROJ);
    const int q0 = qb * 256; const size_t boff = (size_t)b * SEQ * IN_COLS;
    const unsigned char* vimg = ws + WS_VTB + (size_t)(b * 16 + h) * 32 * 16384;
    const int jt_hi = 4 * qb + 3;
    float m[2], l[2]; f32x4 O1[2][8], O0[2][8];
    unsigned char* oscr = ws + WS_OSCR + (size_t)blockIdx.x * 131072; const unsigned tid16 = (unsigned)tid * 16u;
#pragma unroll 1
    for (int mp = 0; mp < 2; ++mp) {
        init_state(m, l, O1, online ? NEG : mfix);
        pass<64, false>(lds, proj + boff + COL_QB + mp * 1024 + h * 64, IN_COLS, A.qb_g, (const f32x2*)(ws + WS_TAB64), 0.125f * LOG2E, ws + WS_KIMG64 + (size_t)((b * 2 + mp) * 16 + h) * 32 * 8192, vimg, q0, 0, jt_hi, m, l, O1, online, mfix, tid, wave, lane);
        if (mp == 0) {
#pragma unroll
            for (int rg = 0; rg < 2; ++rg) { float lt = l[rg]; lt += __shfl_xor(lt, 16); lt += __shfl_xor(lt, 32); const float inv = 1.0f / lt;
#pragma unroll
                for (int dt = 0; dt < 8; ++dt) *(f32x4*)(oscr + (rg * 8 + dt) * 8192 + tid16) = O1[rg][dt] * inv; }
        }
    }
#pragma unroll
    for (int rg = 0; rg < 2; ++rg)
#pragma unroll
        for (int dt = 0; dt < 8; ++dt) O0[rg][dt] = *(const f32x4*)(oscr + (rg * 8 + dt) * 8192 + tid16);
    int lane2 = lane; asm volatile("" : "+v"(lane2));
    const int fr = lane2 & 15, fq = lane2 >> 4;
    bf16* cat = (bf16*)(ws + WS_CAT);
#pragma unroll
    for (int rg = 0; rg < 2; ++rg) { float lt = l[rg]; lt += __shfl_xor(lt, 16); lt += __shfl_xor(lt, 32); const float sc = -lam / lt;
        float ss = 0.f;
#pragma unroll
        for (int dt = 0; dt < 8; ++dt) { const f32x4 o = O0[rg][dt] + O1[rg][dt] * sc; O0[rg][dt] = o; ss += (o[0] * o[0] + o[1] * o[1]) + (o[2] * o[2] + o[3] * o[3]); }
        ss += __shfl_xor(ss, 16); ss += __shfl_xor(ss, 32);
        const float rs = 0.8f / sqrtf(ss * (1.0f / 128.0f) + NORM_EPS);
        bf16* orow = cat + (size_t)(b * SEQ + q0 + 32 * wave + 16 * rg + fr) * D_MODEL + 2048 + h * 128 + 8 * fq;
#pragma unroll
        for (int k = 0; k < 4; ++k) { const f32x4 g0 = *(const f32x4*)(A.subln_g + 32 * k + 8 * fq), g1 = *(const f32x4*)(A.subln_g + 32 * k + 8 * fq + 4); const f32x4 o0 = O0[rg][2 * k] * g0 * rs, o1 = O0[rg][2 * k + 1] * g1 * rs;
            v4u w; w.x = pk2(o0[0], o0[1]); w.y = pk2(o0[2], o0[3]); w.z = pk2(o1[0], o1[1]); w.w = pk2(o1[2], o1[3]); *(v4u*)(orow + 32 * k) = w; } }
}
}

#define RLX_AGENT __ATOMIC_RELAXED, __HIP_MEMORY_SCOPE_AGENT
#define XB_TMO      128
#define XB_XCNT(j)  (256  + 64 * (j))
#define XB_XSUB(j)  (1280 + 64 * (j))
#define XB_XGEN(j)  (2304 + 64 * (j))
#define XB_TOP      3328
#define XB_TOPGEN   3392
#define XCD_BAR_WORDS 3456
#define XB_SPIN_CAP (1u << 18)

__device__ __forceinline__ unsigned xb_ld(unsigned* p)              { return __hip_atomic_load(p, __ATOMIC_RELAXED, __HIP_MEMORY_SCOPE_AGENT); }
__device__ __forceinline__ unsigned xb_add(unsigned* p, unsigned v) { return __hip_atomic_fetch_add(p, v, __ATOMIC_RELAXED, __HIP_MEMORY_SCOPE_AGENT); }
__device__ __forceinline__ unsigned xb_xcc_id() { return (unsigned)__builtin_amdgcn_s_getreg((3 << 11) | 20) & 0xFu; }
#define XB_SPIN(cond, bar) do { unsigned _sp = 0; while (cond) { __builtin_amdgcn_s_sleep(1); \
    if ((++_sp & 255u) == 0u) { if (xb_ld(&(bar)[XB_TMO])) break; if (_sp > XB_SPIN_CAP) { atomicAdd(&(bar)[XB_TMO], 1u); break; } } } } while (0)

struct XcdBarrier {
    unsigned* bar; unsigned x;
    volatile LAS unsigned* st;
};

__device__ __forceinline__ XcdBarrier xcd_barrier_post(unsigned* bar, volatile LAS unsigned* st) {
    XcdBarrier b; b.bar = bar; b.x = xb_xcc_id(); b.st = st;
    if (threadIdx.x == 0) (void)xb_add(&bar[XB_XCNT(b.x)], 1u);
    return b;
}
__device__ __forceinline__ void xcd_barrier_complete(unsigned* bar, unsigned x, unsigned& nloc, unsigned& nx) {
    const unsigned G = gridDim.x * gridDim.y * gridDim.z;
    unsigned sum, cnt, mine, sp = 0u;
    for (;;) {
        sum = 0u; cnt = 0u; mine = 0u;
#pragma unroll
        for (unsigned j = 0; j < 16; ++j) { const unsigned c = xb_ld(&bar[XB_XCNT(j)]); sum += c; cnt += (c > 0u) ? 1u : 0u; mine = (j == x) ? c : mine; }
        if (sum == G) break;
        __builtin_amdgcn_s_sleep(1);
        if ((++sp & 255u) == 0u) { if (xb_ld(&bar[XB_TMO])) break; if (sp > XB_SPIN_CAP) { atomicAdd(&bar[XB_TMO], 1u); break; } }
    }
    nloc = mine > 0u ? mine : 1u; nx = cnt > 0u ? cnt : 1u;
}

__device__ __forceinline__ void xcd_barrier(const XcdBarrier& b) {
    asm volatile("s_waitcnt vmcnt(0)" ::: "memory");
    __syncthreads();
    if (threadIdx.x == 0) {
        unsigned* bar = b.bar;
        __builtin_amdgcn_s_waitcnt(0);
        unsigned nloc = b.st[0], nx = b.st[1];
        if (nloc == 0u) { xcd_barrier_complete(bar, b.x, nloc, nx); b.st[0] = nloc; b.st[1] = nx; }
        const unsigned old = xb_add(&bar[XB_XSUB(b.x)], 1u);
        const unsigned gen = old / nloc;
        if (old + 1u == (gen + 1u) * nloc) {
            __builtin_amdgcn_fence(__ATOMIC_RELEASE, "agent");
            asm volatile("s_waitcnt vmcnt(0)" ::: "memory");
            const unsigned og = xb_add(&bar[XB_TOP], 1u);
            const unsigned tg = og / nx;
            if (og + 1u == (tg + 1u) * nx) xb_add(&bar[XB_TOPGEN], 1u);
            else XB_SPIN(xb_ld(&bar[XB_TOPGEN]) == tg, bar);
            __builtin_amdgcn_fence(__ATOMIC_ACQUIRE, "agent");
            xb_add(&bar[XB_XGEN(b.x)], 1u);
            asm volatile("s_waitcnt vmcnt(0)" ::: "memory");
        } else {
            XB_SPIN(xb_ld(&bar[XB_XGEN(b.x)]) == gen, bar);
            __builtin_amdgcn_fence(__ATOMIC_ACQUIRE, "agent");
            asm volatile("s_waitcnt vmcnt(0)" ::: "memory");
        }
    }
    __syncthreads();
}

#define PG8_SP2 true
#define PG8_ALIGN true
__global__ void __launch_bounds__(NTHREADS, 2) hymba_fwd(Args A) {
    extern __shared__ __attribute__((aligned(16))) unsigned char lds_raw[];
    LAS unsigned char* lds = (LAS unsigned char*)lds_raw;
    const int tid = threadIdx.x, lane = tid & 63, wave = __builtin_amdgcn_readfirstlane(tid >> 6);
    const int G = gridDim.x, gw = blockIdx.x * NWAVES + wave, NGW = G * NWAVES;
    unsigned char* ws = A.ws;
    const int lo = A.ph_lo, hi = A.ph_hi;
#ifndef PHMASK
#define PHMASK 0xff
#endif
#define IN(k) (((PHMASK >> (k)) & 1) && lo <= (k) && (k) < hi)
#ifndef DIAG
#define DIAG 0
#endif
#define STAMP(k) do { if (DIAG && blockIdx.x == 0 && tid == 0) ((unsigned long long*)(ws + 32768))[k] = __builtin_amdgcn_s_memrealtime(); } while (0)
#define SEAM(k) do { if (IN(k) && IN((k) + 1)) { xcd_barrier(bar); } STAMP((k) + 1); } while (0)
    volatile LAS unsigned* MISC = (volatile LAS unsigned*)(lds + LDS_BYTES - 64);
    if (tid < 16) MISC[tid] = 0u;
    __syncthreads();
    XcdBarrier bar; bar.bar = (unsigned*)(ws + WS_CTL); bar.x = 0; bar.st = nullptr;
    if (A.coop) bar = xcd_barrier_post((unsigned*)(ws + WS_CTL), MISC);
    if (A.coop == 2) cg::this_grid().sync();

#ifndef REP0
#define REP0 1
#endif
#ifndef REP3
#define REP3 1
#endif
#ifndef REP5
#define REP5 1
#endif
#ifndef WDOWN_IN_P1
#define WDOWN_IN_P1 1
#endif
    const int p1_rem = WDOWN_IN_P1 ? ((M_TOK / 256) * (IN_COLS / 256)) % G : 0;
    STAMP(0);
    if (IN(0)) { for (int rep = 0; rep < REP0; ++rep) p0_prologue(A, lds, gw, NGW, wave, lane); if (p1_rem == 0) convert_wdown<false>(A, lds, gw, NGW, wave, lane); }
    SEAM(0);
    if (IN(1)) {
        { pg8::Gemm g{(const bf16*)(ws + WS_XN), (const bf16*)(ws + WS_WIN), M_TOK, IN_COLS, D_MODEL}; pg8::StaticOrder S; S.init(M_TOK, IN_COLS, G, (int)blockIdx.x);
          pg8::EpiPlain E{(bf16*)(ws + WS_PROJ), IN_COLS};
          pg8::gemm_phase<pg8::EpiPlain, pg8::StaticOrder, PG8_ALIGN, PG8_SP2>(lds, g, S, E); }
        { pg8::Gemm g{(const bf16*)(ws + WS_PB), (const bf16*)(ws + WS_WPLE), M_TOK, D_MODEL, PLE_DIM}; pg8::StaticOrder S; S.init(M_TOK, D_MODEL, G, (int)blockIdx.x);
          pg8::EpiPle E{(bf16*)(ws + WS_PE), D_MODEL, (float*)(ws + WS_ROWSS_PLE)};
          pg8::gemm_phase<pg8::EpiPle, pg8::StaticOrder, PG8_ALIGN, PG8_SP2>(lds, g, S, E); }
        if (p1_rem != 0 && (int)blockIdx.x >= p1_rem) convert_wdown<true>(A, lds, ((int)blockIdx.x - p1_rem) * NWAVES + wave, (G - p1_rem) * NWAVES, wave, lane);
    }
    SEAM(1);
    if (IN(2)) { p2_qknorm_rope(A, lds, gw, NGW, tid, lane); }
    SEAM(2);
    if (IN(3)) {
        const float s1 = wave_sum(A.lq1[lane] * A.lk1[lane]), s2 = wave_sum(A.lq2[lane] * A.lk2[lane]);
        const float lam = __expf(s1) - __expf(s2) + 0.2f;
        const float gqa = wave_max(fmaxf(fabsf(A.qa_g[lane]), fabsf(A.qa_g[lane + 64]))), gka = wave_max(fmaxf(fabsf(A.ka_g[lane]), fabsf(A.ka_g[lane + 64])));
        const float gqb = wave_max(fabsf(A.qb_g[lane])), gkb = wave_max(fabsf(A.kb_g[lane]));
        const float B128 = gqa * gka * 11.313708499f * LOG2E * 1.02f, B64 = gqb * gkb * 8.0f * LOG2E * 1.02f;
        const bool on128 = !(B128 <= 30.f), on64 = !(B64 <= 30.f);
        for (int rep = 0; rep < REP3; ++rep) {
#ifndef NO_DIFF
#pragma unroll 1
        for (int pr2 = 2 * blockIdx.x; pr2 < 512; pr2 += 2 * G)
#pragma unroll 1
            for (int k = 0; k < 2; ++k) { const int pr = pr2 >> 1, b = pr >> 6, h = (pr >> 2) & 15, pi = pr & 3;
                att::diff_unit(A, lds, b, h, k ? pi : 7 - pi, lam, on64, B64); }
#endif
#ifndef NO_SWA
#pragma unroll 1
        for (int un = blockIdx.x; un < 512; un += G) att::swa_unit(A, lds, un, on128, B128);
#endif
        }
    }
    SEAM(3);
    if (IN(4)) {
        pg8::Gemm g{(const bf16*)(ws + WS_CAT), (const bf16*)(ws + WS_WO), M_TOK, D_MODEL, D_MODEL}; pg8::StaticOrder S; S.init(M_TOK, D_MODEL, G, (int)blockIdx.x);
        pg8::EpiResX E{A.x, (bf16*)(ws + WS_XN), D_MODEL, (float*)(ws + WS_ROWSS_MLP)};
        pg8::gemm_phase<pg8::EpiResX, pg8::StaticOrder, PG8_ALIGN, PG8_SP2>(lds, g, S, E);
    }
    SEAM(4);
    if (IN(5)) {
        pg8::Gemm g{(const bf16*)(ws + WS_XN), (const bf16*)(ws + WS_WUP), M_TOK, D_FF, D_MODEL}; pg8::StaticOrder S; S.init(M_TOK, D_FF, G, (int)blockIdx.x);
        pg8::EpiUp E{(bf16*)(ws + WS_U), D_FF, (const float*)(ws + WS_ROWSS_MLP), 1.0f / D_MODEL};
        for (int rep = 0; rep < REP5; ++rep) pg8::gemm_phase<pg8::EpiUp, pg8::StaticOrder, PG8_ALIGN, PG8_SP2>(lds, g, S, E);
    }
    SEAM(5);
    if (IN(6)) {
        pg8::Gemm g{(const bf16*)(ws + WS_U), (const bf16*)(ws + WS_WDN), M_TOK, D_MODEL, D_FF}; pg8::StaticOrder S; S.init(M_TOK, D_MODEL, G, (int)blockIdx.x);
        pg8::EpiResB E{(bf16*)(ws + WS_XN), D_MODEL};
        pg8::gemm_phase<pg8::EpiResB, pg8::StaticOrder, PG8_ALIGN, PG8_SP2>(lds, g, S, E);
    }
    SEAM(6);
    if (IN(7)) {
        pg8::Gemm g{(const bf16*)(ws + WS_XN), (const bf16*)(ws + WS_WG), M_TOK, D_MODEL, D_MODEL}; pg8::StaticOrder S; S.init(M_TOK, D_MODEL, G, (int)blockIdx.x);
        pg8::EpiFinalB E{A.out, (const bf16*)(ws + WS_XN), (const bf16*)(ws + WS_PE), D_MODEL, (const float*)(ws + WS_ROWSS_PLE), A.ple_g, 1.0f / D_MODEL};
        pg8::gemm_phase<pg8::EpiFinalB, pg8::StaticOrder, PG8_ALIGN, PG8_SP2>(lds, g, S, E);
    }
#if DIAG
    STAMP(8); xcd_barrier(bar);
    if (blockIdx.x == 0 && tid == 0) { const unsigned long long* ts = (const unsigned long long*)(ws + 32768); A.out[0] = (float)(ts[DIAG_B] - ts[DIAG_A]) * 0.01f; }
#endif
#undef IN
#undef SEAM
}

#ifndef MK_PER_PHASE
#define MK_PER_PHASE 0
#endif
extern "C" void kernel_launch(void* const* d_in, const int* in_sizes, int n_in, void* d_out, int out_size, void* d_ws, size_t ws_size, hipStream_t stream) {
    static int grid = 0;
    if (grid == 0) {
        if (n_in != 21 || in_sizes[0] != M_TOK * D_MODEL || out_size != M_TOK * D_MODEL || ws_size < WS_END) { fprintf(stderr, "kernel_launch: unexpected shapes (n_in %d, ws %zu); nothing launched\n", n_in, ws_size); grid = -1; return; }
        int dev = 0, cus = 0, per_cu = 0;
        if (hipGetDevice(&dev) != hipSuccess || hipDeviceGetAttribute(&cus, hipDeviceAttributeMultiprocessorCount, dev) != hipSuccess) { grid = -1; return; }
        if (hipFuncSetAttribute((const void*)hymba_fwd, hipFuncAttributeMaxDynamicSharedMemorySize, LDS_BYTES) != hipSuccess) { fprintf(stderr, "kernel_launch: hipFuncSetAttribute failed\n"); grid = -1; return; }
        if (hipOccupancyMaxActiveBlocksPerMultiprocessor(&per_cu, (const void*)hymba_fwd, NTHREADS, LDS_BYTES) != hipSuccess || per_cu < 1) { fprintf(stderr, "kernel_launch: occupancy query says %d\n", per_cu); per_cu = 1; }
        (void)hipGetLastError();
        grid = cus;
    }
    if (grid < 0) return;
    if (hipMemsetAsync((char*)d_ws + WS_CTL, 0, 16384, stream) != hipSuccess) { fprintf(stderr, "kernel_launch: memset failed\n"); return; }
    Args a{};
    const float** f = (const float**)&a;
    for (int i = 0; i < 21; ++i) f[i] = (const float*)d_in[i];
    a.out = (float*)d_out; a.ws = (unsigned char*)d_ws;
#if MK_PER_PHASE
    for (int ph = 0; ph < 8; ++ph) { a.ph_lo = ph; a.ph_hi = ph + 1; a.coop = 0; hipLaunchKernelGGL(hymba_fwd, dim3(grid), dim3(NTHREADS), LDS_BYTES, stream, a); }
#else
    a.ph_lo = 0; a.ph_hi = 8; a.coop = 1;
    void* args[] = {&a};
    hipError_t e = hipLaunchCooperativeKernel((const void*)hymba_fwd, dim3(grid), dim3(NTHREADS), args, LDS_BYTES, stream);
    if (e != hipSuccess) fprintf(stderr, "kernel_launch: cooperative launch failed: %s (grid %d)\n", hipGetErrorString(e), grid);
#endif
}
```
